# Optimizing an MI355X kernel written in HIP

```python
import math
import jax, jax.numpy as jnp
from jax import lax
import numpy as np

D_MODEL = 1024
BATCH = 2
SEQ = 8192
DEPTH = 4
DEC_BATCH = 16
DEC_SEQ = 32
PAST_LEN = 1024

CHUNK = 64
Q_BLOCK = 128
H_A = 8
DK_A = 128
DV_A = 128
QK_A = H_A * DK_A
W_A = H_A * DV_A
CONV_W = 4
CONV_CH = 2 * QK_A + W_A
H_B = 8
D_QK = 64
DV_B = 2 * D_QK
QK_B = H_B * 2 * D_QK
W_B = H_B * DV_B
ROPE_THETA = 10000.0
EPS = 1e-6
IN_SIZES = (CONV_CH, W_A, H_A, H_A, QK_B, QK_B, W_B, W_B, D_MODEL, D_MODEL)
IN_COLS = CONV_CH + W_A + 2 * H_A + 2 * QK_B + 2 * W_B + 2 * D_MODEL

kernel_name = 'hybrid_gdn_diffattn_stream'


def rmsnorm(x, w):
    xf = x.astype(jnp.float32)
    xf = xf * lax.rsqrt(jnp.mean(xf * xf, axis=-1, keepdims=True) + EPS)
    return xf.astype(x.dtype) * w


def ada_norm(x, c, norm_w, w_ada, b_ada):
    mod = (c @ w_ada + b_ada)[:, None, :]
    shift, scale, gate = jnp.split(mod, 3, axis=-1)
    return rmsnorm(x, norm_w) * (1 + scale) + shift, gate


def split_cols(p):
    outs, off = [], 0
    for s in IN_SIZES:
        outs.append(p[..., off:off + s])
        off += s
    return outs


def causal_conv_silu(u, buf, w):
    T = u.shape[1]
    full = jnp.concatenate([buf.astype(u.dtype), u], axis=1)
    out = full[:, 0:T] * w[0]
    for j in range(1, CONV_W):
        out = out + full[:, j:j + T] * w[j]
    return jax.nn.silu(out), full[:, T:]


def l2norm(x):
    return x * lax.rsqrt(jnp.sum(x * x, axis=-1, keepdims=True) + EPS)


def gated_delta_rule(q, k, v, g, beta, s0):
    B, T, H, _ = q.shape
    L = min(CHUNK, T)
    n = T // L
    f32 = jnp.float32
    q = l2norm(q.astype(f32)) * (DK_A ** -0.5)
    k = l2norm(k.astype(f32))

    def to_chunks(t):
        t = t.reshape((B, n, L, H) + t.shape[3:])
        return jnp.moveaxis(t, (1, 3), (0, 2))

    qc, kc, vc = to_chunks(q), to_chunks(k), to_chunks(v.astype(f32))
    gc, bc = to_chunks(g.astype(f32)), to_chunks(beta.astype(f32))
    G = jnp.cumsum(gc, axis=-1)
    diff = G[..., :, None] - G[..., None, :]
    idx = jnp.arange(L)
    incl = idx[:, None] >= idx[None, :]
    strict = idx[:, None] > idx[None, :]
    dec_incl = jnp.exp(jnp.where(incl, diff, -jnp.inf))
    dec_strict = jnp.where(strict, dec_incl, 0.0)
    kk = jnp.einsum('nbhid,nbhjd->nbhij', kc, kc)
    a_mat = jnp.eye(L, dtype=f32) + bc[..., :, None] * kk * dec_strict
    rhs = jnp.concatenate([bc[..., None] * vc, (bc * jnp.exp(G))[..., None] * kc], axis=-1)
    sol = lax.linalg.triangular_solve(a_mat, rhs, left_side=True, lower=True, unit_diagonal=True)
    v_new, k_cum = sol[..., :DV_A], sol[..., DV_A:]
    qk = jnp.einsum('nbhid,nbhjd->nbhij', qc, kc) * dec_incl
    q_dec = qc * jnp.exp(G)[..., None]
    k_dec = kc * jnp.exp(G[..., -1:] - G)[..., None]
    g_last = jnp.exp(G[..., -1])[..., None, None]

    def step(s, xs):
        vn, kcum, qk_c, qd, kd, gl = xs
        w = vn - jnp.einsum('bhid,bhdv->bhiv', kcum, s)
        o = jnp.einsum('bhid,bhdv->bhiv', qd, s) + jnp.einsum('bhij,bhjv->bhiv', qk_c, w)
        s = gl * s + jnp.einsum('bhjd,bhjv->bhdv', kd, w)
        return s, o

    s_final, o = lax.scan(step, s0.astype(f32), (v_new, k_cum, qk, q_dec, k_dec, g_last))
    o = jnp.moveaxis(o, (0, 2), (1, 3)).reshape(B, T, H, DV_A)
    return o, s_final


def rope(x, pos):
    half = x.shape[-1] // 2
    inv = ROPE_THETA ** (-jnp.arange(half, dtype=jnp.float32) / half)
    ang = pos.astype(jnp.float32)[:, None] * inv[None, :]
    cos = jnp.cos(ang)[None, :, None, None, :].astype(x.dtype)
    sin = jnp.sin(ang)[None, :, None, None, :].astype(x.dtype)
    x1, x2 = x[..., :half], x[..., half:]
    return jnp.concatenate([x1 * cos - x2 * sin, x1 * sin + x2 * cos], axis=-1)


def diff_attn_core(q, k, v, lam, mask):
    s = jnp.einsum('bhqmd,bhkmd->bhmqk', q, k).astype(jnp.float32) * (D_QK ** -0.5)
    if mask is not None:
        s = jnp.where(mask, s, -jnp.inf)
    a = jax.nn.softmax(s, axis=-1)
    a = a[:, :, 0] - lam * a[:, :, 1]
    return jnp.einsum('bhqk,bhkv->bhqv', a.astype(v.dtype), v)


def diff_attn_prompt(q, k, v, lam):
    B, H, T = q.shape[:3]
    nb = T // Q_BLOCK
    q_blocks = jnp.moveaxis(q.reshape(B, H, nb, Q_BLOCK, 2, D_QK), 2, 0)
    key_chunk = jnp.arange(T) // CHUNK

    def one_block(args):
        qb, i = args
        q_chunk = (i * Q_BLOCK + jnp.arange(Q_BLOCK)) // CHUNK
        mask = key_chunk[None, :] <= q_chunk[:, None]
        return diff_attn_core(qb, k, v, lam, mask)

    o = lax.map(one_block, (q_blocks, jnp.arange(nb)))
    return jnp.moveaxis(o, 0, 2).reshape(B, H, T, DV_B)


def mixer_layer(x, c, pos, conv_buf, ssm0, past_k, past_v, p, lam_init):
    B, T, _ = x.shape
    h, gate = ada_norm(x, c, p['norm_w'], p['w_ada'], p['b_ada'])
    u_a, z_a, b_a, a_a, q_b, k_b, v_b, z_b, g_a, g_b = split_cols(h @ p['w_in'])
    u_a, conv_new = causal_conv_silu(u_a, conv_buf, p['conv_w'])
    q_a = u_a[..., :QK_A].reshape(B, T, H_A, DK_A)
    k_a = u_a[..., QK_A:2 * QK_A].reshape(B, T, H_A, DK_A)
    v_a = u_a[..., 2 * QK_A:].reshape(B, T, H_A, DV_A)
    beta = jax.nn.sigmoid(b_a)
    g = -jnp.exp(p['a_log']) * jax.nn.softplus(a_a + p['dt_bias'])
    o_a, ssm_new = gated_delta_rule(q_a, k_a, v_a, g, beta, ssm0)
    o_a = rmsnorm(o_a.astype(x.dtype), p['gdn_norm_w']) * jax.nn.silu(z_a.reshape(B, T, H_A, DV_A))
    o_a = o_a.reshape(B, T, W_A)
    q_b = rope(q_b.reshape(B, T, H_B, 2, D_QK), pos).transpose(0, 2, 1, 3, 4)
    k_b = rope(k_b.reshape(B, T, H_B, 2, D_QK), pos).transpose(0, 2, 1, 3, 4)
    v_b = v_b.reshape(B, T, H_B, DV_B).transpose(0, 2, 1, 3)
    lq = p['lam_qk'].astype(jnp.float32)
    lam = jnp.exp(jnp.sum(lq[0] * lq[1])) - jnp.exp(jnp.sum(lq[2] * lq[3])) + lam_init
    if past_k is None:
        o_b = diff_attn_prompt(q_b, k_b, v_b, lam)
    else:
        P = past_k.shape[2]
        k_all = jnp.concatenate([past_k.reshape(B, H_B, P, 2, D_QK).astype(k_b.dtype), k_b], axis=2)
        v_all = jnp.concatenate([past_v.astype(v_b.dtype), v_b], axis=2)
        o_b = diff_attn_core(q_b, k_all, v_all, lam, None)
    o_b = rmsnorm(o_b.transpose(0, 2, 1, 3), p['diff_norm_w']) * (1.0 - lam_init)
    o_b = (o_b * jax.nn.silu(z_b.reshape(B, T, H_B, DV_B))).reshape(B, T, W_B)
    merged = jax.nn.sigmoid(g_a) * (o_a @ p['w_proj_a']) + jax.nn.sigmoid(g_b) * (o_b @ p['w_proj_b'])
    x = x + gate * (merged @ p['w_out'])
    new_k = k_b.reshape(B, H_B, T, 2 * D_QK)
    return x, new_k, v_b, ssm_new, conv_new


def setup_inputs(seed: int = 0) -> dict:
    key = jax.random.key(seed)
    ks = jax.random.split(key, 24)
    f32 = jnp.float32

    def nrm(k, shape, s):
        return s * jax.random.normal(k, shape, f32)

    dt = jnp.exp(jax.random.uniform(ks[13], (DEPTH, H_A), f32, math.log(1e-3), math.log(1e-1)))
    return {
        'x_prompt': nrm(ks[0], (BATCH, SEQ, D_MODEL), 1.0),
        'x_sample': nrm(ks[1], (DEC_BATCH, DEC_SEQ, D_MODEL), 1.0),
        'c_prompt': nrm(ks[2], (BATCH, D_MODEL), 1.0),
        'c_sample': nrm(ks[3], (DEC_BATCH, D_MODEL), 1.0),
        'cache_k': nrm(ks[4], (DEPTH, DEC_BATCH, H_B, PAST_LEN, 2 * D_QK), 1.0),
        'cache_v': nrm(ks[5], (DEPTH, DEC_BATCH, H_B, PAST_LEN, DV_B), 1.0),
        'state_ssm': nrm(ks[6], (DEPTH, DEC_BATCH, H_A, DK_A, DV_A), 0.1),
        'state_conv': nrm(ks[7], (DEPTH, DEC_BATCH, CONV_W - 1, CONV_CH), 1.0),
        'norm_w': 1.0 + nrm(ks[8], (DEPTH, D_MODEL), 0.02),
        'w_ada': nrm(ks[9], (DEPTH, D_MODEL, 3 * D_MODEL), 0.2 * D_MODEL ** -0.5),
        'b_ada': nrm(ks[10], (DEPTH, 3 * D_MODEL), 0.02),
        'w_in': nrm(ks[11], (DEPTH, D_MODEL, IN_COLS), D_MODEL ** -0.5),
        'conv_w': nrm(ks[12], (DEPTH, CONV_W, CONV_CH), CONV_W ** -0.5),
        'a_log': jnp.log(jax.random.uniform(ks[14], (DEPTH, H_A), f32, 1.0, 16.0)),
        'dt_bias': dt + jnp.log(-jnp.expm1(-dt)),
        'gdn_norm_w': 1.0 + nrm(ks[15], (DEPTH, DV_A), 0.02),
        'lam_qk': nrm(ks[16], (DEPTH, 4, D_QK), 0.1),
        'diff_norm_w': 1.0 + nrm(ks[17], (DEPTH, DV_B), 0.02),
        'w_proj_a': nrm(ks[18], (DEPTH, W_A, D_MODEL), W_A ** -0.5),
        'w_proj_b': nrm(ks[19], (DEPTH, W_B, D_MODEL), W_B ** -0.5),
        'w_out': nrm(ks[20], (DEPTH, D_MODEL, D_MODEL), D_MODEL ** -0.5),
        'final_norm_w': 1.0 + nrm(ks[21], (D_MODEL,), 0.02),
    }


def reference(x_prompt, x_sample, c_prompt, c_sample, cache_k, cache_v, state_ssm, state_conv,
              norm_w, w_ada, b_ada, w_in, conv_w, a_log, dt_bias, gdn_norm_w, lam_qk,
              diff_norm_w, w_proj_a, w_proj_b, w_out, final_norm_w):
    pos_p = jnp.arange(x_prompt.shape[1])
    pos_s = cache_k.shape[3] + jnp.arange(x_sample.shape[1])
    conv0 = jnp.zeros((x_prompt.shape[0], CONV_W - 1, CONV_CH), x_prompt.dtype)
    ssm0 = jnp.zeros((x_prompt.shape[0], H_A, DK_A, DV_A), jnp.float32)
    xp, xs = x_prompt, x_sample
    kp, vp, sp, cp = [], [], [], []
    ksm, vsm, ssm_s, csm = [], [], [], []
    for l in range(DEPTH):
        p = {'norm_w': norm_w[l], 'w_ada': w_ada[l], 'b_ada': b_ada[l], 'w_in': w_in[l],
             'conv_w': conv_w[l], 'a_log': a_log[l], 'dt_bias': dt_bias[l],
             'gdn_norm_w': gdn_norm_w[l], 'lam_qk': lam_qk[l], 'diff_norm_w': diff_norm_w[l],
             'w_proj_a': w_proj_a[l], 'w_proj_b': w_proj_b[l], 'w_out': w_out[l]}
        lam_init = 0.8 - 0.6 * math.exp(-0.3 * l)
        xp, k_, v_, s_, c_ = mixer_layer(xp, c_prompt, pos_p, conv0, ssm0, None, None, p, lam_init)
        kp.append(k_); vp.append(v_); sp.append(s_); cp.append(c_)
        xs, k_, v_, s_, c_ = mixer_layer(xs, c_sample, pos_s, state_conv[l], state_ssm[l],
                                         cache_k[l], cache_v[l], p, lam_init)
        ksm.append(k_); vsm.append(v_); ssm_s.append(s_); csm.append(c_)
    y_prompt = rmsnorm(xp, final_norm_w)
    y_sample = rmsnorm(xs, final_norm_w)
    return (y_prompt, y_sample, jnp.stack(kp), jnp.stack(vp), jnp.stack(sp), jnp.stack(cp),
            jnp.stack(ksm), jnp.stack(vsm), jnp.stack(ssm_s), jnp.stack(csm))
```

```cpp
#include <hip/hip_runtime.h>
#include <hip/hip_cooperative_groups.h>
#include <cstdio>
namespace cg = cooperative_groups;

typedef unsigned short u16;

constexpr int DM = 1024, NPT = 16384, NTOK = 16896, SEQ = 8192, LDP = 10496;
constexpr float EPSF = 1e-6f;
constexpr float QSCALE = 0.125f * 1.44269504088896340736f;

constexpr size_t O_Y = 0, O_KP = 17301504, O_VP = 84410368, O_SSMP = 151519232, O_CONVP = 152567808,
                 O_KS = 152641536, O_VS = 154738688, O_SSMS = 156835840, O_CONVS = 165224448;

constexpr size_t SZ_TOKBF = (size_t)NTOK * 1024 * 2;
constexpr size_t WS_WTIN = 0;
constexpr size_t WS_WTPA = WS_WTIN + (size_t)4 * LDP * 1024 * 2;
constexpr size_t WS_WTPB = WS_WTPA + (size_t)4 * 1024 * 1024 * 2;
constexpr size_t WS_WTOUT = WS_WTPB + (size_t)4 * 1024 * 1024 * 2;
constexpr size_t WS_MOD = WS_WTOUT + (size_t)4 * 1024 * 1024 * 2;
constexpr size_t WS_CS = WS_MOD + (size_t)4 * 18 * 3072 * 4;
constexpr size_t WS_X = WS_CS + (size_t)8192 * 32 * 8;
constexpr size_t WS_P = WS_X + (size_t)NTOK * 1024 * 4;
constexpr size_t WS_BETA = WS_P + (size_t)NTOK * LDP * 2;
constexpr size_t WS_GLOG = WS_BETA + (size_t)NTOK * 8 * 4;
constexpr size_t WS_R1 = WS_GLOG + (size_t)NTOK * 8 * 4;
constexpr size_t WS_QA = WS_R1, WS_KA = WS_R1 + SZ_TOKBF, WS_VA = WS_R1 + 2 * SZ_TOKBF;
constexpr size_t WS_T1 = WS_R1, WS_MERGED = WS_R1 + 2 * SZ_TOKBF;
constexpr size_t WS_QB = WS_R1 + 3 * SZ_TOKBF;
constexpr size_t WS_OAN = WS_QB;
constexpr size_t WS_KB = WS_QB + SZ_TOKBF;
constexpr size_t WS_VT = WS_KB + SZ_TOKBF;
constexpr int NITEM = 2176;
constexpr size_t WS_VNT = WS_VT + (size_t)2 * 8 * 128 * 8192 * 2;
constexpr size_t WS_KCUM = WS_VNT + (size_t)NITEM * 16384;
constexpr size_t WS_QD = WS_KCUM + (size_t)NITEM * 16384;
constexpr size_t WS_KDT = WS_QD + (size_t)NITEM * 16384;
constexpr size_t WS_QKM = WS_KDT + (size_t)NITEM * 16384;
constexpr size_t WS_GLAST = WS_QKM + (size_t)NITEM * 8192;
constexpr size_t WS_ORAW = WS_GLAST + 16384;
constexpr size_t WS_H = WS_ORAW;
constexpr size_t WS_OBN = WS_ORAW + (size_t)NTOK * 1024 * 4;
constexpr size_t WS_END = WS_OBN + SZ_TOKBF;
static_assert(WS_END <= (size_t)1073741824, "workspace too large");
static_assert(WS_P % 256 == 0 && WS_R1 % 256 == 0 && WS_VNT % 256 == 0 && WS_ORAW % 256 == 0 && WS_OBN % 256 == 0, "align");

constexpr int LDS_BYTES = 131072;

struct Params {
    const float* in[22];
    float* out;
    unsigned char* ws;
    int ph_lo, ph_hi;
};

typedef short bf16x8 __attribute__((ext_vector_type(8)));
typedef float f32x4 __attribute__((ext_vector_type(4)));
typedef float f32x16 __attribute__((ext_vector_type(16)));

__device__ __forceinline__ float bf2f(u16 b) { return __uint_as_float(((unsigned)b) << 16); }
__device__ __forceinline__ float bflo(unsigned w) { return __uint_as_float(w << 16); }
__device__ __forceinline__ float bfhi(unsigned w) { return __uint_as_float(w & 0xffff0000u); }
__device__ __forceinline__ unsigned pk2(float lo, float hi) { unsigned r; asm("v_cvt_pk_bf16_f32 %0, %1, %2" : "=v"(r) : "v"(lo), "v"(hi)); return r; }
__device__ __forceinline__ u16 f2bf(float f) { return (u16)(pk2(f, 0.f) & 0xffffu); }
__device__ __forceinline__ float wave_sum(float v) {
#pragma unroll
    for (int o = 32; o; o >>= 1) v += __shfl_xor(v, o);
    return v;
}
__device__ __forceinline__ float siluf(float x) { return x / (1.f + __expf(-x)); }
__device__ __forceinline__ float sigmf(float x) { return 1.f / (1.f + __expf(-x)); }
__device__ __forceinline__ int seq_of(int tok) { return tok < NPT ? (tok >> 13) : 2 + ((tok - NPT) >> 5); }
__device__ __forceinline__ int pos_of(int tok) { return tok < NPT ? (tok & 8191) : 1024 + ((tok - NPT) & 31); }
__device__ __forceinline__ float lam_init_of(int l) { return 0.8f - 0.6f * __expf(-0.3f * (float)l); }

__device__ __forceinline__ int tidx() { int t = (int)__builtin_amdgcn_workitem_id_x(); asm volatile("" : "+v"(t)); return t; }
__device__ __forceinline__ int bidx() { int b = (int)__builtin_amdgcn_workgroup_id_x(); asm volatile("" : "+s"(b)); return b; }

namespace pg8 {
#define PG8_LAS __attribute__((address_space(3)))
typedef unsigned short bf16_t;
typedef unsigned u32x4 __attribute__((ext_vector_type(4)));
constexpr int BM = 256, BK = 64, HALF = 128, HTB = HALF * BK * 2  , STAGE_BYTES = 8 * HTB, NXCD = 8, WGM = 8;

__host__ __device__ __forceinline__ int lds_byte(int r, int c) { const int st = (r >> 4) * 2 + (c >> 5), rr = r & 15, cc = c & 31, ob = rr * 64 + cc * 2; return st * 1024 + (ob ^ (((ob >> 9) & 1) << 5)); }
__host__ __device__ __forceinline__ void stage_rc(int b, int& R, int& C) { const int st = b / 1024, sb = b % 1024, swz = sb ^ (((sb >> 9) & 1) << 5); R = (st >> 1) * 16 + swz / 64; C = (st & 1) * 32 + (swz % 64) / 2; }
__host__ __device__ __forceinline__ int perm32(int rho) { const int n = rho >> 4, i = rho & 15; return 8 * (i >> 2) + 4 * n + (i & 3); }

struct Unit { int pm, pn; };
struct Gemm { const bf16_t* A; const bf16_t* Bt; int M, N, K; };

struct StaticOrder {
    int nM, nN, nwg, G, c;
    __host__ __device__ void init(int M, int N, int G_, int c_) { nM = M / BM; nN = N / BM; nwg = nM * nN; G = G_; c = c_; }
    __host__ __device__ bool next(int i, Unit& u) const {
        const long L = (long)i * G + c; if (L >= nwg) return false;
        int wgid = (int)L; { const int q = nwg / NXCD, r = nwg % NXCD, xcd = wgid % NXCD, off = wgid / NXCD; wgid = (xcd < r ? xcd * (q + 1) : r * (q + 1) + (xcd - r) * q) + off; }
        const int nig = WGM * nN, gid = wgid / nig, fm = gid * WGM, gsz = (nM - fm) < WGM ? (nM - fm) : WGM;
        u.pm = fm + ((wgid % nig) % gsz); u.pn = (wgid % nig) / gsz; return true;
    }
    __device__ __forceinline__ void a_ready(const Unit&) const {}
    __device__ __forceinline__ void done(const Unit&) const {}
};

template <class Epi, class Sched, bool STAMP = false>
__device__ __forceinline__ void gemm_phase(PG8_LAS unsigned char* lds, const Gemm g, const Sched& S, const Epi& E, unsigned long long* stamps) {
    const int tid = tidx(), wid = __builtin_amdgcn_readfirstlane(tid >> 6), lane = tid & 63, wr = wid >> 2, wc = wid & 3, fr = lane & 15, fq = lane >> 4;
    const int K = g.K, nt = K / BK;
    int ts_lo = 0, ts_hi = 0, nts = 0; const unsigned long long rt_entry = STAMP ? (unsigned long long)wall_clock64() : 0ull;
#define PG8_STAMP() do { if (STAMP && wid == 0 && nts < 64) { const unsigned long long _c = (unsigned long long)clock64(); \
        ts_lo = (lane == nts) ? (int)(unsigned)_c : ts_lo; ts_hi = (lane == nts) ? (int)(unsigned)(_c >> 32) : ts_hi; ++nts; } } while (0)
    PG8_STAMP();
    unsigned voffA[2], voffB[2];
#pragma unroll
    for (int i = 0; i < 2; ++i) { int R, C; stage_rc(tid * 16 + i * 8192, R, C); const int Rb = Epi::PERM ? ((R & ~31) + perm32(R & 31)) : R;
        voffA[i] = (unsigned)(R * K + C) * 2u; voffB[i] = (unsigned)(Rb * K + C) * 2u; }
    const size_t kstep = (size_t)(BK * 2);
    const size_t hstep = (size_t)HALF * K * 2;
    const size_t tstep = 2 * hstep;
    const unsigned ldsw = (unsigned)wid * 1024u;
    const int aoff = lds_byte(wr * 64 + fr, fq * 8), boff = lds_byte(wc * 32 + fr, fq * 8);
#define PG8_SA(b, h) (((b) * 2 + (h)) * HTB)
#define PG8_SB(b, h) ((4 + (b) * 2 + (h)) * HTB)
#define PG8_STAGE(bufoff, gbase, voff) do { _Pragma("unroll") for (int _i = 0; _i < 2; ++_i) \
        __builtin_amdgcn_global_load_lds((const unsigned*)((const char*)(gbase) + (voff)[_i]), (PG8_LAS unsigned*)(lds + (bufoff) + ldsw + _i * 8192), 16, 0, 0); } while (0)
#define PG8_LDA(dst, b, h) do { _Pragma("unroll") for (int m = 0; m < 4; ++m) _Pragma("unroll") for (int k = 0; k < 2; ++k) dst[m][k] = *(const PG8_LAS bf16x8*)(lds + PG8_SA(b, h) + aoff + m * 2048 + k * 1024); } while (0)
#define PG8_LDB(dst, b, h) do { _Pragma("unroll") for (int n = 0; n < 2; ++n) _Pragma("unroll") for (int k = 0; k < 2; ++k) dst[n][k] = *(const PG8_LAS bf16x8*)(lds + PG8_SB(b, h) + boff + n * 2048 + k * 1024); } while (0)
#define PG8_MMA(ai, bj, At, Bt) do { __builtin_amdgcn_s_setprio(1); _Pragma("unroll") for (int m = 0; m < 4; ++m) _Pragma("unroll") for (int n = 0; n < 2; ++n) _Pragma("unroll") for (int k = 0; k < 2; ++k) \
        acc[ai][bj][m][n] = __builtin_amdgcn_mfma_f32_16x16x32_bf16(Bt[n][k], At[m][k], acc[ai][bj][m][n], 0, 0, 0); __builtin_amdgcn_s_setprio(0); } while (0)
#define PG8_WAIT_V(n) asm volatile("s_waitcnt vmcnt(" #n ")" ::: "memory")
#define PG8_WAIT_L(n) asm volatile("s_waitcnt lgkmcnt(" #n ")" ::: "memory")
#define PG8_BAR __builtin_amdgcn_s_barrier()
#define PG8_SCHED __builtin_amdgcn_sched_barrier(0)
    Unit cur, nxt; int ui = 0;
    if (!S.next(0, cur)) return;
    f32x4 acc[2][2][4][2];
#pragma unroll
    for (int a = 0; a < 2; ++a)
#pragma unroll
        for (int b = 0; b < 2; ++b)
#pragma unroll
            for (int m = 0; m < 4; ++m)
#pragma unroll
                for (int n = 0; n < 2; ++n) acc[a][b][m][n] = (f32x4){0.f, 0.f, 0.f, 0.f};
    bf16x8 At[4][2], B0[2][2], B1[2][2];
    const char* cA = (const char*)g.A + (size_t)cur.pm * tstep; const char* cB = (const char*)g.Bt + (size_t)cur.pn * tstep;
    S.a_ready(cur);
    PG8_STAGE(PG8_SB(0, 0), cB, voffB); PG8_STAGE(PG8_SA(0, 0), cA, voffA); PG8_STAGE(PG8_SB(0, 1), cB + hstep, voffB); PG8_STAGE(PG8_SA(0, 1), cA + hstep, voffA);
    if (wr == 1) PG8_BAR;
    PG8_WAIT_V(4); PG8_BAR;
    PG8_STAGE(PG8_SB(1, 0), cB + kstep, voffB); PG8_STAGE(PG8_SA(1, 0), cA + kstep, voffA); PG8_STAGE(PG8_SB(1, 1), cB + hstep + kstep, voffB);
    PG8_WAIT_V(6); PG8_BAR;
    PG8_STAMP();
    for (;;) {
        const bool has_next = S.next(ui + 1, nxt);
        const char* nA = has_next ? (const char*)g.A + (size_t)nxt.pm * tstep : cA; const char* nB = has_next ? (const char*)g.Bt + (size_t)nxt.pn * tstep : cB;
        for (int t = 0; t < nt; t += 2) {
            const bool last = (t == nt - 2);
            const char* a1 = cA + (size_t)(t + 1) * kstep;
            const char* a2 = last ? nA : cA + (size_t)(t + 2) * kstep; const char* b2 = last ? nB : cB + (size_t)(t + 2) * kstep;
            const char* a3 = a2 + kstep; const char* b3 = b2 + kstep;
            if (last && has_next) S.a_ready(nxt);
            PG8_LDB(B0, 0, 0); PG8_SCHED; PG8_LDA(At, 0, 0); PG8_STAGE(PG8_SA(1, 1), a1 + hstep, voffA);
            PG8_WAIT_L(8); PG8_BAR; PG8_WAIT_L(0); PG8_MMA(0, 0, At, B0); PG8_BAR; PG8_SCHED;
            PG8_LDB(B1, 0, 1); PG8_STAGE(PG8_SB(0, 0), b2, voffB);
            PG8_BAR; PG8_WAIT_L(0); PG8_MMA(0, 1, At, B1); PG8_BAR;
            PG8_LDA(At, 0, 1); PG8_STAGE(PG8_SA(0, 0), a2, voffA);
            PG8_BAR; PG8_WAIT_L(0); PG8_MMA(1, 0, At, B0); PG8_BAR; PG8_SCHED;
            PG8_STAGE(PG8_SB(0, 1), b2 + hstep, voffB);
            PG8_WAIT_V(6); PG8_BAR; PG8_MMA(1, 1, At, B1); PG8_BAR;
            PG8_LDB(B0, 1, 0); PG8_SCHED; PG8_LDA(At, 1, 0); PG8_STAGE(PG8_SA(0, 1), a2 + hstep, voffA);
            PG8_WAIT_L(8); PG8_BAR; PG8_WAIT_L(0); PG8_MMA(0, 0, At, B0); PG8_BAR; PG8_SCHED;
            PG8_LDB(B1, 1, 1); PG8_STAGE(PG8_SB(1, 0), b3, voffB);
            PG8_BAR; PG8_WAIT_L(0); PG8_MMA(0, 1, At, B1); PG8_BAR;
            PG8_LDA(At, 1, 1); PG8_STAGE(PG8_SA(1, 0), a3, voffA);
            PG8_BAR; PG8_WAIT_L(0); PG8_MMA(1, 0, At, B0); PG8_BAR; PG8_SCHED;
            PG8_STAGE(PG8_SB(1, 1), b3 + hstep, voffB);
            PG8_WAIT_V(6); PG8_BAR; PG8_MMA(1, 1, At, B1); PG8_BAR;
        }
        PG8_STAMP();
        if constexpr (!Epi::AFTER_DRAIN) { E(acc, cur, wr, wc, fr, fq); S.done(cur); }
        PG8_STAMP();
        if (!has_next) break;
#pragma unroll
        for (int a = 0; a < 2; ++a)
#pragma unroll
            for (int b = 0; b < 2; ++b)
#pragma unroll
                for (int m = 0; m < 4; ++m)
#pragma unroll
                    for (int n = 0; n < 2; ++n) acc[a][b][m][n] = (f32x4){0.f, 0.f, 0.f, 0.f};
        cur = nxt; cA = nA; cB = nB; ++ui;
    }
    PG8_WAIT_V(0);
    if (wr == 0) PG8_BAR;
    PG8_BAR;
    if constexpr (Epi::AFTER_DRAIN) { E.fused(acc, cur, wr, wc, fr, fq, lds, wid, lane); S.done(cur); }
    PG8_STAMP();
    if (STAMP && wid == 0) { stamps[lane] = lane < nts ? (((unsigned long long)(unsigned)ts_hi << 32) | (unsigned)ts_lo) : 0ull;
        if (lane == 62) stamps[62] = rt_entry; if (lane == 63) stamps[63] = (unsigned long long)wall_clock64(); }
#undef PG8_STAMP
#undef PG8_SA
#undef PG8_SB
#undef PG8_STAGE
#undef PG8_LDA
#undef PG8_LDB
#undef PG8_MMA
#undef PG8_WAIT_V
#undef PG8_WAIT_L
#undef PG8_BAR
#undef PG8_SCHED
}
}

struct EpiP {
    static constexpr bool PERM = true, AFTER_DRAIN = false;
    u16* O;
    __device__ __forceinline__ void operator()(const f32x4 (&acc)[2][2][4][2], const pg8::Unit& u, int wr, int wc, int fr, int fq) const {
        const int row0 = u.pm * 256 + wr * 64 + fr, col0 = u.pn * 256 + wc * 32 + 8 * fq;
#pragma unroll
        for (int ai = 0; ai < 2; ++ai)
#pragma unroll
            for (int m = 0; m < 4; ++m) { u16* rowp = O + (size_t)(row0 + ai * 128 + m * 16) * LDP + col0;
#pragma unroll
                for (int bj = 0; bj < 2; ++bj) { const f32x4 v0 = acc[ai][bj][m][0], v1 = acc[ai][bj][m][1];
                    uint4 w; w.x = pk2(v0[0], v0[1]); w.y = pk2(v0[2], v0[3]); w.z = pk2(v1[0], v1[1]); w.w = pk2(v1[2], v1[3]);
                    *(uint4*)(rowp + bj * 128) = w; } }
    }
};
template <int MODE> struct EpiG2 {
    static constexpr bool PERM = true, AFTER_DRAIN = false;
    const u16* P; float* T1; u16* MG;
    __device__ __forceinline__ void operator()(const f32x4 (&acc)[2][2][4][2], const pg8::Unit& u, int wr, int wc, int fr, int fq) const {
        const int row0 = u.pm * 256 + wr * 64 + fr, col0 = u.pn * 256 + wc * 32 + 8 * fq;
#pragma unroll
        for (int ai = 0; ai < 2; ++ai)
#pragma unroll
            for (int m = 0; m < 4; ++m) { const size_t row = (size_t)(row0 + ai * 128 + m * 16);
#pragma unroll
                for (int bj = 0; bj < 2; ++bj) { const int col = col0 + bj * 128;
                    const uint4 g = *(const uint4*)(P + row * LDP + (MODE == 0 ? 8192 : 9216) + col);
                    const f32x4 v0 = acc[ai][bj][m][0], v1 = acc[ai][bj][m][1];
                    float r[8];
                    r[0] = sigmf(bflo(g.x)) * v0[0]; r[1] = sigmf(bfhi(g.x)) * v0[1]; r[2] = sigmf(bflo(g.y)) * v0[2]; r[3] = sigmf(bfhi(g.y)) * v0[3];
                    r[4] = sigmf(bflo(g.z)) * v1[0]; r[5] = sigmf(bfhi(g.z)) * v1[1]; r[6] = sigmf(bflo(g.w)) * v1[2]; r[7] = sigmf(bfhi(g.w)) * v1[3];
                    float* tp = T1 + row * 1024 + col;
                    if (MODE == 0) { *(float4*)tp = make_float4(r[0], r[1], r[2], r[3]); *(float4*)(tp + 4) = make_float4(r[4], r[5], r[6], r[7]); }
                    else { const float4 a = *(const float4*)tp, b = *(const float4*)(tp + 4);
                        uint4 w; w.x = pk2(a.x + r[0], a.y + r[1]); w.y = pk2(a.z + r[2], a.w + r[3]); w.z = pk2(b.x + r[4], b.y + r[5]); w.w = pk2(b.z + r[6], b.w + r[7]);
                        *(uint4*)(MG + row * 1024 + col) = w; } } }
    }
};
struct EpiG3 {
    static constexpr bool PERM = false, AFTER_DRAIN = false;
    float* X; const float* MODL;
    __device__ __forceinline__ void operator()(const f32x4 (&acc)[2][2][4][2], const pg8::Unit& u, int wr, int wc, int fr, int fq) const {
        const int row0 = u.pm * 256 + wr * 64 + fr, col0 = u.pn * 256 + wc * 32 + 4 * fq;
#pragma unroll
        for (int ai = 0; ai < 2; ++ai)
#pragma unroll
            for (int m = 0; m < 4; ++m) { const int row = row0 + ai * 128 + m * 16; const float* gp = MODL + seq_of(row) * 3072 + 2048;
#pragma unroll
                for (int bj = 0; bj < 2; ++bj)
#pragma unroll
                    for (int n = 0; n < 2; ++n) { const int col = col0 + bj * 128 + n * 16;
                        const float4 g = *(const float4*)(gp + col); float4* xp = (float4*)(X + (size_t)row * 1024 + col); float4 x = *xp; const f32x4 a = acc[ai][bj][m][n];
                        x.x += g.x * a[0]; x.y += g.y * a[1]; x.z += g.z * a[2]; x.w += g.w * a[3]; *xp = x; } }
    }
};

template <class Epi> __device__ __forceinline__ void run_gemm(unsigned char* lds, const u16* A, const u16* Bt, int M, int N, const Epi& E) {
    pg8::Gemm g; g.A = A; g.Bt = Bt; g.M = M; g.N = N; g.K = 1024;
    pg8::StaticOrder S; S.init(M, N, (int)gridDim.x, (int)bidx());
    pg8::gemm_phase<Epi, pg8::StaticOrder, false>((PG8_LAS unsigned char*)lds, g, S, E, nullptr);
}

__device__ __forceinline__ void phase_prep(const Params& p, unsigned char* lds) {
    float* ldsf = (float*)lds;
    const int tid = tidx(), nb = gridDim.x, bid = bidx(), wid = tid >> 6, lane = tid & 63;
    {
        const float4* xp = (const float4*)p.in[0]; const float4* xs = (const float4*)p.in[1];
        float4* X = (float4*)(p.ws + WS_X);
        const size_t n4p = (size_t)NPT * 256, n4 = (size_t)NTOK * 256;
        for (size_t i = (size_t)bid * 512 + tid; i < n4; i += (size_t)nb * 512) X[i] = i < n4p ? xp[i] : xs[i - n4p];
        float2* CS = (float2*)(p.ws + WS_CS);
        for (int i = bid * 512 + tid; i < 8192 * 32; i += nb * 512) {
            const int pos = i >> 5, d = i & 31;
            const float inv = powf(10000.0f, -(float)d / 32.0f);
            const float ang = (float)pos * inv;
            const float kf = rintf(ang * 0.636619772367581343f);
            float r = fmaf(-kf, 1.5707962512969971f, ang); r = fmaf(-kf, 7.5497894158615964e-08f, r); r = fmaf(-kf, 5.3903029534742384e-15f, r);
            const float sr = sinf(r), cr = cosf(r);
            const int q = ((int)kf) & 3;
            float s, c;
            if (q == 0) { s = sr; c = cr; } else if (q == 1) { s = cr; c = -sr; } else if (q == 2) { s = -sr; c = -cr; } else { s = -cr; c = sr; }
            CS[i] = make_float2(c, s);
        }
    }
    {
        const int NT_IN = LDP / 64, per_layer = (NT_IN + 48) * 16;
        for (int it = bid; it < 4 * per_layer; it += nb) {
            const int l = it / per_layer, r = it % per_layer, kt = r & 15; int ntile = r >> 4;
            const float* src; u16* dst; int ldn; bool is_in;
            if (ntile < NT_IN) { is_in = true; src = p.in[11] + (size_t)l * 1024 * 10256; ldn = 10256; dst = (u16*)(p.ws + WS_WTIN) + (size_t)l * LDP * 1024; }
            else { const int q = (ntile - NT_IN) >> 4; ntile = (ntile - NT_IN) & 15; is_in = false; src = p.in[18 + q] + (size_t)l * 1024 * 1024; ldn = 1024;
                   dst = (u16*)(p.ws + (q == 0 ? WS_WTPA : (q == 1 ? WS_WTPB : WS_WTOUT))) + (size_t)l * 1024 * 1024; }
            const int n0 = ntile * 64, k0 = kt * 64;
            __syncthreads();
#pragma unroll
            for (int i = 0; i < 8; ++i) {
                const int kk = (tid >> 6) + 8 * i, nn = tid & 63, np = n0 + nn; int sc = np;
                if (is_in) sc = np < 4096 ? np : (np < 10240 ? np + 16 : (np < 10256 ? np - 10240 + 4096 : -1));
                ldsf[kk * 65 + nn] = sc >= 0 ? src[(size_t)(k0 + kk) * ldn + sc] : 0.f;
            }
            __syncthreads();
#pragma unroll
            for (int i = 0; i < 4; ++i) {
                const int nn = (tid >> 5) + 16 * i, kk = 2 * (tid & 31);
                *(unsigned*)(dst + (size_t)(n0 + nn) * 1024 + k0 + kk) = pk2(ldsf[kk * 65 + nn], ldsf[(kk + 1) * 65 + nn]);
            }
        }
    }
    {
        __syncthreads();
        for (int i = tid; i < 18 * 1024; i += 512) ldsf[i] = i < 2048 ? p.in[2][i] : p.in[3][i - 2048];
        float* part = ldsf + 18432;
        float* MOD = (float*)(p.ws + WS_MOD);
        __syncthreads();
        for (int it = bid; it < 4 * 48; it += nb) {
            const int l = it / 48, j0 = (it % 48) * 64;
            const float* W = p.in[9] + (size_t)l * 1024 * 3072 + j0 + lane;
            float acc[18];
#pragma unroll
            for (int s = 0; s < 18; ++s) acc[s] = 0.f;
            for (int k = wid * 128; k < wid * 128 + 128; ++k) {
                const float w = W[(size_t)k * 3072];
#pragma unroll
                for (int s = 0; s < 18; ++s) acc[s] = fmaf(ldsf[s * 1024 + k], w, acc[s]);
            }
#pragma unroll
            for (int s = 0; s < 18; ++s) part[(wid * 18 + s) * 64 + lane] = acc[s];
            __syncthreads();
            for (int o = tid; o < 1152; o += 512) {
                const int s = o >> 6, j = o & 63; float v = p.in[10][l * 3072 + j0 + j];
#pragma unroll
                for (int w = 0; w < 8; ++w) v += part[(w * 18 + s) * 64 + j];
                MOD[(size_t)(l * 18 + s) * 3072 + j0 + j] = v;
            }
            __syncthreads();
        }
    }
}

__device__ __forceinline__ void phase_norm(const Params& p, int l) {
    const int wid = tidx() >> 6, lane = tidx() & 63;
    const float* X = (const float*)(p.ws + WS_X);
    const float* nw = p.in[8] + l * 1024;
    const float* MODL = (const float*)(p.ws + WS_MOD) + (size_t)l * 18 * 3072;
    u16* H = (u16*)(p.ws + WS_H);
    for (int tok = bidx() * 8 + wid; tok < NTOK; tok += gridDim.x * 8) {
        const float4* xr = (const float4*)(X + (size_t)tok * 1024);
        float4 v[4]; float ss = 0.f;
#pragma unroll
        for (int i = 0; i < 4; ++i) { v[i] = xr[lane + 64 * i]; ss += v[i].x * v[i].x + v[i].y * v[i].y + v[i].z * v[i].z + v[i].w * v[i].w; }
        ss = wave_sum(ss);
        const float rstd = rsqrtf(ss * (1.f / 1024.f) + EPSF);
        const float* ms = MODL + seq_of(tok) * 3072;
#pragma unroll
        for (int i = 0; i < 4; ++i) {
            const int c = (lane + 64 * i) * 4;
            const float4 w = *(const float4*)(nw + c), sh = *(const float4*)(ms + c), sc = *(const float4*)(ms + 1024 + c);
            const float h0 = v[i].x * rstd * w.x * (1.f + sc.x) + sh.x, h1 = v[i].y * rstd * w.y * (1.f + sc.y) + sh.y;
            const float h2 = v[i].z * rstd * w.z * (1.f + sc.z) + sh.z, h3 = v[i].w * rstd * w.w * (1.f + sc.w) + sh.w;
            *(uint2*)(H + (size_t)tok * 1024 + c) = make_uint2(pk2(h0, h1), pk2(h2, h3));
        }
    }
}

__device__ __forceinline__ void phase_post1(const Params& p, int l, unsigned char* lds) {
    const int tid = tidx(), wid = tid >> 6, lane = tid & 63, nb = gridDim.x, bid = bidx();
    const u16* P = (const u16*)(p.ws + WS_P);
    const int gw = bid * 8 + wid, nw = nb * 8;
    {
        const float* cw = p.in[12] + (size_t)l * 4 * 3072;
        for (int it = gw; it < 1056 * 24; it += nw) {
            const int tg = it / 24, slot = it % 24;
            const int tok0 = tg * 16, ch = slot * 128 + 2 * lane;
            const int t0 = tok0 < NPT ? (tok0 & 8191) : ((tok0 - NPT) & 31);
            float w0[4], w1[4];
#pragma unroll
            for (int j = 0; j < 4; ++j) { const float2 w = *(const float2*)(cw + j * 3072 + ch); w0[j] = w.x; w1[j] = w.y; }
            float a0[3], a1[3];
            if (t0 == 0) {
                if (tok0 < NPT) { for (int j = 0; j < 3; ++j) { a0[j] = 0.f; a1[j] = 0.f; } }
                else { const float* sc = p.in[7] + ((size_t)(l * 16 + ((tok0 - NPT) >> 5)) * 3) * 3072 + ch;
#pragma unroll
                    for (int j = 0; j < 3; ++j) { const float2 s = *(const float2*)(sc + j * 3072); a0[j] = s.x; a1[j] = s.y; } }
            } else {
#pragma unroll
                for (int j = 0; j < 3; ++j) { const unsigned u = *(const unsigned*)(P + (size_t)(tok0 - 3 + j) * LDP + ch); a0[j] = bflo(u); a1[j] = bfhi(u); }
            }
            u16* dst = (u16*)(p.ws + (slot < 8 ? WS_QA : (slot < 16 ? WS_KA : WS_VA))) + (slot & 7) * 128 + 2 * lane;
            const float post = slot < 8 ? 0.08838834764831845f : 1.f;
            for (int i = 0; i < 16; ++i) {
                const unsigned u = *(const unsigned*)(P + (size_t)(tok0 + i) * LDP + ch);
                const float c0 = bflo(u), c1 = bfhi(u);
                float y0 = w0[0] * a0[0] + w0[1] * a0[1] + w0[2] * a0[2] + w0[3] * c0;
                float y1 = w1[0] * a1[0] + w1[1] * a1[1] + w1[2] * a1[2] + w1[3] * c1;
                a0[0] = a0[1]; a0[1] = a0[2]; a0[2] = c0; a1[0] = a1[1]; a1[1] = a1[2]; a1[2] = c1;
                y0 = siluf(y0); y1 = siluf(y1);
                if (slot < 16) { const float ss = wave_sum(y0 * y0 + y1 * y1); const float sc = rsqrtf(ss + EPSF) * post; y0 *= sc; y1 *= sc; }
                *(unsigned*)(dst + (size_t)(tok0 + i) * 1024) = pk2(y0, y1);
            }
        }
    }
    for (int idx = bid * 512 + tid; idx < 18 * 9216; idx += nb * 512) {
        const int s = idx / 9216, r = idx % 9216, j = r / 3072, c = r % 3072;
        const int tok = s < 2 ? s * 8192 + 8189 + j : NPT + (s - 2) * 32 + 29 + j;
        const float v = bf2f(P[(size_t)tok * LDP + c]);
        if (s < 2) p.out[O_CONVP + ((size_t)(l * 2 + s) * 3 + j) * 3072 + c] = v;
        else p.out[O_CONVS + ((size_t)(l * 16 + s - 2) * 3 + j) * 3072 + c] = v;
    }
    {
        float* BETA = (float*)(p.ws + WS_BETA); float* GLOG = (float*)(p.ws + WS_GLOG);
        for (int idx = bid * 512 + tid; idx < NTOK * 8; idx += nb * 512) {
            const int tok = idx >> 3, h = idx & 7;
            const float ba = bf2f(P[(size_t)tok * LDP + 10240 + h]), aa = bf2f(P[(size_t)tok * LDP + 10248 + h]);
            BETA[idx] = sigmf(ba);
            const float x = aa + p.in[14][l * 8 + h];
            const float sp = fmaxf(x, 0.f) + log1pf(__expf(-fabsf(x)));
            GLOG[idx] = -__expf(p.in[13][l * 8 + h]) * sp;
        }
    }
    {
        const float2* CS = (const float2*)(p.ws + WS_CS);
        u16* QB = (u16*)(p.ws + WS_QB); u16* KB = (u16*)(p.ws + WS_KB);
        const int mq = lane >> 5, d = lane & 31;
        for (int it = gw; it < NTOK * 8; it += nw) {
            const int tok = it >> 3, h = it & 7;
            const float2 cs = CS[pos_of(tok) * 32 + d];
            const u16* pr = P + (size_t)tok * LDP;
            const int cb = h * 128 + mq * 64 + d;
            const float q1 = bf2f(pr[4096 + cb]), q2 = bf2f(pr[4096 + cb + 32]);
            const float k1 = bf2f(pr[5120 + cb]), k2 = bf2f(pr[5120 + cb + 32]);
            QB[(size_t)tok * 1024 + cb] = f2bf((q1 * cs.x - q2 * cs.y) * QSCALE);
            QB[(size_t)tok * 1024 + cb + 32] = f2bf((q1 * cs.y + q2 * cs.x) * QSCALE);
            const float ko1 = k1 * cs.x - k2 * cs.y, ko2 = k1 * cs.y + k2 * cs.x;
            KB[(size_t)tok * 1024 + cb] = f2bf(ko1); KB[(size_t)tok * 1024 + cb + 32] = f2bf(ko2);
            size_t orow;
            float* ko; float* vo;
            if (tok < NPT) { orow = ((size_t)(l * 2 + (tok >> 13)) * 8 + h) * 8192 + (tok & 8191); ko = p.out + O_KP; vo = p.out + O_VP; }
            else { const int r = tok - NPT; orow = ((size_t)(l * 16 + (r >> 5)) * 8 + h) * 32 + (r & 31); ko = p.out + O_KS; vo = p.out + O_VS; }
            ko[orow * 128 + mq * 64 + d] = ko1; ko[orow * 128 + mq * 64 + d + 32] = ko2;
            const unsigned vv = *(const unsigned*)(pr + 6144 + h * 128 + 2 * lane);
            *(float2*)(vo + orow * 128 + 2 * lane) = make_float2(bflo(vv), bfhi(vv));
        }
    }
    {
        u16* T = (u16*)lds;
        u16* VT = (u16*)(p.ws + WS_VT);
        for (int it = bid; it < 2048; it += nb) {
            const int tt = it & 127, h = (it >> 7) & 7, b = it >> 10;
            __syncthreads();
#pragma unroll
            for (int i = 0; i < 2; ++i) { const int pk = tid + 512 * i, row = pk >> 4, seg = pk & 15;
                *(uint4*)(T + row * 136 + seg * 8) = *(const uint4*)(P + (size_t)(b * 8192 + tt * 64 + row) * LDP + 6144 + h * 128 + seg * 8); }
            __syncthreads();
            const int c = tid & 127, tq = tid >> 7;
            unsigned w[8];
#pragma unroll
            for (int i = 0; i < 8; ++i) w[i] = (unsigned)T[(tq * 16 + 2 * i) * 136 + c] | ((unsigned)T[(tq * 16 + 2 * i + 1) * 136 + c] << 16);
            u16* o = VT + ((size_t)((b * 8 + h) * 128 + c)) * 8192 + tt * 64 + tq * 16;
            *(uint4*)o = make_uint4(w[0], w[1], w[2], w[3]); *(uint4*)(o + 8) = make_uint4(w[4], w[5], w[6], w[7]);
        }
    }
}

__device__ __forceinline__ void gdn_chunk_item(const Params& p, int item, unsigned char* lds) {
    const int tid = tidx(), wid = tid >> 6, lane = tid & 63, fr = lane & 15, fq = lane >> 4;
    const int ch = item >> 3, h = item & 7;
    const int tok0 = ch < 256 ? ch * 64 : NPT + (ch - 256) * 32, L = ch < 256 ? 64 : 32;
    u16* kT = (u16*)lds; u16* qT = kT + 64 * 136; u16* vT = qT + 64 * 136;
    float* AT = (float*)(lds + 52224); float* Gs = (float*)(lds + 69632); float* Bs = Gs + 64;
    __syncthreads();
#pragma unroll
    for (int i = 0; i < 6; ++i) {
        const int pk = tid + 512 * i, which = pk >> 10, row = (pk >> 4) & 63, seg = pk & 15;
        const size_t wso = which == 0 ? WS_KA : (which == 1 ? WS_QA : WS_VA);
        uint4 v = make_uint4(0, 0, 0, 0);
        if (row < L) v = *(const uint4*)((const u16*)(p.ws + wso) + (size_t)(tok0 + row) * 1024 + h * 128 + seg * 8);
        *(uint4*)(kT + which * 64 * 136 + row * 136 + seg * 8) = v;
    }
    if (wid == 0) {
        float g = lane < L ? ((const float*)(p.ws + WS_GLOG))[(size_t)(tok0 + lane) * 8 + h] : 0.f;
#pragma unroll
        for (int o = 1; o < 64; o <<= 1) { const float t = __shfl_up(g, o); if (lane >= o) g += t; }
        Gs[lane] = g;
        Bs[lane] = lane < L ? ((const float*)(p.ws + WS_BETA))[(size_t)(tok0 + lane) * 8 + h] : 0.f;
    }
    __syncthreads();
    u16* QKM = (u16*)(p.ws + WS_QKM) + (size_t)item * 4096;
#pragma unroll
    for (int u = 0; u < 4; ++u) {
        const int id = wid * 4 + u, which = id >> 4, ti = (id >> 2) & 3, tj = id & 3;
        f32x4 acc = {0.f, 0.f, 0.f, 0.f};
        const u16* Ab = (which ? qT : kT) + (ti * 16 + fr) * 136 + fq * 8;
        const u16* Bb = kT + (tj * 16 + fr) * 136 + fq * 8;
#pragma unroll
        for (int ks = 0; ks < 4; ++ks) acc = __builtin_amdgcn_mfma_f32_16x16x32_bf16(*(const bf16x8*)(Ab + ks * 32), *(const bf16x8*)(Bb + ks * 32), acc, 0, 0, 0);
        const int j = tj * 16 + fr; const float Gj = Gs[j];
#pragma unroll
        for (int r = 0; r < 4; ++r) {
            const int i = ti * 16 + 4 * fq + r; const float Gi = Gs[i];
            if (which == 0) AT[j * 68 + i] = (i > j) ? Bs[i] * acc[r] * __expf(Gi - Gj) : 0.f;
            else QKM[i * 64 + j] = f2bf((i >= j) ? acc[r] * __expf(Gi - Gj) : 0.f);
        }
    }
    __syncthreads();
    if (tid < 256) {
        const int c = tid; float r[64];
        if (c < 128) {
#pragma unroll
            for (int i = 0; i < 64; ++i) r[i] = Bs[i] * bf2f(vT[i * 136 + c]);
        } else {
#pragma unroll
            for (int i = 0; i < 64; ++i) r[i] = Bs[i] * __expf(Gs[i]) * bf2f(kT[i * 136 + c - 128]);
        }
        int zoff; asm volatile("v_mov_b32 %0, 0" : "=v"(zoff));
        const float* ATz = AT + zoff;
#pragma unroll
        for (int j = 0; j < 63; ++j) {
            const float xj = r[j];
#pragma unroll
            for (int i = j + 1; i < 64; ++i) r[i] = fmaf(-ATz[j * 68 + i], xj, r[i]);
        }
        if (c < 128) {
            u16* o = (u16*)(p.ws + WS_VNT) + (size_t)item * 8192 + c * 64;
#pragma unroll
            for (int i = 0; i < 8; ++i) *(uint4*)(o + 8 * i) = make_uint4(pk2(r[8 * i], r[8 * i + 1]), pk2(r[8 * i + 2], r[8 * i + 3]), pk2(r[8 * i + 4], r[8 * i + 5]), pk2(r[8 * i + 6], r[8 * i + 7]));
        } else {
            u16* o = (u16*)(p.ws + WS_KCUM) + (size_t)item * 8192 + (c - 128);
#pragma unroll
            for (int i = 0; i < 64; ++i) o[i * 128] = f2bf(r[i]);
        }
    } else {
        const int e = tid - 256;
        u16* QD = (u16*)(p.ws + WS_QD) + (size_t)item * 8192;
        u16* KDT = (u16*)(p.ws + WS_KDT) + (size_t)item * 8192;
        const float Gl = Gs[63];
#pragma unroll 4
        for (int k = 0; k < 16; ++k) {
            const int idx = e + 256 * k;
            { const int i = idx >> 6, dp = (idx & 63) * 2; const float s = __expf(Gs[i]);
              const unsigned u = *(const unsigned*)(qT + i * 136 + dp);
              *(unsigned*)(QD + i * 128 + dp) = pk2(bflo(u) * s, bfhi(u) * s); }
            { const int d = idx >> 5, jp = (idx & 31) * 2;
              const float v0 = bf2f(kT[jp * 136 + d]) * __expf(Gl - Gs[jp]), v1 = bf2f(kT[(jp + 1) * 136 + d]) * __expf(Gl - Gs[jp + 1]);
              *(unsigned*)(KDT + d * 64 + jp) = pk2(v0, v1); }
        }
        if (e == 0) ((float*)(p.ws + WS_GLAST))[item] = __expf(Gl);
    }
}

__device__ __forceinline__ bf16x8 ld2(const u16* a) {
    const uint2 x = *(const uint2*)a, y = *(const uint2*)(a + 16);
    typedef unsigned u32x4 __attribute__((ext_vector_type(4)));
    u32x4 w; w.x = x.x; w.y = x.y; w.z = y.x; w.w = y.y;
    return __builtin_bit_cast(bf16x8, w);
}
__device__ __forceinline__ bf16x8 pkfrag(const f32x4& a, const f32x4& b) {
    typedef unsigned u32x4 __attribute__((ext_vector_type(4)));
    u32x4 w; w.x = pk2(a[0], a[1]); w.y = pk2(a[2], a[3]); w.z = pk2(b[0], b[1]); w.w = pk2(b[2], b[3]);
    return __builtin_bit_cast(bf16x8, w);
}
__device__ __forceinline__ void gdn_scan_item(const Params& p, int l, int ch0, int nsteps, int h, int cb, const float* s_init, float* s_out, int L) {
    const int lane = tidx() & 63, fr = lane & 15, fq = lane >> 4, c = cb * 16 + fr;
    f32x4 S[8];
#pragma unroll
    for (int u = 0; u < 8; ++u)
#pragma unroll
        for (int r = 0; r < 4; ++r) S[u][r] = s_init ? s_init[(size_t)(16 * u + 4 * fq + r) * 128 + c] : 0.f;
    float* ORAW = (float*)(p.ws + WS_ORAW);
    for (int st = 0; st < nsteps; ++st) {
        const int ch = ch0 + st, item = ch * 8 + h;
        const int tok0 = ch < 256 ? ch * 64 : NPT + (ch - 256) * 32;
        const u16* kc = (const u16*)(p.ws + WS_KCUM) + (size_t)item * 8192 + fr * 128 + 4 * fq;
        const u16* qd = (const u16*)(p.ws + WS_QD) + (size_t)item * 8192 + fr * 128 + 4 * fq;
        const u16* kdt = (const u16*)(p.ws + WS_KDT) + (size_t)item * 8192 + fr * 64 + 4 * fq;
        const u16* qk = (const u16*)(p.ws + WS_QKM) + (size_t)item * 4096 + fr * 64 + 4 * fq;
        const u16* vnt = (const u16*)(p.ws + WS_VNT) + (size_t)item * 8192 + c * 64 + 4 * fq;
        const float gl = ((const float*)(p.ws + WS_GLAST))[item];
        bf16x8 sb[4];
#pragma unroll
        for (int ks = 0; ks < 4; ++ks) sb[ks] = pkfrag(S[2 * ks], S[2 * ks + 1]);
        f32x4 w[4];
#pragma unroll
        for (int t = 0; t < 4; ++t) {
            f32x4 acc = {0.f, 0.f, 0.f, 0.f};
#pragma unroll
            for (int ks = 0; ks < 4; ++ks) acc = __builtin_amdgcn_mfma_f32_16x16x32_bf16(ld2(kc + t * 16 * 128 + ks * 32), sb[ks], acc, 0, 0, 0);
            const uint2 vn = *(const uint2*)(vnt + 16 * t);
            w[t][0] = bflo(vn.x) - acc[0]; w[t][1] = bfhi(vn.x) - acc[1]; w[t][2] = bflo(vn.y) - acc[2]; w[t][3] = bfhi(vn.y) - acc[3];
        }
        bf16x8 wb[2];
        wb[0] = pkfrag(w[0], w[1]); wb[1] = pkfrag(w[2], w[3]);
#pragma unroll
        for (int t = 0; t < 4; ++t) {
            f32x4 acc = {0.f, 0.f, 0.f, 0.f};
#pragma unroll
            for (int ks = 0; ks < 4; ++ks) acc = __builtin_amdgcn_mfma_f32_16x16x32_bf16(ld2(qd + t * 16 * 128 + ks * 32), sb[ks], acc, 0, 0, 0);
#pragma unroll
            for (int k2 = 0; k2 < 2; ++k2) acc = __builtin_amdgcn_mfma_f32_16x16x32_bf16(ld2(qk + t * 16 * 64 + k2 * 32), wb[k2], acc, 0, 0, 0);
#pragma unroll
            for (int r = 0; r < 4; ++r) { const int row = 16 * t + 4 * fq + r; if (row < L) ORAW[(size_t)(tok0 + row) * 1024 + h * 128 + c] = acc[r]; }
        }
#pragma unroll
        for (int u = 0; u < 8; ++u) {
            f32x4 acc = S[u] * gl;
#pragma unroll
            for (int k2 = 0; k2 < 2; ++k2) acc = __builtin_amdgcn_mfma_f32_16x16x32_bf16(ld2(kdt + u * 16 * 64 + k2 * 32), wb[k2], acc, 0, 0, 0);
            S[u] = acc;
        }
    }
#pragma unroll
    for (int u = 0; u < 8; ++u)
#pragma unroll
        for (int r = 0; r < 4; ++r) s_out[(size_t)(16 * u + 4 * fq + r) * 128 + c] = S[u][r];
}
__device__ __forceinline__ void phase_scan(const Params& p, int l) {
    const int wid = __builtin_amdgcn_readfirstlane(tidx() >> 6), bid = bidx(), nb = gridDim.x;
    if (wid == 0) {
        for (int it = bid; it < 128; it += nb) {
            const int cb = it & 7, h = (it >> 3) & 7, b = it >> 6;
            gdn_scan_item(p, l, b * 128, 128, h, cb, nullptr, p.out + O_SSMP + ((size_t)(l * 2 + b) * 8 + h) * 16384, 64);
        }
    } else {
        for (int it = bid * 7 + (wid - 1); it < 1024; it += nb * 7) {
            const int cb = it & 7, h = (it >> 3) & 7, b = it >> 6;
            const size_t so = ((size_t)(l * 16 + b) * 8 + h) * 16384;
            gdn_scan_item(p, l, 256 + b, 1, h, cb, p.in[6] + so, p.out + O_SSMS + so, 32);
        }
    }
}

__device__ __forceinline__ void phase_post2(const Params& p, int l) {
    const int wid = tidx() >> 6, lane = tidx() & 63;
    const float* ORAW = (const float*)(p.ws + WS_ORAW); const u16* P = (const u16*)(p.ws + WS_P); u16* OAN = (u16*)(p.ws + WS_OAN);
    const float2 gw = *(const float2*)(p.in[15] + l * 128 + 2 * lane);
    for (int it = bidx() * 8 + wid; it < NTOK * 8; it += gridDim.x * 8) {
        const int tok = it >> 3, h = it & 7;
        const float2 o = *(const float2*)(ORAW + (size_t)tok * 1024 + h * 128 + 2 * lane);
        const float ss = wave_sum(o.x * o.x + o.y * o.y);
        const float rstd = rsqrtf(ss * (1.f / 128.f) + EPSF);
        const unsigned z = *(const unsigned*)(P + (size_t)tok * LDP + 3072 + h * 128 + 2 * lane);
        *(unsigned*)(OAN + (size_t)tok * 1024 + h * 128 + 2 * lane) = pk2(o.x * rstd * gw.x * siluf(bflo(z)), o.y * rstd * gw.y * siluf(bfhi(z)));
    }
}

__device__ __forceinline__ void phase_final(const Params& p) {
    const int wid = tidx() >> 6, lane = tidx() & 63;
    const float* X = (const float*)(p.ws + WS_X); const float* fw = p.in[21];
    for (int tok = bidx() * 8 + wid; tok < NTOK; tok += gridDim.x * 8) {
        const float4* xr = (const float4*)(X + (size_t)tok * 1024);
        float4 v[4]; float ss = 0.f;
#pragma unroll
        for (int i = 0; i < 4; ++i) { v[i] = xr[lane + 64 * i]; ss += v[i].x * v[i].x + v[i].y * v[i].y + v[i].z * v[i].z + v[i].w * v[i].w; }
        ss = wave_sum(ss);
        const float rstd = rsqrtf(ss * (1.f / 1024.f) + EPSF);
#pragma unroll
        for (int i = 0; i < 4; ++i) { const float4 w = ((const float4*)fw)[lane + 64 * i];
            ((float4*)(p.out + O_Y + (size_t)tok * 1024))[lane + 64 * i] = make_float4(v[i].x * rstd * w.x, v[i].y * rstd * w.y, v[i].z * rstd * w.z, v[i].w * rstd * w.w); }
    }
}

__device__ __forceinline__ float lam_of(const Params& p, int l, int lane) {
    const float* lq = p.in[16] + l * 256;
    const float a = wave_sum(lq[lane] * lq[64 + lane]), b = wave_sum(lq[128 + lane] * lq[192 + lane]);
    return __expf(a) - __expf(b) + lam_init_of(l);
}
__device__ __forceinline__ void attn_store(const Params& p, int l, int tok, int h, int hh, const f32x16 (&d)[4], float ss) {
    ss += __shfl_xor(ss, 32);
    const float sc = rsqrtf(ss * (1.f / 128.f) + EPSF) * (1.f - lam_init_of(l));
    const u16* zp = (const u16*)(p.ws + WS_P) + (size_t)tok * LDP + 7168 + h * 128;
    u16* op = (u16*)(p.ws + WS_OBN) + (size_t)tok * 1024 + h * 128;
    const float* dw = p.in[17] + l * 128;
#pragma unroll
    for (int t = 0; t < 4; ++t)
#pragma unroll
        for (int g = 0; g < 4; ++g) {
            const int vc = 32 * t + 8 * g + 4 * hh;
            const uint2 z = *(const uint2*)(zp + vc); const float4 w = *(const float4*)(dw + vc);
            const float o0 = d[t][4 * g] * sc * w.x * siluf(bflo(z.x)), o1 = d[t][4 * g + 1] * sc * w.y * siluf(bfhi(z.x));
            const float o2 = d[t][4 * g + 2] * sc * w.z * siluf(bflo(z.y)), o3 = d[t][4 * g + 3] * sc * w.w * siluf(bfhi(z.y));
            *(uint2*)(op + vc) = make_uint2(pk2(o0, o1), pk2(o2, o3));
        }
}

constexpr int AT_KPITCH = 272, AT_VPITCH = 136, AT_KBYTES = 64 * AT_KPITCH, AT_STAGE = AT_KBYTES + 128 * AT_VPITCH;

__device__ __forceinline__ void attn_prompt_item(const Params& p, int l, int b, int h, int qb, unsigned char* lds) {
    const int tid = tidx(), wid = __builtin_amdgcn_readfirstlane(tid >> 6), lane = tid & 63;
    const int m = wid & 1, rg = wid >> 1, ql = lane & 31, hh = lane >> 5;
    const int tokq = b * 8192 + qb * 128 + rg * 32 + ql;
    const u16* QB = (const u16*)(p.ws + WS_QB);
    bf16x8 qf[4];
#pragma unroll
    for (int s = 0; s < 4; ++s) qf[s] = *(const bf16x8*)(QB + (size_t)tokq * 1024 + h * 128 + m * 64 + 16 * s + 8 * hh);
    const int ntb = 2 * qb + 2, ntw = 2 * qb + 1 + (rg >> 1);
    f32x16 O[4];
#pragma unroll
    for (int t = 0; t < 4; ++t)
#pragma unroll
        for (int r = 0; r < 16; ++r) O[t][r] = 0.f;
    float mrun = -1e30f, lrun = 0.f;
    const u16* KBp = (const u16*)(p.ws + WS_KB) + (size_t)(b * 8192) * 1024 + h * 128;
    const u16* VTp = (const u16*)(p.ws + WS_VT) + (size_t)((b * 8 + h) * 128) * 8192;
    const int krow0 = tid >> 4, kseg = tid & 15;
    const int vrow0 = tid >> 3, vseg = tid & 7;
    uint4 kr[2], vr[2];
#define AT_LOAD(j) do { _Pragma("unroll") for (int i = 0; i < 2; ++i) { \
        kr[i] = *(const uint4*)(KBp + (size_t)((j) * 64 + krow0 + 32 * i) * 1024 + kseg * 8); \
        vr[i] = *(const uint4*)(VTp + (size_t)(vrow0 + 64 * i) * 8192 + (j) * 64 + vseg * 8); } } while (0)
#define AT_WRITE(st) do { unsigned char* kb = lds + (st) * AT_STAGE; unsigned char* vb = kb + AT_KBYTES; _Pragma("unroll") for (int i = 0; i < 2; ++i) { \
        *(uint4*)(kb + (krow0 + 32 * i) * AT_KPITCH + kseg * 16) = kr[i]; \
        *(uint2*)(vb + (vrow0 + 64 * i) * AT_VPITCH + vseg * 16) = make_uint2(vr[i].x, vr[i].y); \
        *(uint2*)(vb + (vrow0 + 64 * i) * AT_VPITCH + vseg * 16 + 8) = make_uint2(vr[i].z, vr[i].w); } } while (0)
    __syncthreads();
    AT_LOAD(0); AT_WRITE(0);
    __syncthreads();
    for (int j = 0; j < ntb; ++j) {
        if (j + 1 < ntb) AT_LOAD(j + 1);
        if (j < ntw) {
            const unsigned char* kb = lds + (j & 1) * AT_STAGE; const unsigned char* vb = kb + AT_KBYTES;
            f32x16 st[2];
#pragma unroll
            for (int kt = 0; kt < 2; ++kt) {
#pragma unroll
                for (int r = 0; r < 16; ++r) st[kt][r] = 0.f;
#pragma unroll
                for (int s = 0; s < 4; ++s) {
                    const bf16x8 a = *(const bf16x8*)(kb + (32 * kt + ql) * AT_KPITCH + m * 128 + s * 32 + hh * 16);
                    st[kt] = __builtin_amdgcn_mfma_f32_32x32x16_bf16(a, qf[s], st[kt], 0, 0, 0);
                }
            }
            float mx = st[0][0];
#pragma unroll
            for (int r = 1; r < 16; ++r) mx = fmaxf(mx, st[0][r]);
#pragma unroll
            for (int r = 0; r < 16; ++r) mx = fmaxf(mx, st[1][r]);
            mx = fmaxf(mx, __shfl_xor(mx, 32));
            const float mnew = fmaxf(mrun, mx), alpha = __builtin_amdgcn_exp2f(mrun - mnew);
            mrun = mnew; lrun *= alpha;
#pragma unroll
            for (int t = 0; t < 4; ++t) O[t] *= alpha;
            bf16x8 pf[2][2];
#pragma unroll
            for (int kt = 0; kt < 2; ++kt) {
                float e[16];
#pragma unroll
                for (int r = 0; r < 16; ++r) { e[r] = __builtin_amdgcn_exp2f(st[kt][r] - mnew); lrun += e[r]; }
#pragma unroll
                for (int s2 = 0; s2 < 2; ++s2) {
                    typedef unsigned u32x4 __attribute__((ext_vector_type(4)));
                    u32x4 w; w.x = pk2(e[8 * s2], e[8 * s2 + 1]); w.y = pk2(e[8 * s2 + 2], e[8 * s2 + 3]); w.z = pk2(e[8 * s2 + 4], e[8 * s2 + 5]); w.w = pk2(e[8 * s2 + 6], e[8 * s2 + 7]);
                    pf[kt][s2] = __builtin_bit_cast(bf16x8, w);
                }
            }
#pragma unroll
            for (int t = 0; t < 4; ++t)
#pragma unroll
                for (int kt = 0; kt < 2; ++kt)
#pragma unroll
                    for (int s2 = 0; s2 < 2; ++s2) {
                        const unsigned char* vp = vb + (32 * t + ql) * AT_VPITCH + (32 * kt + 16 * s2 + 4 * hh) * 2;
                        const uint2 x = *(const uint2*)vp, y = *(const uint2*)(vp + 16);
                        typedef unsigned u32x4 __attribute__((ext_vector_type(4)));
                        u32x4 w; w.x = x.x; w.y = x.y; w.z = y.x; w.w = y.y;
                        O[t] = __builtin_amdgcn_mfma_f32_32x32x16_bf16(__builtin_bit_cast(bf16x8, w), pf[kt][s2], O[t], 0, 0, 0);
                    }
        }
        if (j + 1 < ntb) AT_WRITE((j + 1) & 1);
        __syncthreads();
    }
#undef AT_LOAD
#undef AT_WRITE
    const float inv = 1.f / (lrun + __shfl_xor(lrun, 32));
    float* xb = (float*)lds + rg * 4096;
    if (m == 1) {
#pragma unroll
        for (int t = 0; t < 4; ++t)
#pragma unroll
            for (int r = 0; r < 16; ++r) xb[(t * 16 + r) * 64 + lane] = O[t][r] * inv;
    }
    __syncthreads();
    if (m == 0) {
        const float lam = lam_of(p, l, lane);
        float ss = 0.f;
#pragma unroll
        for (int t = 0; t < 4; ++t)
#pragma unroll
            for (int r = 0; r < 16; ++r) { const float d = O[t][r] * inv - lam * xb[(t * 16 + r) * 64 + lane]; O[t][r] = d; ss += d * d; }
        attn_store(p, l, tokq, h, hh, O, ss);
    }
}

__device__ __forceinline__ void attn_sample_item(const Params& p, int l, int b, int h, unsigned char* lds) {
    const int tid = tidx(), wid = __builtin_amdgcn_readfirstlane(tid >> 6), lane = tid & 63, ql = lane & 31, hh = lane >> 5;
    const int t = wid & 3, kh = wid >> 2;
    const int tok0 = NPT + b * 32, tokq = tok0 + ql;
    const u16* QB = (const u16*)(p.ws + WS_QB); const u16* KB = (const u16*)(p.ws + WS_KB); const u16* P = (const u16*)(p.ws + WS_P);
    const float* CK = p.in[4] + ((size_t)(l * 16 + b) * 8 + h) * 1024 * 128;
    const float* CV = p.in[5] + ((size_t)(l * 16 + b) * 8 + h) * 1024 * 128;
    float* xo = (float*)lds;
    float* xss = (float*)(lds + 32768);
    typedef unsigned u32x4 __attribute__((ext_vector_type(4)));
    f32x16 O1;
#pragma unroll
    for (int r = 0; r < 16; ++r) O1[r] = 0.f;
    f32x16 O;
    __syncthreads();
    for (int m = 0; m < 2; ++m) {
        bf16x8 qf[4];
#pragma unroll
        for (int s = 0; s < 4; ++s) qf[s] = *(const bf16x8*)(QB + (size_t)tokq * 1024 + h * 128 + m * 64 + 16 * s + 8 * hh);
#pragma unroll
        for (int r = 0; r < 16; ++r) O[r] = 0.f;
        float mrun = -1e30f, lrun = 0.f;
        const int kt0 = kh ? 17 : 0, kt1 = kh ? 33 : 17;
        for (int kt = kt0; kt < kt1; ++kt) {
            f32x16 st;
#pragma unroll
            for (int r = 0; r < 16; ++r) st[r] = 0.f;
            if (kt < 32) {
                const float* kp = CK + (size_t)(kt * 32 + ql) * 128 + m * 64 + 8 * hh;
#pragma unroll
                for (int s = 0; s < 4; ++s) {
                    const float4 x = *(const float4*)(kp + 16 * s), y = *(const float4*)(kp + 16 * s + 4);
                    u32x4 w; w.x = pk2(x.x, x.y); w.y = pk2(x.z, x.w); w.z = pk2(y.x, y.y); w.w = pk2(y.z, y.w);
                    st = __builtin_amdgcn_mfma_f32_32x32x16_bf16(__builtin_bit_cast(bf16x8, w), qf[s], st, 0, 0, 0);
                }
            } else {
                const u16* kp = KB + (size_t)(tok0 + ql) * 1024 + h * 128 + m * 64 + 8 * hh;
#pragma unroll
                for (int s = 0; s < 4; ++s) st = __builtin_amdgcn_mfma_f32_32x32x16_bf16(*(const bf16x8*)(kp + 16 * s), qf[s], st, 0, 0, 0);
            }
            float mx = st[0];
#pragma unroll
            for (int r = 1; r < 16; ++r) mx = fmaxf(mx, st[r]);
            mx = fmaxf(mx, __shfl_xor(mx, 32));
            const float mnew = fmaxf(mrun, mx), alpha = __builtin_amdgcn_exp2f(mrun - mnew);
            mrun = mnew; lrun *= alpha;
            O *= alpha;
            float e[16];
#pragma unroll
            for (int r = 0; r < 16; ++r) { e[r] = __builtin_amdgcn_exp2f(st[r] - mnew); lrun += e[r]; }
#pragma unroll
            for (int s2 = 0; s2 < 2; ++s2) {
                u32x4 pw; pw.x = pk2(e[8 * s2], e[8 * s2 + 1]); pw.y = pk2(e[8 * s2 + 2], e[8 * s2 + 3]); pw.z = pk2(e[8 * s2 + 4], e[8 * s2 + 5]); pw.w = pk2(e[8 * s2 + 6], e[8 * s2 + 7]);
                float v[8];
                if (kt < 32) {
                    const float* vp = CV + (size_t)(kt * 32 + 16 * s2 + 4 * hh) * 128 + 32 * t + ql;
#pragma unroll
                    for (int i = 0; i < 4; ++i) { v[i] = vp[i * 128]; v[4 + i] = vp[(8 + i) * 128]; }
                } else {
                    const u16* vp = P + (size_t)(tok0 + 16 * s2 + 4 * hh) * LDP + 6144 + h * 128 + 32 * t + ql;
#pragma unroll
                    for (int i = 0; i < 4; ++i) { v[i] = bf2f(vp[(size_t)i * LDP]); v[4 + i] = bf2f(vp[(size_t)(8 + i) * LDP]); }
                }
                u32x4 w; w.x = pk2(v[0], v[1]); w.y = pk2(v[2], v[3]); w.z = pk2(v[4], v[5]); w.w = pk2(v[6], v[7]);
                O = __builtin_amdgcn_mfma_f32_32x32x16_bf16(__builtin_bit_cast(bf16x8, w), __builtin_bit_cast(bf16x8, pw), O, 0, 0, 0);
            }
        }
        float* sl = xo + t * 1152;
        if (kh == 1) {
#pragma unroll
            for (int r = 0; r < 16; ++r) sl[r * 64 + lane] = O[r];
            sl[1024 + lane] = mrun; sl[1088 + lane] = lrun;
        }
        __syncthreads();
        if (kh == 0) {
            const float mo = sl[1024 + lane], lo = sl[1088 + lane];
            const float mnew = fmaxf(mrun, mo), a = __builtin_amdgcn_exp2f(mrun - mnew), ao = __builtin_amdgcn_exp2f(mo - mnew);
            lrun = lrun * a + lo * ao;
            const float inv = 1.f / (lrun + __shfl_xor(lrun, 32));
#pragma unroll
            for (int r = 0; r < 16; ++r) O[r] = (O[r] * a + sl[r * 64 + lane] * ao) * inv;
            if (m == 0) O1 = O;
        }
        __syncthreads();
    }
    float ss = 0.f;
    if (kh == 0) {
        const float lam = lam_of(p, l, lane);
#pragma unroll
        for (int r = 0; r < 16; ++r) { const float d = O1[r] - lam * O[r]; O[r] = d; ss += d * d; }
        ss += __shfl_xor(ss, 32);
        if (hh == 0) xss[t * 32 + ql] = ss;
    }
    __syncthreads();
    if (kh == 0) {
        const float tot = xss[ql] + xss[32 + ql] + xss[64 + ql] + xss[96 + ql];
        const float sc = rsqrtf(tot * (1.f / 128.f) + EPSF) * (1.f - lam_init_of(l));
        const u16* zp = (const u16*)(p.ws + WS_P) + (size_t)tokq * LDP + 7168 + h * 128;
        u16* op = (u16*)(p.ws + WS_OBN) + (size_t)tokq * 1024 + h * 128;
        const float* dw = p.in[17] + l * 128;
#pragma unroll
        for (int g = 0; g < 4; ++g) {
            const int vc = 32 * t + 8 * g + 4 * hh;
            const uint2 z = *(const uint2*)(zp + vc); const float4 w = *(const float4*)(dw + vc);
            const float o0 = O[4 * g] * sc * w.x * siluf(bflo(z.x)), o1 = O[4 * g + 1] * sc * w.y * siluf(bfhi(z.x));
            const float o2 = O[4 * g + 2] * sc * w.z * siluf(bflo(z.y)), o3 = O[4 * g + 3] * sc * w.w * siluf(bfhi(z.y));
            *(uint2*)(op + vc) = make_uint2(pk2(o0, o1), pk2(o2, o3));
        }
    }
}

__device__ __forceinline__ void phase_cat(const Params& p, int l, unsigned char* lds) {
    const int bid = bidx(), nb = gridDim.x;
#ifndef SUB
#define SUB 7
#endif
    if (SUB & 1) for (int it = bid; it < NITEM; it += nb) gdn_chunk_item(p, it, lds);
    if (SUB & 2) for (int it = (bid + nb / 2) % nb; it < 128; it += nb) attn_sample_item(p, l, it >> 3, it & 7, lds);
    if (SUB & 4) for (int i = bid; i < 1024; i += nb) {
        const int bh = i & 15, q = i >> 4, j = q & 15, r = q >> 4;
        const int qb = r == 0 ? j : (r == 1 ? 63 - j : (r == 2 ? 16 + j : 47 - j));
        attn_prompt_item(p, l, bh >> 3, bh & 7, qb, lds);
    }
}

__global__ void __launch_bounds__(512, 2) fwd_kernel(Params p) {
    extern __shared__ __attribute__((aligned(16))) unsigned char lds[];
    cg::grid_group grid = cg::this_grid();
    for (int ph = p.ph_lo; ph < p.ph_hi; ++ph) {
#ifndef ONLY
#define ONLY -1
#endif
#define EN(k) (ONLY < 0 || ONLY == (k))
        if (ph == 0) { if (EN(0)) phase_prep(p, lds); }
        else if (ph == 33) { if (EN(9)) phase_final(p); }
        else {
            const int l = (ph - 1) >> 3, k = (ph - 1) & 7;
            const u16* WTIN = (const u16*)(p.ws + WS_WTIN) + (size_t)l * LDP * 1024;
            if (k == 0) { if (EN(1)) phase_norm(p, l); }
            else if (k == 1) { if (EN(2)) { EpiP E; E.O = (u16*)(p.ws + WS_P); run_gemm(lds, (const u16*)(p.ws + WS_H), WTIN, NTOK, LDP, E); } }
            else if (k == 2) { if (EN(3)) phase_post1(p, l, lds); }
            else if (k == 3) { if (EN(4)) phase_cat(p, l, lds); }
            else if (k == 4) { if (EN(5)) phase_scan(p, l); }
            else if (k == 5) { if (EN(6)) phase_post2(p, l); }
            else if (k == 6) { if (EN(7)) {
                EpiG2<0> E0; E0.P = (const u16*)(p.ws + WS_P); E0.T1 = (float*)(p.ws + WS_T1); E0.MG = (u16*)(p.ws + WS_MERGED);
                run_gemm(lds, (const u16*)(p.ws + WS_OAN), (const u16*)(p.ws + WS_WTPA) + (size_t)l * 1048576, NTOK, 1024, E0);
                __syncthreads();
                EpiG2<1> E1; E1.P = E0.P; E1.T1 = E0.T1; E1.MG = E0.MG;
                run_gemm(lds, (const u16*)(p.ws + WS_OBN), (const u16*)(p.ws + WS_WTPB) + (size_t)l * 1048576, NTOK, 1024, E1); }
            } else if (EN(8)) {
                EpiG3 E; E.X = (float*)(p.ws + WS_X); E.MODL = (const float*)(p.ws + WS_MOD) + (size_t)l * 18 * 3072;
                run_gemm(lds, (const u16*)(p.ws + WS_MERGED), (const u16*)(p.ws + WS_WTOUT) + (size_t)l * 1048576, NTOK, 1024, E);
            }
        }
        if (ph + 1 < p.ph_hi) grid.sync();
    }
}

#ifndef MEGA
#define MEGA 0
#endif
extern "C" void kernel_launch(void* const* d_in, const int* in_sizes, int n_in, void* d_out, int out_size, void* d_ws, size_t ws_size, hipStream_t stream) {
    static int grid = 0;
    if (grid == 0) {
        int dev = 0, cus = 0;
        hipGetDevice(&dev);
        hipDeviceGetAttribute(&cus, hipDeviceAttributeMultiprocessorCount, dev);
        if (hipFuncSetAttribute((const void*)fwd_kernel, hipFuncAttributeMaxDynamicSharedMemorySize, LDS_BYTES) != hipSuccess) fprintf(stderr, "hipFuncSetAttribute failed\n");
        int per_cu = 0;
        hipOccupancyMaxActiveBlocksPerMultiprocessor(&per_cu, (const void*)fwd_kernel, 512, LDS_BYTES);
        if (per_cu < 1) fprintf(stderr, "occupancy query says %d blocks per CU\n", per_cu);
        (void)hipGetLastError();
        grid = cus > 0 ? cus : 256;
        if (ws_size < WS_END) fprintf(stderr, "workspace too small: %zu < %zu\n", ws_size, (size_t)WS_END);
    }
    Params p{};
    for (int i = 0; i < 22; ++i) p.in[i] = (const float*)d_in[i];
    p.out = (float*)d_out; p.ws = (unsigned char*)d_ws;
#if MEGA
    p.ph_lo = 0; p.ph_hi = 34;
    void* args[] = {&p};
    hipError_t e = hipLaunchCooperativeKernel((const void*)fwd_kernel, dim3(grid), dim3(512), args, LDS_BYTES, stream);
    if (e != hipSuccess) fprintf(stderr, "cooperative launch failed: %s (grid %d)\n", hipGetErrorString(e), grid);
#else
    for (int ph = 0; ph < 34; ++ph) {
        p.ph_lo = ph; p.ph_hi = ph + 1;
        hipLaunchKernelGGL(fwd_kernel, dim3(grid), dim3(512), LDS_BYTES, stream, p);
    }
#endif
}
```

```cpp
#include <hip/hip_runtime.h>
#include <hip/hip_cooperative_groups.h>
#include <cstdio>
namespace cg = cooperative_groups;

typedef unsigned short u16;

constexpr int DM = 1024, NPT = 16384, NTOK = 16896, SEQ = 8192, LDP = 10496;
constexpr float EPSF = 1e-6f;
constexpr float QSCALE = 0.125f * 1.44269504088896340736f;

constexpr size_t O_Y = 0, O_KP = 17301504, O_VP = 84410368, O_SSMP = 151519232, O_CONVP = 152567808,
                 O_KS = 152641536, O_VS = 154738688, O_SSMS = 156835840, O_CONVS = 165224448;

constexpr size_t SZ_TOKBF = (size_t)NTOK * 1024 * 2;
constexpr size_t WS_WTIN = 0;
constexpr size_t WS_WTPA = WS_WTIN + (size_t)4 * LDP * 1024 * 2;
constexpr size_t WS_WTPB = WS_WTPA + (size_t)4 * 1024 * 1024 * 2;
constexpr size_t WS_WTOUT = WS_WTPB + (size_t)4 * 1024 * 1024 * 2;
constexpr size_t WS_MOD = WS_WTOUT + (size_t)4 * 1024 * 1024 * 2;
constexpr size_t WS_CS = WS_MOD + (size_t)4 * 18 * 3072 * 4;
constexpr size_t WS_X = WS_CS + (size_t)8192 * 32 * 8;
constexpr size_t WS_P = WS_X + (size_t)NTOK * 1024 * 4;
constexpr size_t WS_BETA = WS_P + (size_t)NTOK * LDP * 2;
constexpr size_t WS_GLOG = WS_BETA + (size_t)NTOK * 8 * 4;
constexpr size_t WS_R1 = WS_GLOG + (size_t)NTOK * 8 * 4;
constexpr size_t WS_QA = WS_R1, WS_KA = WS_R1 + SZ_TOKBF, WS_VA = WS_R1 + 2 * SZ_TOKBF;
constexpr size_t WS_T1 = WS_R1, WS_MERGED = WS_R1 + 2 * SZ_TOKBF;
constexpr size_t WS_QB = WS_R1 + 3 * SZ_TOKBF;
constexpr size_t WS_OAN = WS_QB;
constexpr size_t WS_KB = WS_QB + SZ_TOKBF;
constexpr size_t WS_VT = WS_KB + SZ_TOKBF;
constexpr int NITEM = 2176;
constexpr size_t WS_VNT = WS_VT + (size_t)2 * 8 * 128 * 8192 * 2;
constexpr size_t WS_KCUM = WS_VNT + (size_t)NITEM * 16384;
constexpr size_t WS_QD = WS_KCUM + (size_t)NITEM * 16384;
constexpr size_t WS_KDT = WS_QD + (size_t)NITEM * 16384;
constexpr size_t WS_QKM = WS_KDT + (size_t)NITEM * 16384;
constexpr size_t WS_GLAST = WS_QKM + (size_t)NITEM * 8192;
constexpr size_t WS_ORAW = WS_GLAST + 16384;
constexpr size_t WS_H = WS_ORAW;
constexpr size_t WS_OBN = WS_ORAW + (size_t)NTOK * 1024 * 4;
constexpr size_t WS_BAR = WS_OBN + SZ_TOKBF;
constexpr size_t WS_END = WS_BAR + 16384;
static_assert(WS_END <= (size_t)1073741824, "workspace too large");
static_assert(WS_P % 256 == 0 && WS_R1 % 256 == 0 && WS_VNT % 256 == 0 && WS_ORAW % 256 == 0 && WS_OBN % 256 == 0, "align");

constexpr int LDS_BYTES = 147456;

struct Params {
    const float* in[22];
    float* out;
    unsigned char* ws;
    int ph_lo, ph_hi;
};

typedef short bf16x8 __attribute__((ext_vector_type(8)));
typedef float f32x4 __attribute__((ext_vector_type(4)));
typedef float f32x16 __attribute__((ext_vector_type(16)));

__device__ __forceinline__ float bf2f(u16 b) { return __uint_as_float(((unsigned)b) << 16); }
__device__ __forceinline__ float bflo(unsigned w) { return __uint_as_float(w << 16); }
__device__ __forceinline__ float bfhi(unsigned w) { return __uint_as_float(w & 0xffff0000u); }
__device__ __forceinline__ unsigned pk2(float lo, float hi) { unsigned r; asm("v_cvt_pk_bf16_f32 %0, %1, %2" : "=v"(r) : "v"(lo), "v"(hi)); return r; }
__device__ __forceinline__ u16 f2bf(float f) { return (u16)(pk2(f, 0.f) & 0xffffu); }
__device__ __forceinline__ float wave_sum(float v) {
#pragma unroll
    for (int o = 32; o; o >>= 1) v += __shfl_xor(v, o);
    return v;
}
__device__ __forceinline__ float siluf(float x) { return x / (1.f + __expf(-x)); }
__device__ __forceinline__ float sigmf(float x) { return 1.f / (1.f + __expf(-x)); }
__device__ __forceinline__ int seq_of(int tok) { return tok < NPT ? (tok >> 13) : 2 + ((tok - NPT) >> 5); }
__device__ __forceinline__ int pos_of(int tok) { return tok < NPT ? (tok & 8191) : 1024 + ((tok - NPT) & 31); }
__device__ __forceinline__ float lam_init_of(int l) { return 0.8f - 0.6f * __expf(-0.3f * (float)l); }

__device__ __forceinline__ int tidx() { int t = (int)__builtin_amdgcn_workitem_id_x(); asm volatile("" : "+v"(t)); return t; }
__device__ __forceinline__ int bidx() { int b = (int)__builtin_amdgcn_workgroup_id_x(); asm volatile("" : "+s"(b)); return b; }

__device__ __forceinline__ int permk(int x) { const int e = x & 31, q = e >> 2; return (x & ~31) | ((q < 4 ? 2 * q : 2 * (q - 4) + 1) << 2) | (e & 3); }

namespace pg8 {
#define PG8_LAS __attribute__((address_space(3)))
typedef unsigned short bf16_t;
typedef unsigned u32x4 __attribute__((ext_vector_type(4)));
constexpr int BM = 256, BK = 64, HALF = 128, HTB = HALF * BK * 2  , STAGE_BYTES = 8 * HTB, NXCD = 8, WGM = 8;

__host__ __device__ __forceinline__ int lds_byte(int r, int c) { const int st = (r >> 4) * 2 + (c >> 5), rr = r & 15, cc = c & 31, ob = rr * 64 + cc * 2; return st * 1024 + (ob ^ (((ob >> 9) & 1) << 5)); }
__host__ __device__ __forceinline__ void stage_rc(int b, int& R, int& C) { const int st = b / 1024, sb = b % 1024, swz = sb ^ (((sb >> 9) & 1) << 5); R = (st >> 1) * 16 + swz / 64; C = (st & 1) * 32 + (swz % 64) / 2; }
__host__ __device__ __forceinline__ int perm32(int rho) { const int n = rho >> 4, i = rho & 15; return 8 * (i >> 2) + 4 * n + (i & 3); }

struct Unit { int pm, pn; };
struct Gemm { const bf16_t* A; const bf16_t* Bt; int M, N, K; };

struct StaticOrder {
    int nM, nN, nwg, G, c;
    __host__ __device__ void init(int M, int N, int G_, int c_) { nM = M / BM; nN = N / BM; nwg = nM * nN; G = G_; c = c_; }
    __host__ __device__ bool next(int i, Unit& u) const {
        const long L = (long)i * G + c; if (L >= nwg) return false;
        int wgid = (int)L; { const int q = nwg / NXCD, r = nwg % NXCD, xcd = wgid % NXCD, off = wgid / NXCD; wgid = (xcd < r ? xcd * (q + 1) : r * (q + 1) + (xcd - r) * q) + off; }
        const int nig = WGM * nN, gid = wgid / nig, fm = gid * WGM, gsz = (nM - fm) < WGM ? (nM - fm) : WGM;
        u.pm = fm + ((wgid % nig) % gsz); u.pn = (wgid % nig) / gsz; return true;
    }
    __device__ __forceinline__ void a_ready(const Unit&) const {}
    __device__ __forceinline__ void done(const Unit&) const {}
};

template <class Epi, class Sched, bool STAMP = false>
__device__ __forceinline__ void gemm_phase(PG8_LAS unsigned char* lds, const Gemm g, const Sched& S, const Epi& E, unsigned long long* stamps) {
    const int tid = tidx(), wid = __builtin_amdgcn_readfirstlane(tid >> 6), lane = tid & 63, wr = wid >> 2, wc = wid & 3, fr = lane & 15, fq = lane >> 4;
    const int K = g.K, nt = K / BK;
    int ts_lo = 0, ts_hi = 0, nts = 0; const unsigned long long rt_entry = STAMP ? (unsigned long long)wall_clock64() : 0ull;
#define PG8_STAMP() do { if (STAMP && wid == 0 && nts < 64) { const unsigned long long _c = (unsigned long long)clock64(); \
        ts_lo = (lane == nts) ? (int)(unsigned)_c : ts_lo; ts_hi = (lane == nts) ? (int)(unsigned)(_c >> 32) : ts_hi; ++nts; } } while (0)
    PG8_STAMP();
    unsigned voffA[2], voffB[2];
#pragma unroll
    for (int i = 0; i < 2; ++i) { int R, C; stage_rc(tid * 16 + i * 8192, R, C); const int Rb = Epi::PERM ? ((R & ~31) + perm32(R & 31)) : R;
        voffA[i] = (unsigned)(R * K + C) * 2u; voffB[i] = (unsigned)(Rb * K + C) * 2u; }
    const size_t kstep = (size_t)(BK * 2);
    const size_t hstep = (size_t)HALF * K * 2;
    const size_t tstep = 2 * hstep;
    const unsigned ldsw = (unsigned)wid * 1024u;
    const int aoff = lds_byte(wr * 64 + fr, fq * 8), boff = lds_byte(wc * 32 + fr, fq * 8);
#define PG8_SA(b, h) (((b) * 2 + (h)) * HTB)
#define PG8_SB(b, h) ((4 + (b) * 2 + (h)) * HTB)
#define PG8_STAGE(bufoff, gbase, voff) do { _Pragma("unroll") for (int _i = 0; _i < 2; ++_i) \
        __builtin_amdgcn_global_load_lds((const unsigned*)((const char*)(gbase) + (voff)[_i]), (PG8_LAS unsigned*)(lds + (bufoff) + ldsw + _i * 8192), 16, 0, 0); } while (0)
#define PG8_LDA(dst, b, h) do { _Pragma("unroll") for (int m = 0; m < 4; ++m) _Pragma("unroll") for (int k = 0; k < 2; ++k) dst[m][k] = *(const PG8_LAS bf16x8*)(lds + PG8_SA(b, h) + aoff + m * 2048 + k * 1024); } while (0)
#define PG8_LDB(dst, b, h) do { _Pragma("unroll") for (int n = 0; n < 2; ++n) _Pragma("unroll") for (int k = 0; k < 2; ++k) dst[n][k] = *(const PG8_LAS bf16x8*)(lds + PG8_SB(b, h) + boff + n * 2048 + k * 1024); } while (0)
#define PG8_MMA(ai, bj, At, Bt) do { __builtin_amdgcn_s_setprio(1); _Pragma("unroll") for (int k = 0; k < 2; ++k) _Pragma("unroll") for (int m = 0; m < 4; ++m) _Pragma("unroll") for (int n = 0; n < 2; ++n) \
        acc[ai][bj][m][n] = __builtin_amdgcn_mfma_f32_16x16x32_bf16(Bt[n][k], At[m][k], acc[ai][bj][m][n], 0, 0, 0); __builtin_amdgcn_s_setprio(0); } while (0)
#define PG8_WAIT_V(n) asm volatile("s_waitcnt vmcnt(" #n ")" ::: "memory")
#define PG8_WAIT_L(n) asm volatile("s_waitcnt lgkmcnt(" #n ")" ::: "memory")
#define PG8_BAR __builtin_amdgcn_s_barrier()
#define PG8_SCHED __builtin_amdgcn_sched_barrier(0)
    Unit cur, nxt; int ui = 0;
    if (!S.next(0, cur)) return;
    f32x4 acc[2][2][4][2];
#pragma unroll
    for (int a = 0; a < 2; ++a)
#pragma unroll
        for (int b = 0; b < 2; ++b)
#pragma unroll
            for (int m = 0; m < 4; ++m)
#pragma unroll
                for (int n = 0; n < 2; ++n) acc[a][b][m][n] = (f32x4){0.f, 0.f, 0.f, 0.f};
    bf16x8 At[4][2], B0[2][2], B1[2][2];
    const char* cA = (const char*)g.A + (size_t)cur.pm * tstep; const char* cB = (const char*)g.Bt + (size_t)cur.pn * tstep;
    S.a_ready(cur);
    PG8_STAGE(PG8_SB(0, 0), cB, voffB); PG8_STAGE(PG8_SA(0, 0), cA, voffA); PG8_STAGE(PG8_SB(0, 1), cB + hstep, voffB); PG8_STAGE(PG8_SA(0, 1), cA + hstep, voffA);
    if (wr == 1) PG8_BAR;
    PG8_WAIT_V(4); PG8_BAR;
    PG8_STAGE(PG8_SB(1, 0), cB + kstep, voffB); PG8_STAGE(PG8_SA(1, 0), cA + kstep, voffA); PG8_STAGE(PG8_SB(1, 1), cB + hstep + kstep, voffB);
    PG8_WAIT_V(6); PG8_BAR;
    PG8_STAMP();
    for (;;) {
        const bool has_next = S.next(ui + 1, nxt);
        const char* nA = has_next ? (const char*)g.A + (size_t)nxt.pm * tstep : cA; const char* nB = has_next ? (const char*)g.Bt + (size_t)nxt.pn * tstep : cB;
        for (int t = 0; t < nt; t += 2) {
            const bool last = (t == nt - 2);
            const char* a1 = cA + (size_t)(t + 1) * kstep;
            const char* a2 = last ? nA : cA + (size_t)(t + 2) * kstep; const char* b2 = last ? nB : cB + (size_t)(t + 2) * kstep;
            const char* a3 = a2 + kstep; const char* b3 = b2 + kstep;
            if (last && has_next) S.a_ready(nxt);
            PG8_LDB(B0, 0, 0); PG8_SCHED; PG8_LDA(At, 0, 0); PG8_STAGE(PG8_SA(1, 1), a1 + hstep, voffA);
            PG8_WAIT_L(8); PG8_BAR; PG8_WAIT_L(0); PG8_MMA(0, 0, At, B0); PG8_BAR; PG8_SCHED;
            PG8_LDB(B1, 0, 1); PG8_STAGE(PG8_SB(0, 0), b2, voffB);
            PG8_BAR; PG8_WAIT_L(0); PG8_MMA(0, 1, At, B1); PG8_BAR;
            PG8_LDA(At, 0, 1); PG8_STAGE(PG8_SA(0, 0), a2, voffA);
            PG8_BAR; PG8_WAIT_L(0); PG8_MMA(1, 0, At, B0); PG8_BAR; PG8_SCHED;
            PG8_STAGE(PG8_SB(0, 1), b2 + hstep, voffB);
            PG8_WAIT_V(6); PG8_BAR; PG8_MMA(1, 1, At, B1); PG8_BAR;
            PG8_LDB(B0, 1, 0); PG8_SCHED; PG8_LDA(At, 1, 0); PG8_STAGE(PG8_SA(0, 1), a2 + hstep, voffA);
            PG8_WAIT_L(8); PG8_BAR; PG8_WAIT_L(0); PG8_MMA(0, 0, At, B0); PG8_BAR; PG8_SCHED;
            PG8_LDB(B1, 1, 1); PG8_STAGE(PG8_SB(1, 0), b3, voffB);
            PG8_BAR; PG8_WAIT_L(0); PG8_MMA(0, 1, At, B1); PG8_BAR;
            PG8_LDA(At, 1, 1); PG8_STAGE(PG8_SA(1, 0), a3, voffA);
            PG8_BAR; PG8_WAIT_L(0); PG8_MMA(1, 0, At, B0); PG8_BAR; PG8_SCHED;
            PG8_STAGE(PG8_SB(1, 1), b3 + hstep, voffB);
            PG8_WAIT_V(6); PG8_BAR; PG8_MMA(1, 1, At, B1); PG8_BAR;
        }
        PG8_STAMP();
        if constexpr (!Epi::AFTER_DRAIN) { E(acc, cur, wr, wc, fr, fq); S.done(cur); }
        PG8_STAMP();
        if (!has_next) break;
#pragma unroll
        for (int a = 0; a < 2; ++a)
#pragma unroll
            for (int b = 0; b < 2; ++b)
#pragma unroll
                for (int m = 0; m < 4; ++m)
#pragma unroll
                    for (int n = 0; n < 2; ++n) acc[a][b][m][n] = (f32x4){0.f, 0.f, 0.f, 0.f};
        cur = nxt; cA = nA; cB = nB; ++ui;
    }
    PG8_WAIT_V(0);
    if (wr == 0) PG8_BAR;
    PG8_BAR;
    if constexpr (Epi::AFTER_DRAIN) { E.fused(acc, cur, wr, wc, fr, fq, lds, wid, lane); S.done(cur); }
    PG8_STAMP();
    if (STAMP && wid == 0) { stamps[lane] = lane < nts ? (((unsigned long long)(unsigned)ts_hi << 32) | (unsigned)ts_lo) : 0ull;
        if (lane == 62) stamps[62] = rt_entry; if (lane == 63) stamps[63] = (unsigned long long)wall_clock64(); }
#undef PG8_STAMP
#undef PG8_SA
#undef PG8_SB
#undef PG8_STAGE
#undef PG8_LDA
#undef PG8_LDB
#undef PG8_MMA
#undef PG8_WAIT_V
#undef PG8_WAIT_L
#undef PG8_BAR
#undef PG8_SCHED
}
}

struct EpiP {
    static constexpr bool PERM = true, AFTER_DRAIN = false;
    u16* O;
    __device__ __forceinline__ void operator()(const f32x4 (&acc)[2][2][4][2], const pg8::Unit& u, int wr, int wc, int fr, int fq) const {
        const int row0 = u.pm * 256 + wr * 64 + fr, col0 = u.pn * 256 + wc * 32 + 8 * fq;
#pragma unroll
        for (int ai = 0; ai < 2; ++ai)
#pragma unroll
            for (int m = 0; m < 4; ++m) { u16* rowp = O + (size_t)(row0 + ai * 128 + m * 16) * LDP + col0;
#pragma unroll
                for (int bj = 0; bj < 2; ++bj) { const f32x4 v0 = acc[ai][bj][m][0], v1 = acc[ai][bj][m][1];
                    uint4 w; w.x = pk2(v0[0], v0[1]); w.y = pk2(v0[2], v0[3]); w.z = pk2(v1[0], v1[1]); w.w = pk2(v1[2], v1[3]);
                    *(uint4*)(rowp + bj * 128) = w; } }
    }
};
template <int MODE> struct EpiG2 {
    static constexpr bool PERM = true, AFTER_DRAIN = false;
    const u16* P; float* T1; u16* MG;
    __device__ __forceinline__ void operator()(const f32x4 (&acc)[2][2][4][2], const pg8::Unit& u, int wr, int wc, int fr, int fq) const {
        const int row0 = u.pm * 256 + wr * 64 + fr, col0 = u.pn * 256 + wc * 32 + 8 * fq;
#pragma unroll
        for (int aq = 0; aq < 4; ++aq) {
            const int ai = aq >> 1, m0 = (aq & 1) * 2;
            uint4 g[4]; float4 ta[4], tb[4];
#pragma unroll
            for (int m = m0; m < m0 + 2; ++m)
#pragma unroll
                for (int bj = 0; bj < 2; ++bj) {
                    const size_t row = (size_t)(row0 + ai * 128 + m * 16); const int col = col0 + bj * 128;
                    g[(m - m0) * 2 + bj] = *(const uint4*)(P + row * LDP + (MODE == 0 ? 8192 : 9216) + col);
                    if (MODE == 1) { const float* tp = T1 + row * 1024 + col; ta[(m - m0) * 2 + bj] = *(const float4*)tp; tb[(m - m0) * 2 + bj] = *(const float4*)(tp + 4); }
                }
            __builtin_amdgcn_sched_barrier(0);
#pragma unroll
            for (int m = m0; m < m0 + 2; ++m)
#pragma unroll
                for (int bj = 0; bj < 2; ++bj) {
                    const size_t row = (size_t)(row0 + ai * 128 + m * 16); const int col = col0 + bj * 128;
                    const uint4 gg = g[(m - m0) * 2 + bj];
                    const f32x4 v0 = acc[ai][bj][m][0], v1 = acc[ai][bj][m][1];
                    const float r0 = sigmf(bflo(gg.x)) * v0[0], r1 = sigmf(bfhi(gg.x)) * v0[1], r2 = sigmf(bflo(gg.y)) * v0[2], r3 = sigmf(bfhi(gg.y)) * v0[3];
                    const float r4 = sigmf(bflo(gg.z)) * v1[0], r5 = sigmf(bfhi(gg.z)) * v1[1], r6 = sigmf(bflo(gg.w)) * v1[2], r7 = sigmf(bfhi(gg.w)) * v1[3];
                    if (MODE == 0) { float* tp = T1 + row * 1024 + col; *(float4*)tp = make_float4(r0, r1, r2, r3); *(float4*)(tp + 4) = make_float4(r4, r5, r6, r7); }
                    else { const float4 x = ta[(m - m0) * 2 + bj], y = tb[(m - m0) * 2 + bj];
                        uint4 w; w.x = pk2(x.x + r0, x.y + r1); w.y = pk2(x.z + r2, x.w + r3); w.z = pk2(y.x + r4, y.y + r5); w.w = pk2(y.z + r6, y.w + r7);
                        *(uint4*)(MG + row * 1024 + col) = w; }
                }
        }
    }
};
struct EpiG3 {
    static constexpr bool PERM = false, AFTER_DRAIN = false;
    float* X; const float* MODL;
    __device__ __forceinline__ void operator()(const f32x4 (&acc)[2][2][4][2], const pg8::Unit& u, int wr, int wc, int fr, int fq) const {
        const int row0 = u.pm * 256 + wr * 64 + fr, col0 = u.pn * 256 + wc * 32 + 4 * fq;
#pragma unroll
        for (int ai = 0; ai < 2; ++ai)
#pragma unroll
            for (int m = 0; m < 4; ++m) { const int row = row0 + ai * 128 + m * 16; const float* gp = MODL + seq_of(row) * 3072 + 2048;
#pragma unroll
                for (int bj = 0; bj < 2; ++bj)
#pragma unroll
                    for (int n = 0; n < 2; ++n) { const int col = col0 + bj * 128 + n * 16;
                        const float4 g = *(const float4*)(gp + col); float4* xp = (float4*)(X + (size_t)row * 1024 + col); float4 x = *xp; const f32x4 a = acc[ai][bj][m][n];
                        x.x += g.x * a[0]; x.y += g.y * a[1]; x.z += g.z * a[2]; x.w += g.w * a[3]; *xp = x; } }
    }
};

template <class Epi> __device__ __forceinline__ void run_gemm(unsigned char* lds, const u16* A, const u16* Bt, int M, int N, const Epi& E) {
    pg8::Gemm g; g.A = A; g.Bt = Bt; g.M = M; g.N = N; g.K = 1024;
    pg8::StaticOrder S; S.init(M, N, (int)gridDim.x, (int)bidx());
    pg8::gemm_phase<Epi, pg8::StaticOrder, false>((PG8_LAS unsigned char*)lds, g, S, E, nullptr);
}

__device__ __forceinline__ void phase_prep(const Params& p, unsigned char* lds) {
    float* ldsf = (float*)lds;
    const int tid = tidx(), nb = gridDim.x, bid = bidx(), wid = tid >> 6, lane = tid & 63;
    if (bid == 0 && tid < 4) ((unsigned*)(p.ws + WS_GLAST + 12288))[tid] = 0u;
    {
        const float4* xp = (const float4*)p.in[0]; const float4* xs = (const float4*)p.in[1];
        float4* X = (float4*)(p.ws + WS_X);
        const size_t n4p = (size_t)NPT * 256, n4 = (size_t)NTOK * 256;
        for (size_t i = (size_t)bid * 512 + tid; i < n4; i += (size_t)nb * 512) X[i] = i < n4p ? xp[i] : xs[i - n4p];
        float2* CS = (float2*)(p.ws + WS_CS);
        for (int i = bid * 512 + tid; i < 8192 * 32; i += nb * 512) {
            const int pos = i >> 5, d = i & 31;
            const float inv = powf(10000.0f, -(float)d / 32.0f);
            const float ang = (float)pos * inv;
            const float kf = rintf(ang * 0.636619772367581343f);
            float r = fmaf(-kf, 1.5707962512969971f, ang); r = fmaf(-kf, 7.5497894158615964e-08f, r); r = fmaf(-kf, 5.3903029534742384e-15f, r);
            const float sr = sinf(r), cr = cosf(r);
            const int q = ((int)kf) & 3;
            float s, c;
            if (q == 0) { s = sr; c = cr; } else if (q == 1) { s = cr; c = -sr; } else if (q == 2) { s = -sr; c = -cr; } else { s = -cr; c = sr; }
            CS[i] = make_float2(c, s);
        }
    }
    {
        const int NT_IN = LDP / 64, per_layer = (NT_IN + 48) * 16;
        for (int it = bid; it < 4 * per_layer; it += nb) {
            const int l = it / per_layer, r = it % per_layer, kt = r & 15; int ntile = r >> 4;
            const float* src; u16* dst; int ldn; bool is_in;
            if (ntile < NT_IN) { is_in = true; src = p.in[11] + (size_t)l * 1024 * 10256; ldn = 10256; dst = (u16*)(p.ws + WS_WTIN) + (size_t)l * LDP * 1024; }
            else { const int q = (ntile - NT_IN) >> 4; ntile = (ntile - NT_IN) & 15; is_in = false; src = p.in[18 + q] + (size_t)l * 1024 * 1024; ldn = 1024;
                   dst = (u16*)(p.ws + (q == 0 ? WS_WTPA : (q == 1 ? WS_WTPB : WS_WTOUT))) + (size_t)l * 1024 * 1024; }
            const int n0 = ntile * 64, k0 = kt * 64;
            __syncthreads();
#pragma unroll
            for (int i = 0; i < 2; ++i) {
                const int kk = (tid >> 4) + 32 * i, nn = (tid & 15) * 4, np = n0 + nn; int sc = np;
                if (is_in) sc = np < 4096 ? np : (np < 10240 ? np + 16 : (np < 10256 ? np - 10240 + 4096 : -1));
                float4 v = make_float4(0.f, 0.f, 0.f, 0.f);
                if (sc >= 0) v = *(const float4*)(src + (size_t)(k0 + kk) * ldn + sc);
                ldsf[kk * 65 + nn] = v.x; ldsf[kk * 65 + nn + 1] = v.y; ldsf[kk * 65 + nn + 2] = v.z; ldsf[kk * 65 + nn + 3] = v.w;
            }
            __syncthreads();
#pragma unroll
            for (int i = 0; i < 4; ++i) {
                const int nn = (tid >> 5) + 16 * i, kk = 2 * (tid & 31);
                *(unsigned*)(dst + (size_t)(n0 + nn) * 1024 + k0 + kk) = pk2(ldsf[kk * 65 + nn], ldsf[(kk + 1) * 65 + nn]);
            }
        }
    }
    {
        __syncthreads();
        for (int i = tid; i < 18 * 1024; i += 512) ldsf[i] = i < 2048 ? p.in[2][i] : p.in[3][i - 2048];
        float* part = ldsf + 18432;
        float* MOD = (float*)(p.ws + WS_MOD);
        __syncthreads();
        for (int it = bid; it < 4 * 48; it += nb) {
            const int l = it / 48, j0 = (it % 48) * 64;
            const float* W = p.in[9] + (size_t)l * 1024 * 3072 + j0 + lane;
            float acc[18];
#pragma unroll
            for (int s = 0; s < 18; ++s) acc[s] = 0.f;
            for (int k = wid * 128; k < wid * 128 + 128; ++k) {
                const float w = W[(size_t)k * 3072];
#pragma unroll
                for (int s = 0; s < 18; ++s) acc[s] = fmaf(ldsf[s * 1024 + k], w, acc[s]);
            }
#pragma unroll
            for (int s = 0; s < 18; ++s) part[(wid * 18 + s) * 64 + lane] = acc[s];
            __syncthreads();
            for (int o = tid; o < 1152; o += 512) {
                const int s = o >> 6, j = o & 63; float v = p.in[10][l * 3072 + j0 + j];
#pragma unroll
                for (int w = 0; w < 8; ++w) v += part[(w * 18 + s) * 64 + j];
                MOD[(size_t)(l * 18 + s) * 3072 + j0 + j] = v;
            }
            __syncthreads();
        }
    }
}

__device__ __forceinline__ void phase_norm(const Params& p, int l) {
    const int wid = tidx() >> 6, lane = tidx() & 63;
    const float* X = (const float*)(p.ws + WS_X);
    const float* nw = p.in[8] + l * 1024;
    const float* MODL = (const float*)(p.ws + WS_MOD) + (size_t)l * 18 * 3072;
    u16* H = (u16*)(p.ws + WS_H);
    for (int tok = bidx() * 8 + wid; tok < NTOK; tok += gridDim.x * 8) {
        const float4* xr = (const float4*)(X + (size_t)tok * 1024);
        float4 v[4]; float ss = 0.f;
#pragma unroll
        for (int i = 0; i < 4; ++i) { v[i] = xr[lane + 64 * i]; ss += v[i].x * v[i].x + v[i].y * v[i].y + v[i].z * v[i].z + v[i].w * v[i].w; }
        ss = wave_sum(ss);
        const float rstd = rsqrtf(ss * (1.f / 1024.f) + EPSF);
        const float* ms = MODL + seq_of(tok) * 3072;
#pragma unroll
        for (int i = 0; i < 4; ++i) {
            const int c = (lane + 64 * i) * 4;
            const float4 w = *(const float4*)(nw + c), sh = *(const float4*)(ms + c), sc = *(const float4*)(ms + 1024 + c);
            const float h0 = v[i].x * rstd * w.x * (1.f + sc.x) + sh.x, h1 = v[i].y * rstd * w.y * (1.f + sc.y) + sh.y;
            const float h2 = v[i].z * rstd * w.z * (1.f + sc.z) + sh.z, h3 = v[i].w * rstd * w.w * (1.f + sc.w) + sh.w;
            *(uint2*)(H + (size_t)tok * 1024 + c) = make_uint2(pk2(h0, h1), pk2(h2, h3));
        }
    }
}

__device__ __forceinline__ void phase_post1(const Params& p, int l, unsigned char* lds) {
    const int tid = tidx(), wid = tid >> 6, lane = tid & 63, nb = gridDim.x, bid = bidx();
    const u16* P = (const u16*)(p.ws + WS_P);
    const int gw = bid * 8 + wid, nw = nb * 8;
    {
        const float* cw = p.in[12] + (size_t)l * 4 * 3072;
        for (int it = gw; it < 2112 * 6; it += nw) {
            const int tg = it / 6, sg = it % 6;
            const int tok0 = tg * 8, slot = sg * 4 + (lane >> 4), ch = slot * 128 + (lane & 15) * 8;
            const int t0 = tok0 < NPT ? (tok0 & 8191) : ((tok0 - NPT) & 31);
            float w[4][8], a[3][8];
#pragma unroll
            for (int j = 0; j < 4; ++j) { const float4 x = *(const float4*)(cw + j * 3072 + ch), y = *(const float4*)(cw + j * 3072 + ch + 4);
                w[j][0] = x.x; w[j][1] = x.y; w[j][2] = x.z; w[j][3] = x.w; w[j][4] = y.x; w[j][5] = y.y; w[j][6] = y.z; w[j][7] = y.w; }
            if (t0 == 0) {
                if (tok0 < NPT) {
#pragma unroll
                    for (int j = 0; j < 3; ++j)
#pragma unroll
                        for (int e = 0; e < 8; ++e) a[j][e] = 0.f;
                } else { const float* sc = p.in[7] + ((size_t)(l * 16 + ((tok0 - NPT) >> 5)) * 3) * 3072 + ch;
#pragma unroll
                    for (int j = 0; j < 3; ++j) { const float4 x = *(const float4*)(sc + j * 3072), y = *(const float4*)(sc + j * 3072 + 4);
                        a[j][0] = x.x; a[j][1] = x.y; a[j][2] = x.z; a[j][3] = x.w; a[j][4] = y.x; a[j][5] = y.y; a[j][6] = y.z; a[j][7] = y.w; } }
            } else {
#pragma unroll
                for (int j = 0; j < 3; ++j) { const uint4 u = *(const uint4*)(P + (size_t)(tok0 - 3 + j) * LDP + ch);
                    a[j][0] = bflo(u.x); a[j][1] = bfhi(u.x); a[j][2] = bflo(u.y); a[j][3] = bfhi(u.y); a[j][4] = bflo(u.z); a[j][5] = bfhi(u.z); a[j][6] = bflo(u.w); a[j][7] = bfhi(u.w); }
            }
            uint4 u[8];
#pragma unroll
            for (int i = 0; i < 8; ++i) u[i] = *(const uint4*)(P + (size_t)(tok0 + i) * LDP + ch);
            float y[8][8], ss[8];
#pragma unroll
            for (int i = 0; i < 8; ++i) {
                const float c[8] = {bflo(u[i].x), bfhi(u[i].x), bflo(u[i].y), bfhi(u[i].y), bflo(u[i].z), bfhi(u[i].z), bflo(u[i].w), bfhi(u[i].w)};
                float acc = 0.f;
#pragma unroll
                for (int e = 0; e < 8; ++e) {
                    const float v = siluf(w[0][e] * a[0][e] + w[1][e] * a[1][e] + w[2][e] * a[2][e] + w[3][e] * c[e]);
                    a[0][e] = a[1][e]; a[1][e] = a[2][e]; a[2][e] = c[e];
                    y[i][e] = v; acc += v * v;
                }
                ss[i] = acc;
            }
            if (sg < 4) {
#pragma unroll
                for (int o = 8; o; o >>= 1)
#pragma unroll
                    for (int i = 0; i < 8; ++i) ss[i] += __shfl_xor(ss[i], o);
                const float post = sg < 2 ? 0.08838834764831845f : 1.f;
#pragma unroll
                for (int i = 0; i < 8; ++i) { const float sc = rsqrtf(ss[i] + EPSF) * post;
#pragma unroll
                    for (int e = 0; e < 8; ++e) y[i][e] *= sc; }
            }
            u16* dst = (u16*)(p.ws + (sg < 2 ? WS_QA : (sg < 4 ? WS_KA : WS_VA))) + (slot & 7) * 128 + (lane & 15) * 8;
#pragma unroll
            for (int i = 0; i < 8; ++i)
                *(uint4*)(dst + (size_t)(tok0 + i) * 1024) = make_uint4(pk2(y[i][0], y[i][1]), pk2(y[i][2], y[i][3]), pk2(y[i][4], y[i][5]), pk2(y[i][6], y[i][7]));
        }
    }
    for (int idx = bid * 512 + tid; idx < 18 * 9216; idx += nb * 512) {
        const int s = idx / 9216, r = idx % 9216, j = r / 3072, c = r % 3072;
        const int tok = s < 2 ? s * 8192 + 8189 + j : NPT + (s - 2) * 32 + 29 + j;
        const float v = bf2f(P[(size_t)tok * LDP + c]);
        if (s < 2) p.out[O_CONVP + ((size_t)(l * 2 + s) * 3 + j) * 3072 + c] = v;
        else p.out[O_CONVS + ((size_t)(l * 16 + s - 2) * 3 + j) * 3072 + c] = v;
    }
    {
        float* BETA = (float*)(p.ws + WS_BETA); float* GLOG = (float*)(p.ws + WS_GLOG);
        for (int idx = bid * 512 + tid; idx < NTOK * 8; idx += nb * 512) {
            const int tok = idx >> 3, h = idx & 7;
            const float ba = bf2f(P[(size_t)tok * LDP + 10240 + h]), aa = bf2f(P[(size_t)tok * LDP + 10248 + h]);
            BETA[idx] = sigmf(ba);
            const float x = aa + p.in[14][l * 8 + h];
            const float sp = fmaxf(x, 0.f) + log1pf(__expf(-fabsf(x)));
            GLOG[idx] = -__expf(p.in[13][l * 8 + h]) * sp;
        }
    }
    {
        const float4* CS4 = (const float4*)(p.ws + WS_CS);
        u16* QB = (u16*)(p.ws + WS_QB); u16* KB = (u16*)(p.ws + WS_KB);
        const int hs = lane >> 4, mq = (lane >> 3) & 1, d4 = (lane & 7) * 4, vc = (lane & 15) * 8;
        for (int it = gw; it < NTOK * 2; it += nw) {
            const int tok = it >> 1, h = (it & 1) * 4 + hs;
            const float4 csa = CS4[(pos_of(tok) * 32 + d4) >> 1], csb = CS4[((pos_of(tok) * 32 + d4) >> 1) + 1];
            const float cc[4] = {csa.x, csa.z, csb.x, csb.z}, sn[4] = {csa.y, csa.w, csb.y, csb.w};
            const u16* pr = P + (size_t)tok * LDP;
            const int cb = h * 128 + mq * 64 + d4;
            const uint2 q1 = *(const uint2*)(pr + 4096 + cb), q2 = *(const uint2*)(pr + 4096 + cb + 32);
            const uint2 k1 = *(const uint2*)(pr + 5120 + cb), k2 = *(const uint2*)(pr + 5120 + cb + 32);
            const uint4 vv = *(const uint4*)(pr + 6144 + h * 128 + vc);
            const float q1f[4] = {bflo(q1.x), bfhi(q1.x), bflo(q1.y), bfhi(q1.y)}, q2f[4] = {bflo(q2.x), bfhi(q2.x), bflo(q2.y), bfhi(q2.y)};
            const float k1f[4] = {bflo(k1.x), bfhi(k1.x), bflo(k1.y), bfhi(k1.y)}, k2f[4] = {bflo(k2.x), bfhi(k2.x), bflo(k2.y), bfhi(k2.y)};
            float qa[4], qb[4], ka[4], kb[4];
#pragma unroll
            for (int e = 0; e < 4; ++e) {
                qa[e] = (q1f[e] * cc[e] - q2f[e] * sn[e]) * QSCALE; qb[e] = (q1f[e] * sn[e] + q2f[e] * cc[e]) * QSCALE;
                ka[e] = k1f[e] * cc[e] - k2f[e] * sn[e]; kb[e] = k1f[e] * sn[e] + k2f[e] * cc[e];
            }
            *(uint2*)(QB + (size_t)tok * 1024 + cb) = make_uint2(pk2(qa[0], qa[1]), pk2(qa[2], qa[3]));
            *(uint2*)(QB + (size_t)tok * 1024 + cb + 32) = make_uint2(pk2(qb[0], qb[1]), pk2(qb[2], qb[3]));
            *(uint2*)(KB + (size_t)tok * 1024 + cb) = make_uint2(pk2(ka[0], ka[1]), pk2(ka[2], ka[3]));
            *(uint2*)(KB + (size_t)tok * 1024 + cb + 32) = make_uint2(pk2(kb[0], kb[1]), pk2(kb[2], kb[3]));
            size_t orow; float* ko; float* vo;
            if (tok < NPT) { orow = ((size_t)(l * 2 + (tok >> 13)) * 8 + h) * 8192 + (tok & 8191); ko = p.out + O_KP; vo = p.out + O_VP; }
            else { const int r = tok - NPT; orow = ((size_t)(l * 16 + (r >> 5)) * 8 + h) * 32 + (r & 31); ko = p.out + O_KS; vo = p.out + O_VS; }
            *(float4*)(ko + orow * 128 + mq * 64 + d4) = make_float4(ka[0], ka[1], ka[2], ka[3]);
            *(float4*)(ko + orow * 128 + mq * 64 + d4 + 32) = make_float4(kb[0], kb[1], kb[2], kb[3]);
            *(float4*)(vo + orow * 128 + vc) = make_float4(bflo(vv.x), bfhi(vv.x), bflo(vv.y), bfhi(vv.y));
            *(float4*)(vo + orow * 128 + vc + 4) = make_float4(bflo(vv.z), bfhi(vv.z), bflo(vv.w), bfhi(vv.w));
        }
    }
    {
        u16* T = (u16*)lds;
        u16* VT = (u16*)(p.ws + WS_VT);
        uint4 pre0 = make_uint4(0, 0, 0, 0), pre1 = pre0;
#define VT_LOAD(it_) do { const int tt_ = (it_) & 127, h_ = ((it_) >> 7) & 7, b_ = (it_) >> 10; \
        pre0 = *(const uint4*)(P + (size_t)(b_ * 8192 + tt_ * 64 + (tid >> 4)) * LDP + 6144 + h_ * 128 + (tid & 15) * 8); \
        pre1 = *(const uint4*)(P + (size_t)(b_ * 8192 + tt_ * 64 + 32 + (tid >> 4)) * LDP + 6144 + h_ * 128 + (tid & 15) * 8); } while (0)
        if (bid < 2048) VT_LOAD(bid);
        for (int it = bid; it < 2048; it += nb) {
            const int tt = it & 127, h = (it >> 7) & 7, b = it >> 10;
            __syncthreads();
            *(uint4*)(T + (tid >> 4) * 136 + (tid & 15) * 8) = pre0; *(uint4*)(T + (32 + (tid >> 4)) * 136 + (tid & 15) * 8) = pre1;
            __syncthreads();
            if (it + nb < 2048) VT_LOAD(it + nb);
            const int c = tid & 127, tq = tid >> 7;
            unsigned w[8];
#pragma unroll
            for (int i = 0; i < 8; ++i) w[i] = (unsigned)T[(tq * 16 + 2 * i) * 136 + c] | ((unsigned)T[(tq * 16 + 2 * i + 1) * 136 + c] << 16);
            u16* o = VT + ((size_t)((b * 8 + h) * 128 + c)) * 8192 + tt * 64 + tq * 16;
            *(uint4*)o = make_uint4(w[0], w[1], w[4], w[5]); *(uint4*)(o + 8) = make_uint4(w[2], w[3], w[6], w[7]);
        }
#undef VT_LOAD
    }
}

__device__ __forceinline__ void gdn_chunk_load(const Params& p, int item, uint4& t0, uint4& t1, uint4& t2, uint4& t3, uint4& t4, uint4& t5, float& g, float& bt) {
    const int tid = tidx(), lane = tid & 63;
    const int ch = item >> 3, h = item & 7;
    const int tok0 = ch < 256 ? ch * 64 : NPT + (ch - 256) * 32, L = ch < 256 ? 64 : 32;
    const int row = (tid >> 4) & 31, seg = tid & 15;
    const uint4 z = make_uint4(0, 0, 0, 0);
    const size_t o0 = (size_t)(tok0 + row) * 1024 + h * 128 + seg * 8, o1 = o0 + (size_t)32 * 1024;
    const bool v1 = (row + 32) < L;
    t0 = *(const uint4*)((const u16*)(p.ws + WS_KA) + o0); t2 = *(const uint4*)((const u16*)(p.ws + WS_QA) + o0); t4 = *(const uint4*)((const u16*)(p.ws + WS_VA) + o0);
    t1 = z; t3 = z; t5 = z;
    if (v1) { t1 = *(const uint4*)((const u16*)(p.ws + WS_KA) + o1); t3 = *(const uint4*)((const u16*)(p.ws + WS_QA) + o1); t5 = *(const uint4*)((const u16*)(p.ws + WS_VA) + o1); }
    g = 0.f; bt = 0.f;
    if (tid < 64 && lane < L) { g = ((const float*)(p.ws + WS_GLOG))[(size_t)(tok0 + lane) * 8 + h]; bt = ((const float*)(p.ws + WS_BETA))[(size_t)(tok0 + lane) * 8 + h]; }
}
__device__ __forceinline__ void gdn_chunk_item(const Params& p, int item, int next_item, unsigned char* lds,
                                               uint4& t0, uint4& t1, uint4& t2, uint4& t3, uint4& t4, uint4& t5, float& gpre, float& bpre, const int skip = 0) {
    const int tid = tidx(), wid = tid >> 6, lane = tid & 63, fr = lane & 15, fq = lane >> 4;
    u16* kT = (u16*)lds; u16* qT = kT + 64 * 136; u16* vT = qT + 64 * 136;
    float* AT = (float*)(lds + 52224); float* Gs = (float*)(lds + 69632); float* Bs = Gs + 64;
    __syncthreads();
    {
        const int row = (tid >> 4) & 31, seg = tid & 15;
        *(uint4*)(kT + row * 136 + seg * 8) = t0; *(uint4*)(kT + (row + 32) * 136 + seg * 8) = t1;
        *(uint4*)(qT + row * 136 + seg * 8) = t2; *(uint4*)(qT + (row + 32) * 136 + seg * 8) = t3;
        *(uint4*)(vT + row * 136 + seg * 8) = t4; *(uint4*)(vT + (row + 32) * 136 + seg * 8) = t5;
    }
    if (wid == 0) {
        float g = gpre;
#pragma unroll
        for (int o = 1; o < 64; o <<= 1) { const float t = __shfl_up(g, o); if (lane >= o) g += t; }
        Gs[lane] = g;
        Bs[lane] = bpre;
    }
    __syncthreads();
    if (next_item >= 0) gdn_chunk_load(p, next_item, t0, t1, t2, t3, t4, t5, gpre, bpre);
    u16* QKM = (u16*)(p.ws + WS_QKM) + (size_t)item * 4096;
    if (!(skip & 2))
#pragma unroll
    for (int u = 0; u < 4; ++u) {
        const int id = wid * 4 + u, which = id >> 4, ti = (id >> 2) & 3, tj = id & 3;
        f32x4 acc = {0.f, 0.f, 0.f, 0.f};
        const u16* Ab = (which ? qT : kT) + (ti * 16 + fr) * 136 + fq * 8;
        const u16* Bb = kT + (tj * 16 + fr) * 136 + fq * 8;
#pragma unroll
        for (int ks = 0; ks < 4; ++ks) acc = __builtin_amdgcn_mfma_f32_16x16x32_bf16(*(const bf16x8*)(Ab + ks * 32), *(const bf16x8*)(Bb + ks * 32), acc, 0, 0, 0);
        const int j = tj * 16 + fr; const float Gj = Gs[j];
#pragma unroll
        for (int r = 0; r < 4; ++r) {
            const int i = ti * 16 + 4 * fq + r; const float Gi = Gs[i];
            if (which == 0) AT[j * 68 + i] = (i > j) ? Bs[i] * acc[r] * __expf(Gi - Gj) : 0.f;
            else QKM[i * 64 + permk(j)] = f2bf((i >= j) ? acc[r] * __expf(Gi - Gj) : 0.f);
        }
    }
    __syncthreads();
    if (tid < 256) { if (!(skip & 1)) {
        const int c = tid;
        int zoff; asm volatile("v_mov_b32 %0, 0" : "=v"(zoff));
        const float* ATz = AT + zoff;
        float* xs = (float*)(lds + 70144) + c;
        const u16* src = c < 128 ? (vT + c) : (kT + c - 128);
        for (int bk = 0; bk < 4; ++bk) {
            float w[16];
#pragma unroll
            for (int ii = 0; ii < 16; ++ii) { const int i = 16 * bk + ii; const float sc = c < 128 ? Bs[i] : Bs[i] * __expf(Gs[i]); w[ii] = sc * bf2f(src[i * 136]); }
#pragma unroll 4
            for (int j = 0; j < 16 * bk; ++j) {
                const float xj = xs[j * 256];
                const float4* ar = (const float4*)(ATz + j * 68 + 16 * bk);
#pragma unroll
                for (int q = 0; q < 4; ++q) { const float4 a4 = ar[q];
                    w[4 * q] = fmaf(-a4.x, xj, w[4 * q]); w[4 * q + 1] = fmaf(-a4.y, xj, w[4 * q + 1]); w[4 * q + 2] = fmaf(-a4.z, xj, w[4 * q + 2]); w[4 * q + 3] = fmaf(-a4.w, xj, w[4 * q + 3]); }
            }
            const float* ad = ATz + (16 * bk) * 69;
            float dg[15][16];
#pragma unroll
            for (int jj = 0; jj < 15; ++jj)
#pragma unroll
                for (int q = (jj + 1) >> 2; q < 4; ++q) { const float4 a4 = *(const float4*)(ad + jj * 68 + 4 * q);
                    dg[jj][4 * q] = a4.x; dg[jj][4 * q + 1] = a4.y; dg[jj][4 * q + 2] = a4.z; dg[jj][4 * q + 3] = a4.w; }
#pragma unroll
            for (int jj = 0; jj < 15; ++jj) {
                const float xj = w[jj];
#pragma unroll
                for (int ii = jj + 1; ii < 16; ++ii) w[ii] = fmaf(-dg[jj][ii], xj, w[ii]);
            }
            if (bk < 3) {
#pragma unroll
                for (int ii = 0; ii < 16; ++ii) xs[(16 * bk + ii) * 256] = w[ii];
            }
            if (c < 128) {
                u16* o = (u16*)(p.ws + WS_VNT) + (size_t)item * 8192 + c * 64 + 16 * bk;
                *(uint4*)o = make_uint4(pk2(w[0], w[1]), pk2(w[2], w[3]), pk2(w[4], w[5]), pk2(w[6], w[7]));
                *(uint4*)(o + 8) = make_uint4(pk2(w[8], w[9]), pk2(w[10], w[11]), pk2(w[12], w[13]), pk2(w[14], w[15]));
            } else {
                u16* o = (u16*)(p.ws + WS_KCUM) + (size_t)item * 8192 + permk(c - 128) + (16 * bk) * 128;
#pragma unroll
                for (int ii = 0; ii < 16; ++ii) o[ii * 128] = f2bf(w[ii]);
            }
        }
    } } else if (!(skip & 4)) {
        const int e = tid - 256;
        u16* QD = (u16*)(p.ws + WS_QD) + (size_t)item * 8192;
        u16* KDT = (u16*)(p.ws + WS_KDT) + (size_t)item * 8192;
        const float Gl = Gs[63];
#pragma unroll 4
        for (int k = 0; k < 16; ++k) {
            const int idx = e + 256 * k;
            { const int i = idx >> 6, dp = (idx & 63) * 2; const float s = __expf(Gs[i]);
              const unsigned u = *(const unsigned*)(qT + i * 136 + dp);
              *(unsigned*)(QD + i * 128 + permk(dp)) = pk2(bflo(u) * s, bfhi(u) * s); }
            { const int d = idx >> 5, jp = (idx & 31) * 2;
              const float v0 = bf2f(kT[jp * 136 + d]) * __expf(Gl - Gs[jp]), v1 = bf2f(kT[(jp + 1) * 136 + d]) * __expf(Gl - Gs[jp + 1]);
              *(unsigned*)(KDT + d * 64 + permk(jp)) = pk2(v0, v1); }
        }
        if (e == 0) ((float*)(p.ws + WS_GLAST))[item] = __expf(Gl);
    }
}

__device__ __forceinline__ bf16x8 ld2(const u16* a) { return *(const bf16x8*)a; }
__device__ __forceinline__ bf16x8 pkfrag(const f32x4& a, const f32x4& b) {
    typedef unsigned u32x4 __attribute__((ext_vector_type(4)));
    u32x4 w; w.x = pk2(a[0], a[1]); w.y = pk2(a[2], a[3]); w.z = pk2(b[0], b[1]); w.w = pk2(b[2], b[3]);
    return __builtin_bit_cast(bf16x8, w);
}
__device__ __forceinline__ void gdn_scan_item(const Params& p, int l, int ch0, int nsteps, int h, int cb, const float* s_init, float* s_out, int L) {
    const int lane = tidx() & 63, fr = lane & 15, fq = lane >> 4, c = cb * 16 + fr;
    f32x4 S[8];
#pragma unroll
    for (int u = 0; u < 8; ++u)
#pragma unroll
        for (int r = 0; r < 4; ++r) S[u][r] = s_init ? s_init[(size_t)(16 * u + 4 * fq + r) * 128 + c] : 0.f;
    float* ORAW = (float*)(p.ws + WS_ORAW);
    for (int st = 0; st < nsteps; ++st) {
        const int ch = ch0 + st, item = ch * 8 + h;
        const int tok0 = ch < 256 ? ch * 64 : NPT + (ch - 256) * 32;
        const u16* kc = (const u16*)(p.ws + WS_KCUM) + (size_t)item * 8192 + fr * 128 + 8 * fq;
        const u16* qd = (const u16*)(p.ws + WS_QD) + (size_t)item * 8192 + fr * 128 + 8 * fq;
        const u16* kdt = (const u16*)(p.ws + WS_KDT) + (size_t)item * 8192 + fr * 64 + 8 * fq;
        const u16* qk = (const u16*)(p.ws + WS_QKM) + (size_t)item * 4096 + fr * 64 + 8 * fq;
        const u16* vnt = (const u16*)(p.ws + WS_VNT) + (size_t)item * 8192 + c * 64 + 4 * fq;
        const float gl = ((const float*)(p.ws + WS_GLAST))[item];
        bf16x8 sb[4];
#pragma unroll
        for (int ks = 0; ks < 4; ++ks) sb[ks] = pkfrag(S[2 * ks], S[2 * ks + 1]);
        f32x4 w[4];
#pragma unroll
        for (int t = 0; t < 4; ++t) {
            f32x4 acc = {0.f, 0.f, 0.f, 0.f};
#pragma unroll
            for (int ks = 0; ks < 4; ++ks) acc = __builtin_amdgcn_mfma_f32_16x16x32_bf16(ld2(kc + t * 16 * 128 + ks * 32), sb[ks], acc, 0, 0, 0);
            const uint2 vn = *(const uint2*)(vnt + 16 * t);
            w[t][0] = bflo(vn.x) - acc[0]; w[t][1] = bfhi(vn.x) - acc[1]; w[t][2] = bflo(vn.y) - acc[2]; w[t][3] = bfhi(vn.y) - acc[3];
        }
        bf16x8 wb[2];
        wb[0] = pkfrag(w[0], w[1]); wb[1] = pkfrag(w[2], w[3]);
#pragma unroll
        for (int t = 0; t < 4; ++t) {
            f32x4 acc = {0.f, 0.f, 0.f, 0.f};
#pragma unroll
            for (int ks = 0; ks < 4; ++ks) acc = __builtin_amdgcn_mfma_f32_16x16x32_bf16(ld2(qd + t * 16 * 128 + ks * 32), sb[ks], acc, 0, 0, 0);
#pragma unroll
            for (int k2 = 0; k2 < 2; ++k2) acc = __builtin_amdgcn_mfma_f32_16x16x32_bf16(ld2(qk + t * 16 * 64 + k2 * 32), wb[k2], acc, 0, 0, 0);
#pragma unroll
            for (int r = 0; r < 4; ++r) { const int row = 16 * t + 4 * fq + r; if (row < L) ORAW[(size_t)(tok0 + row) * 1024 + h * 128 + c] = acc[r]; }
        }
#pragma unroll
        for (int u = 0; u < 8; ++u) {
            f32x4 acc = S[u] * gl;
#pragma unroll
            for (int k2 = 0; k2 < 2; ++k2) acc = __builtin_amdgcn_mfma_f32_16x16x32_bf16(ld2(kdt + u * 16 * 64 + k2 * 32), wb[k2], acc, 0, 0, 0);
            S[u] = acc;
        }
    }
#pragma unroll
    for (int u = 0; u < 8; ++u)
#pragma unroll
        for (int r = 0; r < 4; ++r) s_out[(size_t)(16 * u + 4 * fq + r) * 128 + c] = S[u][r];
}
constexpr int SC_KC = 0, SC_QD = 17408, SC_KDT = 34816, SC_QK = 53248, SC_STAGE = 62464;
__device__ __forceinline__ bf16x8 ld2s(const unsigned char* a) { return *(const bf16x8*)a; }
__device__ __forceinline__ void gdn_scan_block(const Params& p, int l, int b, int h, int cq, unsigned char* lds, const int mode = 0) {
    const int tid = tidx(), wid = __builtin_amdgcn_readfirstlane(tid >> 6), lane = tid & 63, fr = lane & 15, fq = lane >> 4;
    const int c = cq * 32 + (wid & 1) * 16 + fr;
    const bool comp = wid < 2 && mode != 1;
    const int rowA = tid >> 4, segA = tid & 15;
    const int rowB = tid >> 3, segB = tid & 7;
    const int sA = (rowA * 128 + segA * 8) * 2, dA = rowA * 272 + segA * 16;
    const int sB = (rowB * 64 + segB * 8) * 2, dB = rowB * 144 + segB * 16;
    const unsigned char* gKC = p.ws + WS_KCUM + sA; const unsigned char* gQD = p.ws + WS_QD + sA;
    const unsigned char* gKDT = p.ws + WS_KDT + sB; const unsigned char* gQK = p.ws + WS_QKM + sB;
    uint4 a0, a1, a2, a3, a4, a5, a6, b0, b1, b2, b3, b4, b5, b6;
#define SC_LOAD(P_, item) do { const size_t o_ = (size_t)(item) * 16384; \
        P_##0 = *(const uint4*)(gKC + o_); P_##1 = *(const uint4*)(gKC + o_ + 32 * 256); P_##2 = *(const uint4*)(gQD + o_); P_##3 = *(const uint4*)(gQD + o_ + 32 * 256); \
        P_##4 = *(const uint4*)(gKDT + o_); P_##5 = *(const uint4*)(gKDT + o_ + 64 * 128); P_##6 = *(const uint4*)(gQK + (size_t)(item) * 8192); } while (0)
#define SC_WRITE(P_, st) do { unsigned char* d_ = lds + (st) * SC_STAGE; \
        *(uint4*)(d_ + SC_KC + dA) = P_##0; *(uint4*)(d_ + SC_KC + dA + 32 * 272) = P_##1; *(uint4*)(d_ + SC_QD + dA) = P_##2; *(uint4*)(d_ + SC_QD + dA + 32 * 272) = P_##3; \
        *(uint4*)(d_ + SC_KDT + dB) = P_##4; *(uint4*)(d_ + SC_KDT + dB + 64 * 144) = P_##5; *(uint4*)(d_ + SC_QK + dB) = P_##6; } while (0)
    f32x4 S[8];
#pragma unroll
    for (int u = 0; u < 8; ++u) S[u] = (f32x4){0.f, 0.f, 0.f, 0.f};
    float* ORAW = (float*)(p.ws + (mode ? WS_T1 : WS_ORAW));
    const int item0 = (b * 128) * 8 + h;
    __syncthreads();
    SC_LOAD(a, item0); SC_WRITE(a, 0); SC_LOAD(a, item0 + 8);
    uint2 vn0[4], vn1[4]; float gl0, gl1;
    {
        const u16* vnt = (const u16*)(p.ws + WS_VNT) + (size_t)item0 * 8192 + c * 64 + 4 * fq;
#pragma unroll
        for (int t = 0; t < 4; ++t) { vn0[t] = *(const uint2*)(vnt + 16 * t); vn1[t] = *(const uint2*)(vnt + 8 * 8192 + 16 * t); }
        gl0 = ((const float*)(p.ws + WS_GLAST))[item0]; gl1 = ((const float*)(p.ws + WS_GLAST))[item0 + 8];
    }
    float* obuf = (float*)(lds + 2 * SC_STAGE);
    const int orow = tid >> 3, ocol = (tid & 7) * 4;
    __syncthreads();
    auto compute = [&](int st, uint2 (&vn)[4], const float gl) __attribute__((always_inline)) {
        const unsigned char* sb_ = lds + (st & 1) * SC_STAGE;
        const unsigned char* kc = sb_ + SC_KC + fr * 272 + fq * 16;
        const unsigned char* qd = sb_ + SC_QD + fr * 272 + fq * 16;
        const unsigned char* kdt = sb_ + SC_KDT + fr * 144 + fq * 16;
        const unsigned char* qk = sb_ + SC_QK + fr * 144 + fq * 16;
        bf16x8 ga[8], gb[8];
#define SC_RD(dst, base, pitch, t0, nk) do { _Pragma("unroll") for (int i_ = 0; i_ < 8; ++i_) dst[i_] = ld2s(base + ((t0) + i_ / (nk)) * 16 * (pitch) + (i_ % (nk)) * 64); } while (0)
        SC_RD(ga, kc, 272, 0, 4);
        SC_RD(gb, kc, 272, 2, 4);
        bf16x8 sb[4];
#pragma unroll
        for (int ks = 0; ks < 4; ++ks) sb[ks] = pkfrag(S[2 * ks], S[2 * ks + 1]);
        __builtin_amdgcn_sched_barrier(0);
        f32x4 w[4];
#pragma unroll
        for (int t = 0; t < 2; ++t) {
            f32x4 acc = {0.f, 0.f, 0.f, 0.f};
#pragma unroll
            for (int ks = 0; ks < 4; ++ks) acc = __builtin_amdgcn_mfma_f32_16x16x32_bf16(ga[t * 4 + ks], sb[ks], acc, 0, 0, 0);
            w[t][0] = bflo(vn[t].x) - acc[0]; w[t][1] = bfhi(vn[t].x) - acc[1]; w[t][2] = bflo(vn[t].y) - acc[2]; w[t][3] = bfhi(vn[t].y) - acc[3];
        }
        __builtin_amdgcn_sched_barrier(0);
        SC_RD(ga, kdt, 144, 0, 2);
        __builtin_amdgcn_sched_barrier(0);
#pragma unroll
        for (int t = 2; t < 4; ++t) {
            f32x4 acc = {0.f, 0.f, 0.f, 0.f};
#pragma unroll
            for (int ks = 0; ks < 4; ++ks) acc = __builtin_amdgcn_mfma_f32_16x16x32_bf16(gb[(t - 2) * 4 + ks], sb[ks], acc, 0, 0, 0);
            w[t][0] = bflo(vn[t].x) - acc[0]; w[t][1] = bfhi(vn[t].x) - acc[1]; w[t][2] = bflo(vn[t].y) - acc[2]; w[t][3] = bfhi(vn[t].y) - acc[3];
        }
        bf16x8 wb[2];
        wb[0] = pkfrag(w[0], w[1]); wb[1] = pkfrag(w[2], w[3]);
        __builtin_amdgcn_sched_barrier(0);
        SC_RD(gb, kdt, 144, 4, 2);
        __builtin_amdgcn_sched_barrier(0);
#pragma unroll
        for (int u = 0; u < 4; ++u) {
            f32x4 acc = S[u] * gl;
#pragma unroll
            for (int k2 = 0; k2 < 2; ++k2) acc = __builtin_amdgcn_mfma_f32_16x16x32_bf16(ga[u * 2 + k2], wb[k2], acc, 0, 0, 0);
            S[u] = acc;
        }
        __builtin_amdgcn_sched_barrier(0);
        SC_RD(ga, qd, 272, 0, 4);
        __builtin_amdgcn_sched_barrier(0);
#pragma unroll
        for (int u = 4; u < 8; ++u) {
            f32x4 acc = S[u] * gl;
#pragma unroll
            for (int k2 = 0; k2 < 2; ++k2) acc = __builtin_amdgcn_mfma_f32_16x16x32_bf16(gb[(u - 4) * 2 + k2], wb[k2], acc, 0, 0, 0);
            S[u] = acc;
        }
        __builtin_amdgcn_sched_barrier(0);
        SC_RD(gb, qd, 272, 2, 4);
        __builtin_amdgcn_sched_barrier(0);
        float* ob = obuf + (st & 1) * 2304 + (wid & 1) * 16 + fr;
        f32x4 o[4];
#pragma unroll
        for (int t = 0; t < 2; ++t) {
            o[t] = (f32x4){0.f, 0.f, 0.f, 0.f};
#pragma unroll
            for (int ks = 0; ks < 4; ++ks) o[t] = __builtin_amdgcn_mfma_f32_16x16x32_bf16(ga[t * 4 + ks], sb[ks], o[t], 0, 0, 0);
        }
        __builtin_amdgcn_sched_barrier(0);
        SC_RD(ga, qk, 144, 0, 2);
        __builtin_amdgcn_sched_barrier(0);
#pragma unroll
        for (int t = 2; t < 4; ++t) {
            o[t] = (f32x4){0.f, 0.f, 0.f, 0.f};
#pragma unroll
            for (int ks = 0; ks < 4; ++ks) o[t] = __builtin_amdgcn_mfma_f32_16x16x32_bf16(gb[(t - 2) * 4 + ks], sb[ks], o[t], 0, 0, 0);
        }
        __builtin_amdgcn_sched_barrier(0);
#pragma unroll
        for (int t = 0; t < 4; ++t) {
#pragma unroll
            for (int k2 = 0; k2 < 2; ++k2) o[t] = __builtin_amdgcn_mfma_f32_16x16x32_bf16(ga[t * 2 + k2], wb[k2], o[t], 0, 0, 0);
#pragma unroll
            for (int r = 0; r < 4; ++r) ob[(16 * t + 4 * fq + r) * 36] = o[t][r];
        }
#undef SC_RD
    };
#define SC_HALF(sc, LS, WS, VN, GL) do { \
        const int sp_ = (sc) > 0 ? (sc) - 1 : 0, sn_ = (sc) + 2 < 128 ? (sc) + 2 : 127; \
        const float4 ov_ = *(const float4*)(obuf + (sp_ & 1) * 2304 + orow * 36 + ocol); \
        if (mode != 2) SC_LOAD(LS, item0 + sn_ * 8); \
        *(float4*)(ORAW + (size_t)((b * 128 + sp_) * 64 + orow) * 1024 + h * 128 + cq * 32 + ocol) = ov_;     \
        if (comp) compute(sc, VN, GL); \
        if (mode != 2) SC_WRITE(WS, ((sc) + 1) & 1); \
        { const u16* vnt_ = (const u16*)(p.ws + WS_VNT) + (size_t)(item0 + sn_ * 8) * 8192 + c * 64 + 4 * fq; \
          _Pragma("unroll") for (int t = 0; t < 4; ++t) VN[t] = *(const uint2*)(vnt_ + 16 * t); \
          GL = ((const float*)(p.ws + WS_GLAST))[item0 + sn_ * 8]; } \
        __syncthreads(); } while (0)
    for (int st = 0; st < 128; st += 2) { SC_HALF(st, b, a, vn0, gl0); SC_HALF(st + 1, a, b, vn1, gl1); }
#undef SC_HALF
    *(float4*)(ORAW + (size_t)((b * 128 + 127) * 64 + orow) * 1024 + h * 128 + cq * 32 + ocol) = *(const float4*)(obuf + 2304 + orow * 36 + ocol);
#undef SC_LOAD
#undef SC_WRITE
    if (comp) {
        float* s_out = mode ? (float*)(p.ws + WS_T1) : p.out + O_SSMP + ((size_t)(l * 2 + b) * 8 + h) * 16384;
#pragma unroll
        for (int u = 0; u < 8; ++u)
#pragma unroll
            for (int r = 0; r < 4; ++r) s_out[(size_t)(16 * u + 4 * fq + r) * 128 + c] = S[u][r];
    }
}
__device__ __forceinline__ void phase_post2(const Params& p, int l) {
    const int wid = tidx() >> 6, lane = tidx() & 63;
    const float* ORAW = (const float*)(p.ws + WS_ORAW); const u16* P = (const u16*)(p.ws + WS_P); u16* OAN = (u16*)(p.ws + WS_OAN);
    const float2 gw = *(const float2*)(p.in[15] + l * 128 + 2 * lane);
    for (int it = bidx() * 8 + wid; it < NTOK * 8; it += gridDim.x * 8) {
        const int tok = it >> 3, h = it & 7;
        const float2 o = *(const float2*)(ORAW + (size_t)tok * 1024 + h * 128 + 2 * lane);
        const float ss = wave_sum(o.x * o.x + o.y * o.y);
        const float rstd = rsqrtf(ss * (1.f / 128.f) + EPSF);
        const unsigned z = *(const unsigned*)(P + (size_t)tok * LDP + 3072 + h * 128 + 2 * lane);
        *(unsigned*)(OAN + (size_t)tok * 1024 + h * 128 + 2 * lane) = pk2(o.x * rstd * gw.x * siluf(bflo(z)), o.y * rstd * gw.y * siluf(bfhi(z)));
    }
}

__device__ __forceinline__ void phase_final(const Params& p) {
    const int wid = tidx() >> 6, lane = tidx() & 63;
    const float* X = (const float*)(p.ws + WS_X); const float* fw = p.in[21];
    for (int tok = bidx() * 8 + wid; tok < NTOK; tok += gridDim.x * 8) {
        const float4* xr = (const float4*)(X + (size_t)tok * 1024);
        float4 v[4]; float ss = 0.f;
#pragma unroll
        for (int i = 0; i < 4; ++i) { v[i] = xr[lane + 64 * i]; ss += v[i].x * v[i].x + v[i].y * v[i].y + v[i].z * v[i].z + v[i].w * v[i].w; }
        ss = wave_sum(ss);
        const float rstd = rsqrtf(ss * (1.f / 1024.f) + EPSF);
#pragma unroll
        for (int i = 0; i < 4; ++i) { const float4 w = ((const float4*)fw)[lane + 64 * i];
            ((float4*)(p.out + O_Y + (size_t)tok * 1024))[lane + 64 * i] = make_float4(v[i].x * rstd * w.x, v[i].y * rstd * w.y, v[i].z * rstd * w.z, v[i].w * rstd * w.w); }
    }
}

__device__ __forceinline__ float lam_of(const Params& p, int l, int lane) {
    const float* lq = p.in[16] + l * 256;
    const float a = wave_sum(lq[lane] * lq[64 + lane]), b = wave_sum(lq[128 + lane] * lq[192 + lane]);
    return __expf(a) - __expf(b) + lam_init_of(l);
}
__device__ __forceinline__ void attn_store(const Params& p, int l, int tok, int h, int hh, const f32x16 (&d)[4], float ss) {
    ss += __shfl_xor(ss, 32);
    const float sc = rsqrtf(ss * (1.f / 128.f) + EPSF) * (1.f - lam_init_of(l));
    const u16* zp = (const u16*)(p.ws + WS_P) + (size_t)tok * LDP + 7168 + h * 128;
    u16* op = (u16*)(p.ws + WS_OBN) + (size_t)tok * 1024 + h * 128;
    const float* dw = p.in[17] + l * 128;
#pragma unroll
    for (int t = 0; t < 4; ++t)
#pragma unroll
        for (int g = 0; g < 4; ++g) {
            const int vc = 32 * t + 8 * g + 4 * hh;
            const uint2 z = *(const uint2*)(zp + vc); const float4 w = *(const float4*)(dw + vc);
            const float o0 = d[t][4 * g] * sc * w.x * siluf(bflo(z.x)), o1 = d[t][4 * g + 1] * sc * w.y * siluf(bfhi(z.x));
            const float o2 = d[t][4 * g + 2] * sc * w.z * siluf(bflo(z.y)), o3 = d[t][4 * g + 3] * sc * w.w * siluf(bfhi(z.y));
            *(uint2*)(op + vc) = make_uint2(pk2(o0, o1), pk2(o2, o3));
        }
}

constexpr int AT_KPITCH = 272, AT_VPITCH = 144, AT_KBYTES = 64 * AT_KPITCH, AT_VBYTES = 128 * AT_VPITCH, AT_VBASE = 2 * AT_KBYTES;

__device__ __forceinline__ void attn_prompt_item(const Params& p, int l, int b, int h, int qb, unsigned char* lds) {
    const int tid = tidx(), wid = __builtin_amdgcn_readfirstlane(tid >> 6), lane = tid & 63;
    const int m = wid & 1, rg = wid >> 1, ql = lane & 31, hh = lane >> 5;
    const bool late = wid >= 4;
    const int tokq = b * 8192 + qb * 128 + rg * 32 + ql;
    const u16* QB = (const u16*)(p.ws + WS_QB);
    bf16x8 qf[4];
#pragma unroll
    for (int s = 0; s < 4; ++s) qf[s] = *(const bf16x8*)(QB + (size_t)tokq * 1024 + h * 128 + m * 64 + 16 * s + 8 * hh);
    const int ntb = 2 * qb + 2, ntw = 2 * qb + 1 + (rg >> 1);
    f32x16 O[4];
#pragma unroll
    for (int t = 0; t < 4; ++t)
#pragma unroll
        for (int r = 0; r < 16; ++r) O[t][r] = 0.f;
    float mrun = -1e30f, lrun = 0.f;
    const u16* KBp = (const u16*)(p.ws + WS_KB) + (size_t)(b * 8192) * 1024 + h * 128;
    const u16* VTp = (const u16*)(p.ws + WS_VT) + (size_t)((b * 8 + h) * 128) * 8192;
    const int krow0 = tid >> 4, kseg = tid & 15;
    const int vrow0 = tid >> 3, vseg = tid & 7;
    uint4 kr0, kr1, vr0, vr1;
#define AT_LOAD(j) do { \
        kr0 = *(const uint4*)(KBp + (size_t)((j) * 64 + krow0) * 1024 + kseg * 8); kr1 = *(const uint4*)(KBp + (size_t)((j) * 64 + krow0 + 32) * 1024 + kseg * 8); \
        vr0 = *(const uint4*)(VTp + (size_t)(vrow0) * 8192 + (j) * 64 + vseg * 8); vr1 = *(const uint4*)(VTp + (size_t)(vrow0 + 64) * 8192 + (j) * 64 + vseg * 8); } while (0)
#define AT_WRITE(ks_, vs_) do { unsigned char* kb = lds + (ks_) * AT_KBYTES; unsigned char* vb = lds + AT_VBASE + (vs_) * AT_VBYTES; \
        *(uint4*)(kb + (krow0) * AT_KPITCH + kseg * 16) = kr0; *(uint4*)(kb + (krow0 + 32) * AT_KPITCH + kseg * 16) = kr1; \
        *(uint4*)(vb + (vrow0) * AT_VPITCH + vseg * 16) = vr0; *(uint4*)(vb + (vrow0 + 64) * AT_VPITCH + vseg * 16) = vr1; } while (0)
    auto pv = [&](const unsigned char* vb, const bf16x8 f0, const bf16x8 f1, const bf16x8 f2, const bf16x8 f3) __attribute__((always_inline)) {
        const unsigned char* vl = vb + ql * AT_VPITCH + hh * 16;
        bf16x8 va[4], vc[4];
#define AT_VRD(dst, k) do { _Pragma("unroll") for (int t = 0; t < 4; ++t) dst[t] = *(const bf16x8*)(vl + (32 * t) * AT_VPITCH + (k) * 32); } while (0)
#define AT_VMM(src, f) do { _Pragma("unroll") for (int t = 0; t < 4; ++t) O[t] = __builtin_amdgcn_mfma_f32_32x32x16_bf16(src[t], f, O[t], 0, 0, 0); } while (0)
        AT_VRD(va, 0); AT_VRD(vc, 1);
        __builtin_amdgcn_sched_barrier(0);
        AT_VMM(va, f0);
        __builtin_amdgcn_sched_barrier(0);
        AT_VRD(va, 2);
        __builtin_amdgcn_sched_barrier(0);
        AT_VMM(vc, f1);
        __builtin_amdgcn_sched_barrier(0);
        AT_VRD(vc, 3);
        __builtin_amdgcn_sched_barrier(0);
        AT_VMM(va, f2); AT_VMM(vc, f3);
        __builtin_amdgcn_sched_barrier(0);
#undef AT_VRD
#undef AT_VMM
    };
    typedef unsigned u32x4 __attribute__((ext_vector_type(4)));
    u32x4 pp0 = {0, 0, 0, 0}, pp1 = {0, 0, 0, 0}, pp2 = {0, 0, 0, 0}, pp3 = {0, 0, 0, 0};
    __syncthreads();
    AT_LOAD(0); AT_WRITE(0, 0);
    __syncthreads();
    int vcur = 0;
    for (int j = 0; j < ntb; ++j) {
        const int vprev = vcur == 0 ? 2 : vcur - 1, vnext = vcur == 2 ? 0 : vcur + 1;
        if (j + 1 < ntb) AT_LOAD(j + 1);
        if (late && j >= 1) pv(lds + AT_VBASE + vprev * AT_VBYTES, __builtin_bit_cast(bf16x8, pp0), __builtin_bit_cast(bf16x8, pp1), __builtin_bit_cast(bf16x8, pp2), __builtin_bit_cast(bf16x8, pp3));
        if (j < ntw) {
            const unsigned char* kb = lds + (j & 1) * AT_KBYTES;
            bf16x8 kf[8];
#pragma unroll
            for (int kt = 0; kt < 2; ++kt)
#pragma unroll
                for (int s = 0; s < 4; ++s) kf[kt * 4 + s] = *(const bf16x8*)(kb + (32 * kt + ql) * AT_KPITCH + m * 128 + s * 32 + hh * 16);
            __builtin_amdgcn_sched_barrier(0);
            f32x16 st[2];
#pragma unroll
            for (int kt = 0; kt < 2; ++kt)
#pragma unroll
                for (int r = 0; r < 16; ++r) st[kt][r] = 0.f;
#pragma unroll
            for (int s = 0; s < 4; ++s) {
                st[0] = __builtin_amdgcn_mfma_f32_32x32x16_bf16(kf[s], qf[s], st[0], 0, 0, 0);
                st[1] = __builtin_amdgcn_mfma_f32_32x32x16_bf16(kf[4 + s], qf[s], st[1], 0, 0, 0);
            }
            __builtin_amdgcn_sched_barrier(0);
            float mx = st[0][0];
#pragma unroll
            for (int r = 1; r < 16; ++r) mx = fmaxf(mx, st[0][r]);
#pragma unroll
            for (int r = 0; r < 16; ++r) mx = fmaxf(mx, st[1][r]);
            mx = fmaxf(mx, __shfl_xor(mx, 32));
            if (__any(mx > mrun)) {
                const float mnew_ = fmaxf(mrun, mx), alpha = __builtin_amdgcn_exp2f(mrun - mnew_);
                mrun = mnew_; lrun *= alpha;
#pragma unroll
                for (int t = 0; t < 4; ++t) O[t] *= alpha;
            }
            const float mnew = mrun;
#define AT_PFRAG(dst, kt, s2) do { float e0 = __builtin_amdgcn_exp2f(st[kt][8 * s2 + 0] - mnew), e1 = __builtin_amdgcn_exp2f(st[kt][8 * s2 + 1] - mnew), \
        e2 = __builtin_amdgcn_exp2f(st[kt][8 * s2 + 2] - mnew), e3 = __builtin_amdgcn_exp2f(st[kt][8 * s2 + 3] - mnew), \
        e4 = __builtin_amdgcn_exp2f(st[kt][8 * s2 + 4] - mnew), e5 = __builtin_amdgcn_exp2f(st[kt][8 * s2 + 5] - mnew), \
        e6 = __builtin_amdgcn_exp2f(st[kt][8 * s2 + 6] - mnew), e7 = __builtin_amdgcn_exp2f(st[kt][8 * s2 + 7] - mnew); \
        lrun += ((e0 + e1) + (e2 + e3)) + ((e4 + e5) + (e6 + e7)); \
        dst.x = pk2(e0, e1); dst.y = pk2(e2, e3); dst.z = pk2(e4, e5); dst.w = pk2(e6, e7); } while (0)
            AT_PFRAG(pp0, 0, 0); AT_PFRAG(pp1, 0, 1); AT_PFRAG(pp2, 1, 0); AT_PFRAG(pp3, 1, 1);
#undef AT_PFRAG
            __builtin_amdgcn_sched_barrier(0);
            if (!late) pv(lds + AT_VBASE + vcur * AT_VBYTES, __builtin_bit_cast(bf16x8, pp0), __builtin_bit_cast(bf16x8, pp1), __builtin_bit_cast(bf16x8, pp2), __builtin_bit_cast(bf16x8, pp3));
        }
        if (j + 1 < ntb) AT_WRITE((j + 1) & 1, vnext);
        __syncthreads();
        vcur = vnext;
    }
    if (late) { const int vlast = vcur == 0 ? 2 : vcur - 1;
        pv(lds + AT_VBASE + vlast * AT_VBYTES, __builtin_bit_cast(bf16x8, pp0), __builtin_bit_cast(bf16x8, pp1), __builtin_bit_cast(bf16x8, pp2), __builtin_bit_cast(bf16x8, pp3)); }
    __syncthreads();
#undef AT_LOAD
#undef AT_WRITE
    const float inv = 1.f / (lrun + __shfl_xor(lrun, 32));
    float* xb = (float*)lds + rg * 4096;
    if (m == 1) {
#pragma unroll
        for (int t = 0; t < 4; ++t)
#pragma unroll
            for (int r = 0; r < 16; ++r) xb[(t * 16 + r) * 64 + lane] = O[t][r] * inv;
    }
    __syncthreads();
    if (m == 0) {
        const float lam = lam_of(p, l, lane);
        float ss = 0.f;
#pragma unroll
        for (int t = 0; t < 4; ++t)
#pragma unroll
            for (int r = 0; r < 16; ++r) { const float d = O[t][r] * inv - lam * xb[(t * 16 + r) * 64 + lane]; O[t][r] = d; ss += d * d; }
        attn_store(p, l, tokq, h, hh, O, ss);
    }
}

__device__ __forceinline__ void attn_sample_item(const Params& p, int l, int b, int h, unsigned char* lds) {
    const int tid = tidx(), wid = __builtin_amdgcn_readfirstlane(tid >> 6), lane = tid & 63, ql = lane & 31, hh = lane >> 5;
    const int t = wid & 3, kh = wid >> 2;
    const int tok0 = NPT + b * 32, tokq = tok0 + ql;
    const u16* QB = (const u16*)(p.ws + WS_QB); const u16* KB = (const u16*)(p.ws + WS_KB); const u16* P = (const u16*)(p.ws + WS_P);
    const float* CK = p.in[4] + ((size_t)(l * 16 + b) * 8 + h) * 1024 * 128;
    const float* CV = p.in[5] + ((size_t)(l * 16 + b) * 8 + h) * 1024 * 128;
    float* xo = (float*)lds;
    float* xss = (float*)(lds + 32768);
    typedef unsigned u32x4 __attribute__((ext_vector_type(4)));
    f32x16 O1;
#pragma unroll
    for (int r = 0; r < 16; ++r) O1[r] = 0.f;
    f32x16 O;
    __syncthreads();
    for (int m = 0; m < 2; ++m) {
        bf16x8 qf[4];
#pragma unroll
        for (int s = 0; s < 4; ++s) qf[s] = *(const bf16x8*)(QB + (size_t)tokq * 1024 + h * 128 + m * 64 + 16 * s + 8 * hh);
#pragma unroll
        for (int r = 0; r < 16; ++r) O[r] = 0.f;
        float mrun = -1e30f, lrun = 0.f;
        const int kt0 = kh ? 17 : 0, kt1 = kh ? 33 : 17;
        for (int kt = kt0; kt < kt1; ++kt) {
            f32x16 st;
#pragma unroll
            for (int r = 0; r < 16; ++r) st[r] = 0.f;
            if (kt < 32) {
                const float* kp = CK + (size_t)(kt * 32 + ql) * 128 + m * 64 + 8 * hh;
#pragma unroll
                for (int s = 0; s < 4; ++s) {
                    const float4 x = *(const float4*)(kp + 16 * s), y = *(const float4*)(kp + 16 * s + 4);
                    u32x4 w; w.x = pk2(x.x, x.y); w.y = pk2(x.z, x.w); w.z = pk2(y.x, y.y); w.w = pk2(y.z, y.w);
                    st = __builtin_amdgcn_mfma_f32_32x32x16_bf16(__builtin_bit_cast(bf16x8, w), qf[s], st, 0, 0, 0);
                }
            } else {
                const u16* kp = KB + (size_t)(tok0 + ql) * 1024 + h * 128 + m * 64 + 8 * hh;
#pragma unroll
                for (int s = 0; s < 4; ++s) st = __builtin_amdgcn_mfma_f32_32x32x16_bf16(*(const bf16x8*)(kp + 16 * s), qf[s], st, 0, 0, 0);
            }
            float mx = st[0];
#pragma unroll
            for (int r = 1; r < 16; ++r) mx = fmaxf(mx, st[r]);
            mx = fmaxf(mx, __shfl_xor(mx, 32));
            const float mnew = fmaxf(mrun, mx), alpha = __builtin_amdgcn_exp2f(mrun - mnew);
            mrun = mnew; lrun *= alpha;
            O *= alpha;
            float e[16];
#pragma unroll
            for (int r = 0; r < 16; ++r) { e[r] = __builtin_amdgcn_exp2f(st[r] - mnew); lrun += e[r]; }
#pragma unroll
            for (int s2 = 0; s2 < 2; ++s2) {
                u32x4 pw; pw.x = pk2(e[8 * s2], e[8 * s2 + 1]); pw.y = pk2(e[8 * s2 + 2], e[8 * s2 + 3]); pw.z = pk2(e[8 * s2 + 4], e[8 * s2 + 5]); pw.w = pk2(e[8 * s2 + 6], e[8 * s2 + 7]);
                float v[8];
                if (kt < 32) {
                    const float* vp = CV + (size_t)(kt * 32 + 16 * s2 + 4 * hh) * 128 + 32 * t + ql;
#pragma unroll
                    for (int i = 0; i < 4; ++i) { v[i] = vp[i * 128]; v[4 + i] = vp[(8 + i) * 128]; }
                } else {
                    const u16* vp = P + (size_t)(tok0 + 16 * s2 + 4 * hh) * LDP + 6144 + h * 128 + 32 * t + ql;
#pragma unroll
                    for (int i = 0; i < 4; ++i) { v[i] = bf2f(vp[(size_t)i * LDP]); v[4 + i] = bf2f(vp[(size_t)(8 + i) * LDP]); }
                }
                u32x4 w; w.x = pk2(v[0], v[1]); w.y = pk2(v[2], v[3]); w.z = pk2(v[4], v[5]); w.w = pk2(v[6], v[7]);
                O = __builtin_amdgcn_mfma_f32_32x32x16_bf16(__builtin_bit_cast(bf16x8, w), __builtin_bit_cast(bf16x8, pw), O, 0, 0, 0);
            }
        }
        float* sl = xo + t * 1152;
        if (kh == 1) {
#pragma unroll
            for (int r = 0; r < 16; ++r) sl[r * 64 + lane] = O[r];
            sl[1024 + lane] = mrun; sl[1088 + lane] = lrun;
        }
        __syncthreads();
        if (kh == 0) {
            const float mo = sl[1024 + lane], lo = sl[1088 + lane];
            const float mnew = fmaxf(mrun, mo), a = __builtin_amdgcn_exp2f(mrun - mnew), ao = __builtin_amdgcn_exp2f(mo - mnew);
            lrun = lrun * a + lo * ao;
            const float inv = 1.f / (lrun + __shfl_xor(lrun, 32));
#pragma unroll
            for (int r = 0; r < 16; ++r) O[r] = (O[r] * a + sl[r * 64 + lane] * ao) * inv;
            if (m == 0) O1 = O;
        }
        __syncthreads();
    }
    float ss = 0.f;
    if (kh == 0) {
        const float lam = lam_of(p, l, lane);
#pragma unroll
        for (int r = 0; r < 16; ++r) { const float d = O1[r] - lam * O[r]; O[r] = d; ss += d * d; }
        ss += __shfl_xor(ss, 32);
        if (hh == 0) xss[t * 32 + ql] = ss;
    }
    __syncthreads();
    if (kh == 0) {
        const float tot = xss[ql] + xss[32 + ql] + xss[64 + ql] + xss[96 + ql];
        const float sc = rsqrtf(tot * (1.f / 128.f) + EPSF) * (1.f - lam_init_of(l));
        const u16* zp = (const u16*)(p.ws + WS_P) + (size_t)tokq * LDP + 7168 + h * 128;
        u16* op = (u16*)(p.ws + WS_OBN) + (size_t)tokq * 1024 + h * 128;
        const float* dw = p.in[17] + l * 128;
#pragma unroll
        for (int g = 0; g < 4; ++g) {
            const int vc = 32 * t + 8 * g + 4 * hh;
            const uint2 z = *(const uint2*)(zp + vc); const float4 w = *(const float4*)(dw + vc);
            const float o0 = O[4 * g] * sc * w.x * siluf(bflo(z.x)), o1 = O[4 * g + 1] * sc * w.y * siluf(bfhi(z.x));
            const float o2 = O[4 * g + 2] * sc * w.z * siluf(bflo(z.y)), o3 = O[4 * g + 3] * sc * w.w * siluf(bfhi(z.y));
            *(uint2*)(op + vc) = make_uint2(pk2(o0, o1), pk2(o2, o3));
        }
    }
}

__device__ __forceinline__ void phase_cat(const Params& p, int l, unsigned char* lds, int sub) {
    const int bid = bidx(), nb = gridDim.x;
    uint4 t0, t1, t2, t3, t4, t5; float gpre, bpre;
    if (bid < NITEM) gdn_chunk_load(p, bid, t0, t1, t2, t3, t4, t5, gpre, bpre);
#if defined(REP_SUB)
    if (sub != 7) { for (int it = bid; it < NITEM; it += nb) gdn_chunk_item(p, it, it + nb < NITEM ? it + nb : -1, lds, t0, t1, t2, t3, t4, t5, gpre, bpre, REP_SUB); return; }
#endif
    for (int it = bid; it < NITEM; it += nb) gdn_chunk_item(p, it, it + nb < NITEM ? it + nb : -1, lds, t0, t1, t2, t3, t4, t5, gpre, bpre);
}
constexpr int QCTR_OFF = 12288;
__device__ __forceinline__ int queue_pop(unsigned* ctr, unsigned char* lds) {
    __syncthreads();
    if (tidx() == 0) *(volatile int*)(lds + LDS_BYTES - 16) = (int)atomicAdd(ctr, 1u);
    __syncthreads();
    return *(volatile int*)(lds + LDS_BYTES - 16);
}
__device__ __forceinline__ void phase_scan(const Params& p, int l, unsigned char* lds, int sub) {
    const int wid = __builtin_amdgcn_readfirstlane(tidx() >> 6), bid = bidx(), nb = gridDim.x;
    const int npb = nb > 64 ? 64 : nb;
    if (bid < npb) for (int it = bid; it < 64; it += npb) gdn_scan_block(p, l, it >> 5, (it >> 2) & 7, it & 3, lds);
    unsigned* ctr = (unsigned*)(p.ws + WS_GLAST + QCTR_OFF) + l;
    for (;;) {
        const int it = queue_pop(ctr, lds);
        if (it >= 128 + 1024 + 128) break;
        if (it < 128) attn_sample_item(p, l, it >> 3, it & 7, lds);
        else if (it < 128 + 1024) { const int j = it - 128, qb = 63 - (j >> 4), bh = j & 15; attn_prompt_item(p, l, bh >> 3, bh & 7, qb, lds); }
        else {
            const int wi = (it - 1152) * 8 + wid, cb = wi & 7, h = (wi >> 3) & 7, b = wi >> 6;
            const size_t so = ((size_t)(l * 16 + b) * 8 + h) * 16384;
            gdn_scan_item(p, l, 256 + b, 1, h, cb, p.in[6] + so, p.out + O_SSMS + so, 32);
        }
    }
}

#define XB_TMO      128
#define XB_XCNT(j)  (256  + 64 * (j))
#define XB_XSUB(j)  (1280 + 64 * (j))
#define XB_XGEN(j)  (2304 + 64 * (j))
#define XB_TOP      3328
#define XB_TOPGEN   3392
#define XCD_BAR_WORDS 3456
#define XB_SPIN_CAP (1u << 18)
#define LAS __attribute__((address_space(3)))

__device__ __forceinline__ unsigned xb_ld(unsigned* p)              { return __hip_atomic_load(p, __ATOMIC_RELAXED, __HIP_MEMORY_SCOPE_AGENT); }
__device__ __forceinline__ unsigned xb_add(unsigned* p, unsigned v) { return __hip_atomic_fetch_add(p, v, __ATOMIC_RELAXED, __HIP_MEMORY_SCOPE_AGENT); }
__device__ __forceinline__ unsigned xb_xcc_id() { return (unsigned)__builtin_amdgcn_s_getreg((3 << 11) | 20) & 0xFu; }
#define XB_SPIN(cond, bar) do { unsigned _sp = 0; while (cond) { __builtin_amdgcn_s_sleep(1); \
    if ((++_sp & 255u) == 0u) { if (xb_ld(&(bar)[XB_TMO])) break; if (_sp > XB_SPIN_CAP) { atomicAdd(&(bar)[XB_TMO], 1u); break; } } } } while (0)

struct XcdBarrier {
    unsigned* bar; unsigned x;
    volatile LAS unsigned* st;
};

__device__ __forceinline__ XcdBarrier xcd_barrier_post(unsigned* bar, volatile LAS unsigned* st) {
    XcdBarrier b; b.bar = bar; b.x = xb_xcc_id(); b.st = st;
    if (tidx() == 0) (void)xb_add(&bar[XB_XCNT(b.x)], 1u);
    return b;
}
__device__ __forceinline__ void xcd_barrier_complete(unsigned* bar, unsigned x, unsigned& nloc, unsigned& nx) {
    const unsigned G = gridDim.x * gridDim.y * gridDim.z;
    unsigned sum, cnt, mine, sp = 0u;
    for (;;) {
        sum = 0u; cnt = 0u; mine = 0u;
#pragma unroll
        for (unsigned j = 0; j < 16; ++j) { const unsigned c = xb_ld(&bar[XB_XCNT(j)]); sum += c; cnt += (c > 0u) ? 1u : 0u; mine = (j == x) ? c : mine; }
        if (sum == G) break;
        __builtin_amdgcn_s_sleep(1);
        if ((++sp & 255u) == 0u) { if (xb_ld(&bar[XB_TMO])) break; if (sp > XB_SPIN_CAP) { atomicAdd(&bar[XB_TMO], 1u); break; } }
    }
    nloc = mine > 0u ? mine : 1u; nx = cnt > 0u ? cnt : 1u;
}

__device__ __forceinline__ void xcd_barrier(const XcdBarrier& b) {
    asm volatile("s_waitcnt vmcnt(0)" ::: "memory");
    __syncthreads();
    if (tidx() == 0) {
        unsigned* bar = b.bar;
        __builtin_amdgcn_s_waitcnt(0);
        unsigned nloc = b.st[0], nx = b.st[1];
        if (nloc == 0u) { xcd_barrier_complete(bar, b.x, nloc, nx); b.st[0] = nloc; b.st[1] = nx; }
        const unsigned old = xb_add(&bar[XB_XSUB(b.x)], 1u);
        const unsigned gen = old / nloc;
        if (old + 1u == (gen + 1u) * nloc) {
            __builtin_amdgcn_fence(__ATOMIC_RELEASE, "agent");
            asm volatile("s_waitcnt vmcnt(0)" ::: "memory");
            const unsigned og = xb_add(&bar[XB_TOP], 1u);
            const unsigned tg = og / nx;
            if (og + 1u == (tg + 1u) * nx) xb_add(&bar[XB_TOPGEN], 1u);
            else XB_SPIN(xb_ld(&bar[XB_TOPGEN]) == tg, bar);
            __builtin_amdgcn_fence(__ATOMIC_ACQUIRE, "agent");
            xb_add(&bar[XB_XGEN(b.x)], 1u);
            asm volatile("s_waitcnt vmcnt(0)" ::: "memory");
        } else {
            XB_SPIN(xb_ld(&bar[XB_XGEN(b.x)]) == gen, bar);
            __builtin_amdgcn_fence(__ATOMIC_ACQUIRE, "agent");
            asm volatile("s_waitcnt vmcnt(0)" ::: "memory");
        }
    }
    __syncthreads();
}

__global__ void __launch_bounds__(512, 2) fwd_kernel(Params p) {
    extern __shared__ __attribute__((aligned(16))) unsigned char lds[];
    cg::grid_group grid = cg::this_grid();
    if (tidx() == 0) { *(volatile unsigned*)(lds + LDS_BYTES - 32) = 0u; *(volatile unsigned*)(lds + LDS_BYTES - 28) = 0u; }
    __syncthreads();
    XcdBarrier xb = xcd_barrier_post((unsigned*)(p.ws + WS_BAR), (volatile LAS unsigned*)(lds + LDS_BYTES - 32));
    for (int ph = p.ph_lo; ph < p.ph_hi; ++ph) {
#ifdef REP_KIND
      const int nrep = ((ph == 0 ? 0 : (ph == 33 ? 9 : 1 + ((ph - 1) & 7))) == REP_KIND) ? 2 : 1;
      for (int rep = 0; rep < nrep; ++rep) {
        if (rep) grid.sync();
#endif
#ifndef ONLY
#define ONLY -1
#endif
#define EN(k) (ONLY < 0 || ONLY == (k))
#if defined(REP_KIND) && defined(REP_SUB)
#define CATSUB (rep ? REP_SUB : 7)
#else
#define CATSUB 7
#endif
        if (ph == 0) { if (EN(0)) phase_prep(p, lds); }
        else if (ph == 33) { if (EN(9)) phase_final(p); }
        else {
            const int l = (ph - 1) >> 3, k = (ph - 1) & 7;
            const u16* WTIN = (const u16*)(p.ws + WS_WTIN) + (size_t)l * LDP * 1024;
            if (k == 0) { if (EN(1)) phase_norm(p, l); }
            else if (k == 1) { if (EN(2)) { EpiP E; E.O = (u16*)(p.ws + WS_P); run_gemm(lds, (const u16*)(p.ws + WS_H), WTIN, NTOK, LDP, E); } }
            else if (k == 2) { if (EN(3)) phase_post1(p, l, lds); }
            else if (k == 3) { if (EN(4)) phase_cat(p, l, lds, CATSUB); }
            else if (k == 4) { if (EN(5)) phase_scan(p, l, lds, CATSUB); }
            else if (k == 5) { if (EN(6)) phase_post2(p, l); }
            else if (k == 6) { if (EN(7)) {
                EpiG2<0> E0; E0.P = (const u16*)(p.ws + WS_P); E0.T1 = (float*)(p.ws + WS_T1); E0.MG = (u16*)(p.ws + WS_MERGED);
                run_gemm(lds, (const u16*)(p.ws + WS_OAN), (const u16*)(p.ws + WS_WTPA) + (size_t)l * 1048576, NTOK, 1024, E0);
                __syncthreads();
                EpiG2<1> E1; E1.P = E0.P; E1.T1 = E0.T1; E1.MG = E0.MG;
                run_gemm(lds, (const u16*)(p.ws + WS_OBN), (const u16*)(p.ws + WS_WTPB) + (size_t)l * 1048576, NTOK, 1024, E1); }
            } else if (EN(8)) {
                EpiG3 E; E.X = (float*)(p.ws + WS_X); E.MODL = (const float*)(p.ws + WS_MOD) + (size_t)l * 18 * 3072;
                run_gemm(lds, (const u16*)(p.ws + WS_MERGED), (const u16*)(p.ws + WS_WTOUT) + (size_t)l * 1048576, NTOK, 1024, E);
            }
        }
#ifdef REP_KIND
      }
#endif
        if (ph + 1 < p.ph_hi) { if (ph == p.ph_lo) grid.sync(); else xcd_barrier(xb); }
#ifdef EXTRA_SYNC
        if (ph + 1 < p.ph_hi) { xcd_barrier(xb); xcd_barrier(xb); xcd_barrier(xb); }
#endif
    }
}

#ifndef MEGA
#define MEGA 1
#endif
extern "C" void kernel_launch(void* const* d_in, const int* in_sizes, int n_in, void* d_out, int out_size, void* d_ws, size_t ws_size, hipStream_t stream) {
    static int grid = 0;
    if (grid == 0) {
        int dev = 0, cus = 0;
        hipGetDevice(&dev);
        hipDeviceGetAttribute(&cus, hipDeviceAttributeMultiprocessorCount, dev);
        if (hipFuncSetAttribute((const void*)fwd_kernel, hipFuncAttributeMaxDynamicSharedMemorySize, LDS_BYTES) != hipSuccess) fprintf(stderr, "hipFuncSetAttribute failed\n");
        int per_cu = 0;
        hipOccupancyMaxActiveBlocksPerMultiprocessor(&per_cu, (const void*)fwd_kernel, 512, LDS_BYTES);
        if (per_cu < 1) fprintf(stderr, "occupancy query says %d blocks per CU\n", per_cu);
        (void)hipGetLastError();
        grid = cus > 0 ? cus : 256;
        if (ws_size < WS_END) fprintf(stderr, "workspace too small: %zu < %zu\n", ws_size, (size_t)WS_END);
    }
    Params p{};
    for (int i = 0; i < 22; ++i) p.in[i] = (const float*)d_in[i];
    p.out = (float*)d_out; p.ws = (unsigned char*)d_ws;
#if MEGA
    p.ph_lo = 0; p.ph_hi = 34;
    if (hipMemsetAsync((unsigned char*)d_ws + WS_BAR, 0, XCD_BAR_WORDS * 4, stream) != hipSuccess) fprintf(stderr, "memset of barrier words failed\n");
    void* args[] = {&p};
    hipError_t e = hipLaunchCooperativeKernel((const void*)fwd_kernel, dim3(grid), dim3(512), args, LDS_BYTES, stream);
    if (e != hipSuccess) fprintf(stderr, "cooperative launch failed: %s (grid %d)\n", hipGetErrorString(e), grid);
#else
    for (int ph = 0; ph < 34; ++ph) {
        p.ph_lo = ph; p.ph_hi = ph + 1;
        hipLaunchKernelGGL(fwd_kernel, dim3(grid), dim3(512), LDS_BYTES, stream, p);
    }
#endif
}
```

```cpp
#include <hip/hip_runtime.h>
#include <hip/hip_cooperative_groups.h>
#include <cstdio>
namespace cg = cooperative_groups;

typedef unsigned short u16;

constexpr int DM = 1024, NPT = 16384, NTOK = 16896, SEQ = 8192, LDP = 10496;
constexpr float EPSF = 1e-6f;
constexpr float QSCALE = 0.125f * 1.44269504088896340736f;

constexpr size_t O_Y = 0, O_KP = 17301504, O_VP = 84410368, O_SSMP = 151519232, O_CONVP = 152567808,
                 O_KS = 152641536, O_VS = 154738688, O_SSMS = 156835840, O_CONVS = 165224448;

constexpr size_t SZ_TOKBF = (size_t)NTOK * 1024 * 2;
constexpr size_t WS_WTIN = 0;
constexpr size_t WS_WTPA = WS_WTIN + (size_t)4 * LDP * 1024 * 2;
constexpr size_t WS_WTPB = WS_WTPA + (size_t)4 * 1024 * 1024 * 2;
constexpr size_t WS_WTOUT = WS_WTPB + (size_t)4 * 1024 * 1024 * 2;
constexpr size_t WS_MOD = WS_WTOUT + (size_t)4 * 1024 * 1024 * 2;
constexpr size_t WS_CS = WS_MOD + (size_t)4 * 18 * 3072 * 4;
constexpr size_t WS_X = WS_CS + (size_t)8192 * 32 * 8;
constexpr size_t WS_P = WS_X + (size_t)NTOK * 1024 * 4;
constexpr size_t WS_BETA = WS_P + (size_t)NTOK * LDP * 2;
constexpr size_t WS_GLOG = WS_BETA + (size_t)NTOK * 8 * 4;
constexpr size_t WS_R1 = WS_GLOG + (size_t)NTOK * 8 * 4;
constexpr size_t WS_QA = WS_R1, WS_KA = WS_R1 + SZ_TOKBF, WS_VA = WS_R1 + 2 * SZ_TOKBF;
constexpr size_t WS_T1 = WS_R1, WS_MERGED = WS_R1 + 2 * SZ_TOKBF;
constexpr size_t WS_QB = WS_R1 + 3 * SZ_TOKBF;
constexpr size_t WS_OAN = WS_QB;
constexpr size_t WS_KB = WS_QB + SZ_TOKBF;
constexpr size_t WS_VT = WS_KB + SZ_TOKBF;
constexpr int NITEM = 2176;
constexpr size_t WS_VNT = WS_VT + (size_t)2 * 8 * 128 * 8192 * 2;
constexpr size_t WS_KCUM = WS_VNT + (size_t)NITEM * 16384;
constexpr size_t WS_QD = WS_KCUM + (size_t)NITEM * 16384;
constexpr size_t WS_KDT = WS_QD + (size_t)NITEM * 16384;
constexpr size_t WS_QKM = WS_KDT + (size_t)NITEM * 16384;
constexpr size_t WS_GLAST = WS_QKM + (size_t)NITEM * 8192;
constexpr size_t WS_ORAW = WS_GLAST + 16384;
constexpr size_t WS_H = WS_ORAW;
constexpr size_t WS_OBN = WS_ORAW + (size_t)NTOK * 1024 * 4;
constexpr size_t WS_BAR = WS_OBN + SZ_TOKBF;
constexpr size_t WS_END = WS_BAR + 16384;
static_assert(WS_END <= (size_t)1073741824, "workspace too large");
static_assert(WS_P % 256 == 0 && WS_R1 % 256 == 0 && WS_VNT % 256 == 0 && WS_ORAW % 256 == 0 && WS_OBN % 256 == 0, "align");

constexpr int LDS_BYTES = 163840;

struct Params {
    const float* in[22];
    float* out;
    unsigned char* ws;
    int ph_lo, ph_hi;
};

typedef short bf16x8 __attribute__((ext_vector_type(8)));
typedef float f32x4 __attribute__((ext_vector_type(4)));
typedef float f32x16 __attribute__((ext_vector_type(16)));

__device__ __forceinline__ float bf2f(u16 b) { return __uint_as_float(((unsigned)b) << 16); }
__device__ __forceinline__ float bflo(unsigned w) { return __uint_as_float(w << 16); }
__device__ __forceinline__ float bfhi(unsigned w) { return __uint_as_float(w & 0xffff0000u); }
__device__ __forceinline__ unsigned pk2(float lo, float hi) { unsigned r; asm("v_cvt_pk_bf16_f32 %0, %1, %2" : "=v"(r) : "v"(lo), "v"(hi)); return r; }
__device__ __forceinline__ u16 f2bf(float f) { return (u16)(pk2(f, 0.f) & 0xffffu); }
__device__ __forceinline__ float wave_sum(float v) {
#pragma unroll
    for (int o = 32; o; o >>= 1) v += __shfl_xor(v, o);
    return v;
}
__device__ __forceinline__ float siluf(float x) { return x / (1.f + __expf(-x)); }
__device__ __forceinline__ float sigmf(float x) { return 1.f / (1.f + __expf(-x)); }
__device__ __forceinline__ int seq_of(int tok) { return tok < NPT ? (tok >> 13) : 2 + ((tok - NPT) >> 5); }
__device__ __forceinline__ int pos_of(int tok) { return tok < NPT ? (tok & 8191) : 1024 + ((tok - NPT) & 31); }
__device__ __forceinline__ float lam_init_of(int l) { return 0.8f - 0.6f * __expf(-0.3f * (float)l); }

__device__ __forceinline__ int tidx() { int t = (int)__builtin_amdgcn_workitem_id_x(); asm volatile("" : "+v"(t)); return t; }
__device__ __forceinline__ int bidx() { int b = (int)__builtin_amdgcn_workgroup_id_x(); asm volatile("" : "+s"(b)); return b; }

__device__ __forceinline__ int permk(int x) { const int e = x & 31, q = e >> 2; return (x & ~31) | ((q < 4 ? 2 * q : 2 * (q - 4) + 1) << 2) | (e & 3); }

namespace pg8 {
#define PG8_LAS __attribute__((address_space(3)))
typedef unsigned short bf16_t;
typedef unsigned u32x4 __attribute__((ext_vector_type(4)));
constexpr int BM = 256, BK = 64, HALF = 128, HTB = HALF * BK * 2  , STAGE_BYTES = 8 * HTB, NXCD = 8, WGM = 8;

__host__ __device__ __forceinline__ int lds_byte(int r, int c) { const int st = (r >> 4) * 2 + (c >> 5), rr = r & 15, cc = c & 31, ob = rr * 64 + cc * 2; return st * 1024 + (ob ^ (((ob >> 9) & 1) << 5)); }
__host__ __device__ __forceinline__ void stage_rc(int b, int& R, int& C) { const int st = b / 1024, sb = b % 1024, swz = sb ^ (((sb >> 9) & 1) << 5); R = (st >> 1) * 16 + swz / 64; C = (st & 1) * 32 + (swz % 64) / 2; }
__host__ __device__ __forceinline__ int perm32(int rho) { const int n = rho >> 4, i = rho & 15; return 8 * (i >> 2) + 4 * n + (i & 3); }

struct Unit { int pm, pn; };
struct Gemm { const bf16_t* A; const bf16_t* Bt; int M, N, K; };

struct StaticOrder {
    int nM, nN, nwg, G, c;
    __host__ __device__ void init(int M, int N, int G_, int c_) { nM = M / BM; nN = N / BM; nwg = nM * nN; G = G_; c = c_; }
    __host__ __device__ bool next(int i, Unit& u) const {
        const long L = (long)i * G + c; if (L >= nwg) return false;
        int wgid = (int)L; { const int q = nwg / NXCD, r = nwg % NXCD, xcd = wgid % NXCD, off = wgid / NXCD; wgid = (xcd < r ? xcd * (q + 1) : r * (q + 1) + (xcd - r) * q) + off; }
        const int nig = WGM * nN, gid = wgid / nig, fm = gid * WGM, gsz = (nM - fm) < WGM ? (nM - fm) : WGM;
        u.pm = fm + ((wgid % nig) % gsz); u.pn = (wgid % nig) / gsz; return true;
    }
    __device__ __forceinline__ void a_ready(const Unit&) const {}
    __device__ __forceinline__ void done(const Unit&) const {}
};

template <class Epi, class Sched, bool STAMP = false>
__device__ __forceinline__ void gemm_phase(PG8_LAS unsigned char* lds, const Gemm g, const Sched& S, const Epi& E, unsigned long long* stamps) {
    const int tid = tidx(), wid = __builtin_amdgcn_readfirstlane(tid >> 6), lane = tid & 63, wr = wid >> 2, wc = wid & 3, fr = lane & 15, fq = lane >> 4;
    const int K = g.K, nt = K / BK;
    int ts_lo = 0, ts_hi = 0, nts = 0; const unsigned long long rt_entry = STAMP ? (unsigned long long)wall_clock64() : 0ull;
#define PG8_STAMP() do { if (STAMP && wid == 0 && nts < 64) { const unsigned long long _c = (unsigned long long)clock64(); \
        ts_lo = (lane == nts) ? (int)(unsigned)_c : ts_lo; ts_hi = (lane == nts) ? (int)(unsigned)(_c >> 32) : ts_hi; ++nts; } } while (0)
    PG8_STAMP();
    unsigned voffA[2], voffB[2];
#pragma unroll
    for (int i = 0; i < 2; ++i) { int R, C; stage_rc(tid * 16 + i * 8192, R, C); const int Rb = Epi::PERM ? ((R & ~31) + perm32(R & 31)) : R;
        voffA[i] = (unsigned)(R * K + C) * 2u; voffB[i] = (unsigned)(Rb * K + C) * 2u; }
    const size_t kstep = (size_t)(BK * 2);
    const size_t hstep = (size_t)HALF * K * 2;
    const size_t tstep = 2 * hstep;
    const unsigned ldsw = (unsigned)wid * 1024u;
    const int aoff = lds_byte(wr * 64 + fr, fq * 8), boff = lds_byte(wc * 32 + fr, fq * 8);
#define PG8_SA(b, h) (((b) * 2 + (h)) * HTB)
#define PG8_SB(b, h) ((4 + (b) * 2 + (h)) * HTB)
#define PG8_STAGE(bufoff, gbase, voff) do { _Pragma("unroll") for (int _i = 0; _i < 2; ++_i) \
        __builtin_amdgcn_global_load_lds((const unsigned*)((const char*)(gbase) + (voff)[_i]), (PG8_LAS unsigned*)(lds + (bufoff) + ldsw + _i * 8192), 16, 0, 0); } while (0)
#define PG8_LDA(dst, b, h) do { _Pragma("unroll") for (int m = 0; m < 4; ++m) _Pragma("unroll") for (int k = 0; k < 2; ++k) dst[m][k] = *(const PG8_LAS bf16x8*)(lds + PG8_SA(b, h) + aoff + m * 2048 + k * 1024); } while (0)
#define PG8_LDB(dst, b, h) do { _Pragma("unroll") for (int n = 0; n < 2; ++n) _Pragma("unroll") for (int k = 0; k < 2; ++k) dst[n][k] = *(const PG8_LAS bf16x8*)(lds + PG8_SB(b, h) + boff + n * 2048 + k * 1024); } while (0)
#define PG8_MMA(ai, bj, At, Bt) do { __builtin_amdgcn_s_setprio(1); _Pragma("unroll") for (int k = 0; k < 2; ++k) _Pragma("unroll") for (int m = 0; m < 4; ++m) _Pragma("unroll") for (int n = 0; n < 2; ++n) \
        acc[ai][bj][m][n] = __builtin_amdgcn_mfma_f32_16x16x32_bf16(Bt[n][k], At[m][k], acc[ai][bj][m][n], 0, 0, 0); __builtin_amdgcn_s_setprio(0); } while (0)
#define PG8_WAIT_V(n) asm volatile("s_waitcnt vmcnt(" #n ")" ::: "memory")
#define PG8_WAIT_L(n) asm volatile("s_waitcnt lgkmcnt(" #n ")" ::: "memory")
#define PG8_BAR __builtin_amdgcn_s_barrier()
#define PG8_SCHED __builtin_amdgcn_sched_barrier(0)
    Unit cur, nxt; int ui = 0;
    if (!S.next(0, cur)) return;
    f32x4 acc[2][2][4][2];
#pragma unroll
    for (int a = 0; a < 2; ++a)
#pragma unroll
        for (int b = 0; b < 2; ++b)
#pragma unroll
            for (int m = 0; m < 4; ++m)
#pragma unroll
                for (int n = 0; n < 2; ++n) acc[a][b][m][n] = (f32x4){0.f, 0.f, 0.f, 0.f};
    bf16x8 At[4][2], B0[2][2], B1[2][2];
    const char* cA = (const char*)g.A + (size_t)cur.pm * tstep; const char* cB = (const char*)g.Bt + (size_t)cur.pn * tstep;
    S.a_ready(cur);
    PG8_STAGE(PG8_SB(0, 0), cB, voffB); PG8_STAGE(PG8_SA(0, 0), cA, voffA); PG8_STAGE(PG8_SB(0, 1), cB + hstep, voffB); PG8_STAGE(PG8_SA(0, 1), cA + hstep, voffA);
    if (wr == 1) PG8_BAR;
    PG8_WAIT_V(4); PG8_BAR;
    PG8_STAGE(PG8_SB(1, 0), cB + kstep, voffB); PG8_STAGE(PG8_SA(1, 0), cA + kstep, voffA); PG8_STAGE(PG8_SB(1, 1), cB + hstep + kstep, voffB);
    PG8_WAIT_V(6); PG8_BAR;
    PG8_STAMP();
    for (;;) {
        const bool has_next = S.next(ui + 1, nxt);
        const char* nA = has_next ? (const char*)g.A + (size_t)nxt.pm * tstep : cA; const char* nB = has_next ? (const char*)g.Bt + (size_t)nxt.pn * tstep : cB;
        for (int t = 0; t < nt; t += 2) {
            const bool last = (t == nt - 2);
            const char* a1 = cA + (size_t)(t + 1) * kstep;
            const char* a2 = last ? nA : cA + (size_t)(t + 2) * kstep; const char* b2 = last ? nB : cB + (size_t)(t + 2) * kstep;
            const char* a3 = a2 + kstep; const char* b3 = b2 + kstep;
            if (last && has_next) S.a_ready(nxt);
            PG8_LDB(B0, 0, 0); PG8_SCHED; PG8_LDA(At, 0, 0); PG8_STAGE(PG8_SA(1, 1), a1 + hstep, voffA);
            PG8_WAIT_L(8); PG8_BAR; PG8_WAIT_L(0); PG8_MMA(0, 0, At, B0); PG8_BAR; PG8_SCHED;
            PG8_LDB(B1, 0, 1); PG8_STAGE(PG8_SB(0, 0), b2, voffB);
            PG8_BAR; PG8_WAIT_L(0); PG8_MMA(0, 1, At, B1); PG8_BAR;
            PG8_LDA(At, 0, 1); PG8_STAGE(PG8_SA(0, 0), a2, voffA);
            PG8_BAR; PG8_WAIT_L(0); PG8_MMA(1, 0, At, B0); PG8_BAR; PG8_SCHED;
            PG8_STAGE(PG8_SB(0, 1), b2 + hstep, voffB);
            PG8_WAIT_V(6); PG8_BAR; PG8_MMA(1, 1, At, B1); PG8_BAR;
            PG8_LDB(B0, 1, 0); PG8_SCHED; PG8_LDA(At, 1, 0); PG8_STAGE(PG8_SA(0, 1), a2 + hstep, voffA);
            PG8_WAIT_L(8); PG8_BAR; PG8_WAIT_L(0); PG8_MMA(0, 0, At, B0); PG8_BAR; PG8_SCHED;
            PG8_LDB(B1, 1, 1); PG8_STAGE(PG8_SB(1, 0), b3, voffB);
            PG8_BAR; PG8_WAIT_L(0); PG8_MMA(0, 1, At, B1); PG8_BAR;
            PG8_LDA(At, 1, 1); PG8_STAGE(PG8_SA(1, 0), a3, voffA);
            PG8_BAR; PG8_WAIT_L(0); PG8_MMA(1, 0, At, B0); PG8_BAR; PG8_SCHED;
            PG8_STAGE(PG8_SB(1, 1), b3 + hstep, voffB);
            PG8_WAIT_V(6); PG8_BAR; PG8_MMA(1, 1, At, B1); PG8_BAR;
        }
        PG8_STAMP();
        if constexpr (!Epi::AFTER_DRAIN) { E(acc, cur, wr, wc, fr, fq); S.done(cur); }
        PG8_STAMP();
        if (!has_next) break;
#pragma unroll
        for (int a = 0; a < 2; ++a)
#pragma unroll
            for (int b = 0; b < 2; ++b)
#pragma unroll
                for (int m = 0; m < 4; ++m)
#pragma unroll
                    for (int n = 0; n < 2; ++n) acc[a][b][m][n] = (f32x4){0.f, 0.f, 0.f, 0.f};
        cur = nxt; cA = nA; cB = nB; ++ui;
    }
    PG8_WAIT_V(0);
    if (wr == 0) PG8_BAR;
    PG8_BAR;
    if constexpr (Epi::AFTER_DRAIN) { E.fused(acc, cur, wr, wc, fr, fq, lds, wid, lane); S.done(cur); }
    PG8_STAMP();
    if (STAMP && wid == 0) { stamps[lane] = lane < nts ? (((unsigned long long)(unsigned)ts_hi << 32) | (unsigned)ts_lo) : 0ull;
        if (lane == 62) stamps[62] = rt_entry; if (lane == 63) stamps[63] = (unsigned long long)wall_clock64(); }
#undef PG8_STAMP
#undef PG8_SA
#undef PG8_SB
#undef PG8_STAGE
#undef PG8_LDA
#undef PG8_LDB
#undef PG8_MMA
#undef PG8_WAIT_V
#undef PG8_WAIT_L
#undef PG8_BAR
#undef PG8_SCHED
}
}

struct EpiP {
    static constexpr bool PERM = true, AFTER_DRAIN = false;
    u16* O;
    __device__ __forceinline__ void operator()(const f32x4 (&acc)[2][2][4][2], const pg8::Unit& u, int wr, int wc, int fr, int fq) const {
        const int row0 = u.pm * 256 + wr * 64 + fr, col0 = u.pn * 256 + wc * 32 + 8 * fq;
#pragma unroll
        for (int ai = 0; ai < 2; ++ai)
#pragma unroll
            for (int m = 0; m < 4; ++m) { u16* rowp = O + (size_t)(row0 + ai * 128 + m * 16) * LDP + col0;
#pragma unroll
                for (int bj = 0; bj < 2; ++bj) { const f32x4 v0 = acc[ai][bj][m][0], v1 = acc[ai][bj][m][1];
                    uint4 w; w.x = pk2(v0[0], v0[1]); w.y = pk2(v0[2], v0[3]); w.z = pk2(v1[0], v1[1]); w.w = pk2(v1[2], v1[3]);
                    *(uint4*)(rowp + bj * 128) = w; } }
    }
};
template <int MODE> struct EpiG2 {
    static constexpr bool PERM = true, AFTER_DRAIN = false;
    const u16* P; float* T1; u16* MG;
    __device__ __forceinline__ void operator()(const f32x4 (&acc)[2][2][4][2], const pg8::Unit& u, int wr, int wc, int fr, int fq) const {
        const int row0 = u.pm * 256 + wr * 64 + fr, col0 = u.pn * 256 + wc * 32 + 8 * fq;
#pragma unroll
        for (int aq = 0; aq < 4; ++aq) {
            const int ai = aq >> 1, m0 = (aq & 1) * 2;
            uint4 g[4]; float4 ta[4], tb[4];
#pragma unroll
            for (int m = m0; m < m0 + 2; ++m)
#pragma unroll
                for (int bj = 0; bj < 2; ++bj) {
                    const size_t row = (size_t)(row0 + ai * 128 + m * 16); const int col = col0 + bj * 128;
                    g[(m - m0) * 2 + bj] = *(const uint4*)(P + row * LDP + (MODE == 0 ? 8192 : 9216) + col);
                    if (MODE == 1) { const float* tp = T1 + row * 1024 + col; ta[(m - m0) * 2 + bj] = *(const float4*)tp; tb[(m - m0) * 2 + bj] = *(const float4*)(tp + 4); }
                }
            __builtin_amdgcn_sched_barrier(0);
#pragma unroll
            for (int m = m0; m < m0 + 2; ++m)
#pragma unroll
                for (int bj = 0; bj < 2; ++bj) {
                    const size_t row = (size_t)(row0 + ai * 128 + m * 16); const int col = col0 + bj * 128;
                    const uint4 gg = g[(m - m0) * 2 + bj];
                    const f32x4 v0 = acc[ai][bj][m][0], v1 = acc[ai][bj][m][1];
                    const float r0 = sigmf(bflo(gg.x)) * v0[0], r1 = sigmf(bfhi(gg.x)) * v0[1], r2 = sigmf(bflo(gg.y)) * v0[2], r3 = sigmf(bfhi(gg.y)) * v0[3];
                    const float r4 = sigmf(bflo(gg.z)) * v1[0], r5 = sigmf(bfhi(gg.z)) * v1[1], r6 = sigmf(bflo(gg.w)) * v1[2], r7 = sigmf(bfhi(gg.w)) * v1[3];
                    if (MODE == 0) { float* tp = T1 + row * 1024 + col; *(float4*)tp = make_float4(r0, r1, r2, r3); *(float4*)(tp + 4) = make_float4(r4, r5, r6, r7); }
                    else { const float4 x = ta[(m - m0) * 2 + bj], y = tb[(m - m0) * 2 + bj];
                        uint4 w; w.x = pk2(x.x + r0, x.y + r1); w.y = pk2(x.z + r2, x.w + r3); w.z = pk2(y.x + r4, y.y + r5); w.w = pk2(y.z + r6, y.w + r7);
                        *(uint4*)(MG + row * 1024 + col) = w; }
                }
        }
    }
};
struct EpiG3 {
    static constexpr bool PERM = false, AFTER_DRAIN = false;
    float* X; const float* MODL;
    __device__ __forceinline__ void operator()(const f32x4 (&acc)[2][2][4][2], const pg8::Unit& u, int wr, int wc, int fr, int fq) const {
        const int row0 = u.pm * 256 + wr * 64 + fr, col0 = u.pn * 256 + wc * 32 + 4 * fq;
#pragma unroll
        for (int ai = 0; ai < 2; ++ai)
#pragma unroll
            for (int m = 0; m < 4; ++m) { const int row = row0 + ai * 128 + m * 16; const float* gp = MODL + seq_of(row) * 3072 + 2048;
#pragma unroll
                for (int bj = 0; bj < 2; ++bj)
#pragma unroll
                    for (int n = 0; n < 2; ++n) { const int col = col0 + bj * 128 + n * 16;
                        const float4 g = *(const float4*)(gp + col); float4* xp = (float4*)(X + (size_t)row * 1024 + col); float4 x = *xp; const f32x4 a = acc[ai][bj][m][n];
                        x.x += g.x * a[0]; x.y += g.y * a[1]; x.z += g.z * a[2]; x.w += g.w * a[3]; *xp = x; } }
    }
};

template <class Epi> __device__ __forceinline__ void run_gemm(unsigned char* lds, const u16* A, const u16* Bt, int M, int N, const Epi& E) {
    pg8::Gemm g; g.A = A; g.Bt = Bt; g.M = M; g.N = N; g.K = 1024;
    pg8::StaticOrder S; S.init(M, N, (int)gridDim.x, (int)bidx());
    pg8::gemm_phase<Epi, pg8::StaticOrder, false>((PG8_LAS unsigned char*)lds, g, S, E, nullptr);
}

__device__ __forceinline__ void phase_prep(const Params& p, unsigned char* lds) {
    float* ldsf = (float*)lds;
    const int tid = tidx(), nb = gridDim.x, bid = bidx(), wid = tid >> 6, lane = tid & 63;
    if (bid == 0 && tid < 4) ((unsigned*)(p.ws + WS_GLAST + 12288))[tid] = 0u;
    {
        const float4* xp = (const float4*)p.in[0]; const float4* xs = (const float4*)p.in[1];
        float4* X = (float4*)(p.ws + WS_X);
        const size_t n4p = (size_t)NPT * 256, n4 = (size_t)NTOK * 256;
        for (size_t i = (size_t)bid * 512 + tid; i < n4; i += (size_t)nb * 512) X[i] = i < n4p ? xp[i] : xs[i - n4p];
        float2* CS = (float2*)(p.ws + WS_CS);
        for (int i = bid * 512 + tid; i < 8192 * 32; i += nb * 512) {
            const int pos = i >> 5, d = i & 31;
            const float inv = powf(10000.0f, -(float)d / 32.0f);
            const float ang = (float)pos * inv;
            const float kf = rintf(ang * 0.636619772367581343f);
            float r = fmaf(-kf, 1.5707962512969971f, ang); r = fmaf(-kf, 7.5497894158615964e-08f, r); r = fmaf(-kf, 5.3903029534742384e-15f, r);
            const float sr = sinf(r), cr = cosf(r);
            const int q = ((int)kf) & 3;
            float s, c;
            if (q == 0) { s = sr; c = cr; } else if (q == 1) { s = cr; c = -sr; } else if (q == 2) { s = -sr; c = -cr; } else { s = -cr; c = sr; }
            CS[i] = make_float2(c, s);
        }
    }
    {
        const int NT_IN = LDP / 64, per_layer = (NT_IN + 48) * 16;
        for (int it = bid; it < 4 * per_layer; it += nb) {
            const int l = it / per_layer, r = it % per_layer, kt = r & 15; int ntile = r >> 4;
            const float* src; u16* dst; int ldn; bool is_in;
            if (ntile < NT_IN) { is_in = true; src = p.in[11] + (size_t)l * 1024 * 10256; ldn = 10256; dst = (u16*)(p.ws + WS_WTIN) + (size_t)l * LDP * 1024; }
            else { const int q = (ntile - NT_IN) >> 4; ntile = (ntile - NT_IN) & 15; is_in = false; src = p.in[18 + q] + (size_t)l * 1024 * 1024; ldn = 1024;
                   dst = (u16*)(p.ws + (q == 0 ? WS_WTPA : (q == 1 ? WS_WTPB : WS_WTOUT))) + (size_t)l * 1024 * 1024; }
            const int n0 = ntile * 64, k0 = kt * 64;
            __syncthreads();
#pragma unroll
            for (int i = 0; i < 2; ++i) {
                const int kk = (tid >> 4) + 32 * i, nn = (tid & 15) * 4, np = n0 + nn; int sc = np;
                if (is_in) sc = np < 4096 ? np : (np < 10240 ? np + 16 : (np < 10256 ? np - 10240 + 4096 : -1));
                float4 v = make_float4(0.f, 0.f, 0.f, 0.f);
                if (sc >= 0) v = *(const float4*)(src + (size_t)(k0 + kk) * ldn + sc);
                ldsf[kk * 65 + nn] = v.x; ldsf[kk * 65 + nn + 1] = v.y; ldsf[kk * 65 + nn + 2] = v.z; ldsf[kk * 65 + nn + 3] = v.w;
            }
            __syncthreads();
#pragma unroll
            for (int i = 0; i < 4; ++i) {
                const int nn = (tid >> 5) + 16 * i, kk = 2 * (tid & 31);
                *(unsigned*)(dst + (size_t)(n0 + nn) * 1024 + k0 + kk) = pk2(ldsf[kk * 65 + nn], ldsf[(kk + 1) * 65 + nn]);
            }
        }
    }
    {
        __syncthreads();
        for (int i = tid; i < 18 * 1024; i += 512) ldsf[i] = i < 2048 ? p.in[2][i] : p.in[3][i - 2048];
        float* part = ldsf + 18432;
        float* MOD = (float*)(p.ws + WS_MOD);
        __syncthreads();
        for (int it = bid; it < 4 * 48; it += nb) {
            const int l = it / 48, j0 = (it % 48) * 64;
            const float* W = p.in[9] + (size_t)l * 1024 * 3072 + j0 + lane;
            float acc[18];
#pragma unroll
            for (int s = 0; s < 18; ++s) acc[s] = 0.f;
            for (int k = wid * 128; k < wid * 128 + 128; ++k) {
                const float w = W[(size_t)k * 3072];
#pragma unroll
                for (int s = 0; s < 18; ++s) acc[s] = fmaf(ldsf[s * 1024 + k], w, acc[s]);
            }
#pragma unroll
            for (int s = 0; s < 18; ++s) part[(wid * 18 + s) * 64 + lane] = acc[s];
            __syncthreads();
            for (int o = tid; o < 1152; o += 512) {
                const int s = o >> 6, j = o & 63; float v = p.in[10][l * 3072 + j0 + j];
#pragma unroll
                for (int w = 0; w < 8; ++w) v += part[(w * 18 + s) * 64 + j];
                MOD[(size_t)(l * 18 + s) * 3072 + j0 + j] = v;
            }
            __syncthreads();
        }
    }
}

__device__ __forceinline__ void phase_norm(const Params& p, int l) {
    const int wid = tidx() >> 6, lane = tidx() & 63;
    const float* X = (const float*)(p.ws + WS_X);
    const float* nw = p.in[8] + l * 1024;
    const float* MODL = (const float*)(p.ws + WS_MOD) + (size_t)l * 18 * 3072;
    u16* H = (u16*)(p.ws + WS_H);
    for (int tok = bidx() * 8 + wid; tok < NTOK; tok += gridDim.x * 8) {
        const float4* xr = (const float4*)(X + (size_t)tok * 1024);
        float4 v[4]; float ss = 0.f;
#pragma unroll
        for (int i = 0; i < 4; ++i) { v[i] = xr[lane + 64 * i]; ss += v[i].x * v[i].x + v[i].y * v[i].y + v[i].z * v[i].z + v[i].w * v[i].w; }
        ss = wave_sum(ss);
        const float rstd = rsqrtf(ss * (1.f / 1024.f) + EPSF);
        const float* ms = MODL + seq_of(tok) * 3072;
#pragma unroll
        for (int i = 0; i < 4; ++i) {
            const int c = (lane + 64 * i) * 4;
            const float4 w = *(const float4*)(nw + c), sh = *(const float4*)(ms + c), sc = *(const float4*)(ms + 1024 + c);
            const float h0 = v[i].x * rstd * w.x * (1.f + sc.x) + sh.x, h1 = v[i].y * rstd * w.y * (1.f + sc.y) + sh.y;
            const float h2 = v[i].z * rstd * w.z * (1.f + sc.z) + sh.z, h3 = v[i].w * rstd * w.w * (1.f + sc.w) + sh.w;
            *(uint2*)(H + (size_t)tok * 1024 + c) = make_uint2(pk2(h0, h1), pk2(h2, h3));
        }
    }
}

__device__ __forceinline__ void phase_post1(const Params& p, int l, unsigned char* lds) {
    const int tid = tidx(), wid = tid >> 6, lane = tid & 63, nb = gridDim.x, bid = bidx();
    const u16* P = (const u16*)(p.ws + WS_P);
    const int gw = bid * 8 + wid, nw = nb * 8;
    {
        const float* cw = p.in[12] + (size_t)l * 4 * 3072;
        for (int it = gw; it < 2112 * 6; it += nw) {
            const int tg = it / 6, sg = it % 6;
            const int tok0 = tg * 8, slot = sg * 4 + (lane >> 4), ch = slot * 128 + (lane & 15) * 8;
            const int t0 = tok0 < NPT ? (tok0 & 8191) : ((tok0 - NPT) & 31);
            float w[4][8], a[3][8];
#pragma unroll
            for (int j = 0; j < 4; ++j) { const float4 x = *(const float4*)(cw + j * 3072 + ch), y = *(const float4*)(cw + j * 3072 + ch + 4);
                w[j][0] = x.x; w[j][1] = x.y; w[j][2] = x.z; w[j][3] = x.w; w[j][4] = y.x; w[j][5] = y.y; w[j][6] = y.z; w[j][7] = y.w; }
            if (t0 == 0) {
                if (tok0 < NPT) {
#pragma unroll
                    for (int j = 0; j < 3; ++j)
#pragma unroll
                        for (int e = 0; e < 8; ++e) a[j][e] = 0.f;
                } else { const float* sc = p.in[7] + ((size_t)(l * 16 + ((tok0 - NPT) >> 5)) * 3) * 3072 + ch;
#pragma unroll
                    for (int j = 0; j < 3; ++j) { const float4 x = *(const float4*)(sc + j * 3072), y = *(const float4*)(sc + j * 3072 + 4);
                        a[j][0] = x.x; a[j][1] = x.y; a[j][2] = x.z; a[j][3] = x.w; a[j][4] = y.x; a[j][5] = y.y; a[j][6] = y.z; a[j][7] = y.w; } }
            } else {
#pragma unroll
                for (int j = 0; j < 3; ++j) { const uint4 u = *(const uint4*)(P + (size_t)(tok0 - 3 + j) * LDP + ch);
                    a[j][0] = bflo(u.x); a[j][1] = bfhi(u.x); a[j][2] = bflo(u.y); a[j][3] = bfhi(u.y); a[j][4] = bflo(u.z); a[j][5] = bfhi(u.z); a[j][6] = bflo(u.w); a[j][7] = bfhi(u.w); }
            }
            uint4 u[8];
#pragma unroll
            for (int i = 0; i < 8; ++i) u[i] = *(const uint4*)(P + (size_t)(tok0 + i) * LDP + ch);
            float y[8][8], ss[8];
#pragma unroll
            for (int i = 0; i < 8; ++i) {
                const float c[8] = {bflo(u[i].x), bfhi(u[i].x), bflo(u[i].y), bfhi(u[i].y), bflo(u[i].z), bfhi(u[i].z), bflo(u[i].w), bfhi(u[i].w)};
                float acc = 0.f;
#pragma unroll
                for (int e = 0; e < 8; ++e) {
                    const float v = siluf(w[0][e] * a[0][e] + w[1][e] * a[1][e] + w[2][e] * a[2][e] + w[3][e] * c[e]);
                    a[0][e] = a[1][e]; a[1][e] = a[2][e]; a[2][e] = c[e];
                    y[i][e] = v; acc += v * v;
                }
                ss[i] = acc;
            }
            if (sg < 4) {
#pragma unroll
                for (int o = 8; o; o >>= 1)
#pragma unroll
                    for (int i = 0; i < 8; ++i) ss[i] += __shfl_xor(ss[i], o);
                const float post = sg < 2 ? 0.08838834764831845f : 1.f;
#pragma unroll
                for (int i = 0; i < 8; ++i) { const float sc = rsqrtf(ss[i] + EPSF) * post;
#pragma unroll
                    for (int e = 0; e < 8; ++e) y[i][e] *= sc; }
            }
            u16* dst = (u16*)(p.ws + (sg < 2 ? WS_QA : (sg < 4 ? WS_KA : WS_VA))) + (slot & 7) * 128 + (lane & 15) * 8;
#pragma unroll
            for (int i = 0; i < 8; ++i)
                *(uint4*)(dst + (size_t)(tok0 + i) * 1024) = make_uint4(pk2(y[i][0], y[i][1]), pk2(y[i][2], y[i][3]), pk2(y[i][4], y[i][5]), pk2(y[i][6], y[i][7]));
        }
    }
    for (int idx = bid * 512 + tid; idx < 18 * 9216; idx += nb * 512) {
        const int s = idx / 9216, r = idx % 9216, j = r / 3072, c = r % 3072;
        const int tok = s < 2 ? s * 8192 + 8189 + j : NPT + (s - 2) * 32 + 29 + j;
        const float v = bf2f(P[(size_t)tok * LDP + c]);
        if (s < 2) p.out[O_CONVP + ((size_t)(l * 2 + s) * 3 + j) * 3072 + c] = v;
        else p.out[O_CONVS + ((size_t)(l * 16 + s - 2) * 3 + j) * 3072 + c] = v;
    }
    {
        float* BETA = (float*)(p.ws + WS_BETA); float* GLOG = (float*)(p.ws + WS_GLOG);
        for (int idx = bid * 512 + tid; idx < NTOK * 8; idx += nb * 512) {
            const int tok = idx >> 3, h = idx & 7;
            const float ba = bf2f(P[(size_t)tok * LDP + 10240 + h]), aa = bf2f(P[(size_t)tok * LDP + 10248 + h]);
            BETA[idx] = sigmf(ba);
            const float x = aa + p.in[14][l * 8 + h];
            const float sp = fmaxf(x, 0.f) + log1pf(__expf(-fabsf(x)));
            GLOG[idx] = -__expf(p.in[13][l * 8 + h]) * sp;
        }
    }
    {
        const float4* CS4 = (const float4*)(p.ws + WS_CS);
        u16* QB = (u16*)(p.ws + WS_QB); u16* KB = (u16*)(p.ws + WS_KB);
        const int hs = lane >> 4, mq = (lane >> 3) & 1, d4 = (lane & 7) * 4, vc = (lane & 15) * 8;
        for (int it = gw; it < NTOK * 2; it += nw) {
            const int tok = it >> 1, h = (it & 1) * 4 + hs;
            const float4 csa = CS4[(pos_of(tok) * 32 + d4) >> 1], csb = CS4[((pos_of(tok) * 32 + d4) >> 1) + 1];
            const float cc[4] = {csa.x, csa.z, csb.x, csb.z}, sn[4] = {csa.y, csa.w, csb.y, csb.w};
            const u16* pr = P + (size_t)tok * LDP;
            const int cb = h * 128 + mq * 64 + d4;
            const uint2 q1 = *(const uint2*)(pr + 4096 + cb), q2 = *(const uint2*)(pr + 4096 + cb + 32);
            const uint2 k1 = *(const uint2*)(pr + 5120 + cb), k2 = *(const uint2*)(pr + 5120 + cb + 32);
            const uint4 vv = *(const uint4*)(pr + 6144 + h * 128 + vc);
            const float q1f[4] = {bflo(q1.x), bfhi(q1.x), bflo(q1.y), bfhi(q1.y)}, q2f[4] = {bflo(q2.x), bfhi(q2.x), bflo(q2.y), bfhi(q2.y)};
            const float k1f[4] = {bflo(k1.x), bfhi(k1.x), bflo(k1.y), bfhi(k1.y)}, k2f[4] = {bflo(k2.x), bfhi(k2.x), bflo(k2.y), bfhi(k2.y)};
            float qa[4], qb[4], ka[4], kb[4];
#pragma unroll
            for (int e = 0; e < 4; ++e) {
                qa[e] = (q1f[e] * cc[e] - q2f[e] * sn[e]) * QSCALE; qb[e] = (q1f[e] * sn[e] + q2f[e] * cc[e]) * QSCALE;
                ka[e] = k1f[e] * cc[e] - k2f[e] * sn[e]; kb[e] = k1f[e] * sn[e] + k2f[e] * cc[e];
            }
            *(uint2*)(QB + (size_t)tok * 1024 + cb) = make_uint2(pk2(qa[0], qa[1]), pk2(qa[2], qa[3]));
            *(uint2*)(QB + (size_t)tok * 1024 + cb + 32) = make_uint2(pk2(qb[0], qb[1]), pk2(qb[2], qb[3]));
            *(uint2*)(KB + (size_t)tok * 1024 + cb) = make_uint2(pk2(ka[0], ka[1]), pk2(ka[2], ka[3]));
            *(uint2*)(KB + (size_t)tok * 1024 + cb + 32) = make_uint2(pk2(kb[0], kb[1]), pk2(kb[2], kb[3]));
            size_t orow; float* ko; float* vo;
            if (tok < NPT) { orow = ((size_t)(l * 2 + (tok >> 13)) * 8 + h) * 8192 + (tok & 8191); ko = p.out + O_KP; vo = p.out + O_VP; }
            else { const int r = tok - NPT; orow = ((size_t)(l * 16 + (r >> 5)) * 8 + h) * 32 + (r & 31); ko = p.out + O_KS; vo = p.out + O_VS; }
            *(float4*)(ko + orow * 128 + mq * 64 + d4) = make_float4(ka[0], ka[1], ka[2], ka[3]);
            *(float4*)(ko + orow * 128 + mq * 64 + d4 + 32) = make_float4(kb[0], kb[1], kb[2], kb[3]);
            *(float4*)(vo + orow * 128 + vc) = make_float4(bflo(vv.x), bfhi(vv.x), bflo(vv.y), bfhi(vv.y));
            *(float4*)(vo + orow * 128 + vc + 4) = make_float4(bflo(vv.z), bfhi(vv.z), bflo(vv.w), bfhi(vv.w));
        }
    }
    {
        u16* T = (u16*)lds;
        u16* VT = (u16*)(p.ws + WS_VT);
        uint4 pre0 = make_uint4(0, 0, 0, 0), pre1 = pre0;
#define VT_LOAD(it_) do { const int tt_ = (it_) & 127, h_ = ((it_) >> 7) & 7, b_ = (it_) >> 10; \
        pre0 = *(const uint4*)(P + (size_t)(b_ * 8192 + tt_ * 64 + (tid >> 4)) * LDP + 6144 + h_ * 128 + (tid & 15) * 8); \
        pre1 = *(const uint4*)(P + (size_t)(b_ * 8192 + tt_ * 64 + 32 + (tid >> 4)) * LDP + 6144 + h_ * 128 + (tid & 15) * 8); } while (0)
        if (bid < 2048) VT_LOAD(bid);
        for (int it = bid; it < 2048; it += nb) {
            const int tt = it & 127, h = (it >> 7) & 7, b = it >> 10;
            __syncthreads();
            *(uint4*)(T + (tid >> 4) * 136 + (tid & 15) * 8) = pre0; *(uint4*)(T + (32 + (tid >> 4)) * 136 + (tid & 15) * 8) = pre1;
            __syncthreads();
            if (it + nb < 2048) VT_LOAD(it + nb);
            const int c = tid & 127, tq = tid >> 7;
            unsigned w[8];
#pragma unroll
            for (int i = 0; i < 8; ++i) w[i] = (unsigned)T[(tq * 16 + 2 * i) * 136 + c] | ((unsigned)T[(tq * 16 + 2 * i + 1) * 136 + c] << 16);
            u16* o = VT + ((size_t)((b * 8 + h) * 128 + c)) * 8192 + tt * 64 + tq * 16;
            *(uint4*)o = make_uint4(w[0], w[1], w[4], w[5]); *(uint4*)(o + 8) = make_uint4(w[2], w[3], w[6], w[7]);
        }
#undef VT_LOAD
    }
}

__device__ __forceinline__ void gdn_chunk_load(const Params& p, int item, uint4& t0, uint4& t1, uint4& t2, uint4& t3, uint4& t4, uint4& t5, float& g, float& bt) {
    const int tid = tidx(), lane = tid & 63;
    const int ch = item >> 3, h = item & 7;
    const int tok0 = ch < 256 ? ch * 64 : NPT + (ch - 256) * 32, L = ch < 256 ? 64 : 32;
    const int row = (tid >> 4) & 31, seg = tid & 15;
    const uint4 z = make_uint4(0, 0, 0, 0);
    const size_t o0 = (size_t)(tok0 + row) * 1024 + h * 128 + seg * 8, o1 = o0 + (size_t)32 * 1024;
    const bool v1 = (row + 32) < L;
    t0 = *(const uint4*)((const u16*)(p.ws + WS_KA) + o0); t2 = *(const uint4*)((const u16*)(p.ws + WS_QA) + o0); t4 = *(const uint4*)((const u16*)(p.ws + WS_VA) + o0);
    t1 = z; t3 = z; t5 = z;
    if (v1) { t1 = *(const uint4*)((const u16*)(p.ws + WS_KA) + o1); t3 = *(const uint4*)((const u16*)(p.ws + WS_QA) + o1); t5 = *(const uint4*)((const u16*)(p.ws + WS_VA) + o1); }
    g = 0.f; bt = 0.f;
    if (tid < 64 && lane < L) { g = ((const float*)(p.ws + WS_GLOG))[(size_t)(tok0 + lane) * 8 + h]; bt = ((const float*)(p.ws + WS_BETA))[(size_t)(tok0 + lane) * 8 + h]; }
}
__device__ __forceinline__ void gdn_chunk_item(const Params& p, int item, int next_item, unsigned char* lds,
                                               uint4& t0, uint4& t1, uint4& t2, uint4& t3, uint4& t4, uint4& t5, float& gpre, float& bpre, const int skip = 0) {
    const int tid = tidx(), wid = tid >> 6, lane = tid & 63, fr = lane & 15, fq = lane >> 4;
    u16* kT = (u16*)lds; u16* qT = kT + 64 * 136; u16* vT = qT + 64 * 136;
    float* AT = (float*)(lds + 52224); float* Gs = (float*)(lds + 69632); float* Bs = Gs + 64;
    __syncthreads();
    {
        const int row = (tid >> 4) & 31, seg = tid & 15;
        *(uint4*)(kT + row * 136 + seg * 8) = t0; *(uint4*)(kT + (row + 32) * 136 + seg * 8) = t1;
        *(uint4*)(qT + row * 136 + seg * 8) = t2; *(uint4*)(qT + (row + 32) * 136 + seg * 8) = t3;
        *(uint4*)(vT + row * 136 + seg * 8) = t4; *(uint4*)(vT + (row + 32) * 136 + seg * 8) = t5;
    }
    if (wid == 0) {
        float g = gpre;
#pragma unroll
        for (int o = 1; o < 64; o <<= 1) { const float t = __shfl_up(g, o); if (lane >= o) g += t; }
        Gs[lane] = g;
        Bs[lane] = bpre;
    }
    __syncthreads();
    if (next_item >= 0) gdn_chunk_load(p, next_item, t0, t1, t2, t3, t4, t5, gpre, bpre);
    u16* QKM = (u16*)(p.ws + WS_QKM) + (size_t)item * 4096;
    if (!(skip & 2))
#pragma unroll
    for (int u = 0; u < 4; ++u) {
        const int id = wid * 4 + u, which = id >> 4, ti = (id >> 2) & 3, tj = id & 3;
        f32x4 acc = {0.f, 0.f, 0.f, 0.f};
        const u16* Ab = (which ? qT : kT) + (ti * 16 + fr) * 136 + fq * 8;
        const u16* Bb = kT + (tj * 16 + fr) * 136 + fq * 8;
#pragma unroll
        for (int ks = 0; ks < 4; ++ks) acc = __builtin_amdgcn_mfma_f32_16x16x32_bf16(*(const bf16x8*)(Ab + ks * 32), *(const bf16x8*)(Bb + ks * 32), acc, 0, 0, 0);
        const int j = tj * 16 + fr; const float Gj = Gs[j];
#pragma unroll
        for (int r = 0; r < 4; ++r) {
            const int i = ti * 16 + 4 * fq + r; const float Gi = Gs[i];
            if (which == 0) AT[j * 68 + i] = (i > j) ? Bs[i] * acc[r] * __expf(Gi - Gj) : 0.f;
            else QKM[i * 64 + permk(j)] = f2bf((i >= j) ? acc[r] * __expf(Gi - Gj) : 0.f);
        }
    }
    __syncthreads();
    if (tid < 256) { if (!(skip & 1)) {
        const int c = tid;
        int zoff; asm volatile("v_mov_b32 %0, 0" : "=v"(zoff));
        const float* ATz = AT + zoff;
        float* xs = (float*)(lds + 70144) + c;
        const u16* src = c < 128 ? (vT + c) : (kT + c - 128);
        for (int bk = 0; bk < 4; ++bk) {
            float w[16];
#pragma unroll
            for (int ii = 0; ii < 16; ++ii) { const int i = 16 * bk + ii; const float sc = c < 128 ? Bs[i] : Bs[i] * __expf(Gs[i]); w[ii] = sc * bf2f(src[i * 136]); }
#pragma unroll 4
            for (int j = 0; j < 16 * bk; ++j) {
                const float xj = xs[j * 256];
                const float4* ar = (const float4*)(ATz + j * 68 + 16 * bk);
#pragma unroll
                for (int q = 0; q < 4; ++q) { const float4 a4 = ar[q];
                    w[4 * q] = fmaf(-a4.x, xj, w[4 * q]); w[4 * q + 1] = fmaf(-a4.y, xj, w[4 * q + 1]); w[4 * q + 2] = fmaf(-a4.z, xj, w[4 * q + 2]); w[4 * q + 3] = fmaf(-a4.w, xj, w[4 * q + 3]); }
            }
            const float* ad = ATz + (16 * bk) * 69;
            float dg[15][16];
#pragma unroll
            for (int jj = 0; jj < 15; ++jj)
#pragma unroll
                for (int q = (jj + 1) >> 2; q < 4; ++q) { const float4 a4 = *(const float4*)(ad + jj * 68 + 4 * q);
                    dg[jj][4 * q] = a4.x; dg[jj][4 * q + 1] = a4.y; dg[jj][4 * q + 2] = a4.z; dg[jj][4 * q + 3] = a4.w; }
#pragma unroll
            for (int jj = 0; jj < 15; ++jj) {
                const float xj = w[jj];
#pragma unroll
                for (int ii = jj + 1; ii < 16; ++ii) w[ii] = fmaf(-dg[jj][ii], xj, w[ii]);
            }
            if (bk < 3) {
#pragma unroll
                for (int ii = 0; ii < 16; ++ii) xs[(16 * bk + ii) * 256] = w[ii];
            }
            if (c < 128) {
                u16* o = (u16*)(p.ws + WS_VNT) + (size_t)item * 8192 + c * 64 + 16 * bk;
                *(uint4*)o = make_uint4(pk2(w[0], w[1]), pk2(w[2], w[3]), pk2(w[4], w[5]), pk2(w[6], w[7]));
                *(uint4*)(o + 8) = make_uint4(pk2(w[8], w[9]), pk2(w[10], w[11]), pk2(w[12], w[13]), pk2(w[14], w[15]));
            } else {
                u16* o = (u16*)(p.ws + WS_KCUM) + (size_t)item * 8192 + permk(c - 128) + (16 * bk) * 128;
#pragma unroll
                for (int ii = 0; ii < 16; ++ii) o[ii * 128] = f2bf(w[ii]);
            }
        }
    } } else if (!(skip & 4)) {
        const int e = tid - 256;
        u16* QD = (u16*)(p.ws + WS_QD) + (size_t)item * 8192;
        u16* KDT = (u16*)(p.ws + WS_KDT) + (size_t)item * 8192;
        const float Gl = Gs[63];
#pragma unroll 4
        for (int k = 0; k < 16; ++k) {
            const int idx = e + 256 * k;
            { const int i = idx >> 6, dp = (idx & 63) * 2; const float s = __expf(Gs[i]);
              const unsigned u = *(const unsigned*)(qT + i * 136 + dp);
              *(unsigned*)(QD + i * 128 + permk(dp)) = pk2(bflo(u) * s, bfhi(u) * s); }
            { const int d = idx >> 5, jp = (idx & 31) * 2;
              const float v0 = bf2f(kT[jp * 136 + d]) * __expf(Gl - Gs[jp]), v1 = bf2f(kT[(jp + 1) * 136 + d]) * __expf(Gl - Gs[jp + 1]);
              *(unsigned*)(KDT + d * 64 + permk(jp)) = pk2(v0, v1); }
        }
        if (e == 0) ((float*)(p.ws + WS_GLAST))[item] = __expf(Gl);
    }
}

__device__ __forceinline__ bf16x8 ld2(const u16* a) { return *(const bf16x8*)a; }
__device__ __forceinline__ bf16x8 pkfrag(const f32x4& a, const f32x4& b) {
    typedef unsigned u32x4 __attribute__((ext_vector_type(4)));
    u32x4 w; w.x = pk2(a[0], a[1]); w.y = pk2(a[2], a[3]); w.z = pk2(b[0], b[1]); w.w = pk2(b[2], b[3]);
    return __builtin_bit_cast(bf16x8, w);
}
__device__ __forceinline__ void gdn_scan_item(const Params& p, int l, int ch0, int nsteps, int h, int cb, const float* s_init, float* s_out, int L) {
    const int lane = tidx() & 63, fr = lane & 15, fq = lane >> 4, c = cb * 16 + fr;
    f32x4 S[8];
#pragma unroll
    for (int u = 0; u < 8; ++u)
#pragma unroll
        for (int r = 0; r < 4; ++r) S[u][r] = s_init ? s_init[(size_t)(16 * u + 4 * fq + r) * 128 + c] : 0.f;
    float* ORAW = (float*)(p.ws + WS_ORAW);
    for (int st = 0; st < nsteps; ++st) {
        const int ch = ch0 + st, item = ch * 8 + h;
        const int tok0 = ch < 256 ? ch * 64 : NPT + (ch - 256) * 32;
        const u16* kc = (const u16*)(p.ws + WS_KCUM) + (size_t)item * 8192 + fr * 128 + 8 * fq;
        const u16* qd = (const u16*)(p.ws + WS_QD) + (size_t)item * 8192 + fr * 128 + 8 * fq;
        const u16* kdt = (const u16*)(p.ws + WS_KDT) + (size_t)item * 8192 + fr * 64 + 8 * fq;
        const u16* qk = (const u16*)(p.ws + WS_QKM) + (size_t)item * 4096 + fr * 64 + 8 * fq;
        const u16* vnt = (const u16*)(p.ws + WS_VNT) + (size_t)item * 8192 + c * 64 + 4 * fq;
        const float gl = ((const float*)(p.ws + WS_GLAST))[item];
        bf16x8 sb[4];
#pragma unroll
        for (int ks = 0; ks < 4; ++ks) sb[ks] = pkfrag(S[2 * ks], S[2 * ks + 1]);
        f32x4 w[4];
#pragma unroll
        for (int t = 0; t < 4; ++t) {
            f32x4 acc = {0.f, 0.f, 0.f, 0.f};
#pragma unroll
            for (int ks = 0; ks < 4; ++ks) acc = __builtin_amdgcn_mfma_f32_16x16x32_bf16(ld2(kc + t * 16 * 128 + ks * 32), sb[ks], acc, 0, 0, 0);
            const uint2 vn = *(const uint2*)(vnt + 16 * t);
            w[t][0] = bflo(vn.x) - acc[0]; w[t][1] = bfhi(vn.x) - acc[1]; w[t][2] = bflo(vn.y) - acc[2]; w[t][3] = bfhi(vn.y) - acc[3];
        }
        bf16x8 wb[2];
        wb[0] = pkfrag(w[0], w[1]); wb[1] = pkfrag(w[2], w[3]);
#pragma unroll
        for (int t = 0; t < 4; ++t) {
            f32x4 acc = {0.f, 0.f, 0.f, 0.f};
#pragma unroll
            for (int ks = 0; ks < 4; ++ks) acc = __builtin_amdgcn_mfma_f32_16x16x32_bf16(ld2(qd + t * 16 * 128 + ks * 32), sb[ks], acc, 0, 0, 0);
#pragma unroll
            for (int k2 = 0; k2 < 2; ++k2) acc = __builtin_amdgcn_mfma_f32_16x16x32_bf16(ld2(qk + t * 16 * 64 + k2 * 32), wb[k2], acc, 0, 0, 0);
#pragma unroll
            for (int r = 0; r < 4; ++r) { const int row = 16 * t + 4 * fq + r; if (row < L) ORAW[(size_t)(tok0 + row) * 1024 + h * 128 + c] = acc[r]; }
        }
#pragma unroll
        for (int u = 0; u < 8; ++u) {
            f32x4 acc = S[u] * gl;
#pragma unroll
            for (int k2 = 0; k2 < 2; ++k2) acc = __builtin_amdgcn_mfma_f32_16x16x32_bf16(ld2(kdt + u * 16 * 64 + k2 * 32), wb[k2], acc, 0, 0, 0);
            S[u] = acc;
        }
    }
#pragma unroll
    for (int u = 0; u < 8; ++u)
#pragma unroll
        for (int r = 0; r < 4; ++r) s_out[(size_t)(16 * u + 4 * fq + r) * 128 + c] = S[u][r];
}
constexpr int SC_KC = 0, SC_QD = 17408, SC_KDT = 34816, SC_QK = 53248, SC_STAGE = 62464;
__device__ __forceinline__ bf16x8 ld2s(const unsigned char* a) { return *(const bf16x8*)a; }
__device__ __forceinline__ void gdn_scan_block(const Params& p, int l, int b, int h, int cq, unsigned char* lds, const int mode = 0) {
    const int tid = tidx(), wid = __builtin_amdgcn_readfirstlane(tid >> 6), lane = tid & 63, fr = lane & 15, fq = lane >> 4;
    const int c = cq * 64 + (wid & 3) * 16 + fr;
    const bool comp = wid < 4 && mode != 1;
    const int rowA = tid >> 4, segA = tid & 15;
    const int rowB = tid >> 3, segB = tid & 7;
    const int sA = (rowA * 128 + segA * 8) * 2, dA = rowA * 272 + segA * 16;
    const int sB = (rowB * 64 + segB * 8) * 2, dB = rowB * 144 + segB * 16;
    const unsigned char* gKC = p.ws + WS_KCUM + sA; const unsigned char* gQD = p.ws + WS_QD + sA;
    const unsigned char* gKDT = p.ws + WS_KDT + sB; const unsigned char* gQK = p.ws + WS_QKM + sB;
    uint4 a0, a1, a2, a3, a4, a5, a6, b0, b1, b2, b3, b4, b5, b6;
#define SC_LOAD(P_, item) do { const size_t o_ = (size_t)(item) * 16384; \
        P_##0 = *(const uint4*)(gKC + o_); P_##1 = *(const uint4*)(gKC + o_ + 32 * 256); P_##2 = *(const uint4*)(gQD + o_); P_##3 = *(const uint4*)(gQD + o_ + 32 * 256); \
        P_##4 = *(const uint4*)(gKDT + o_); P_##5 = *(const uint4*)(gKDT + o_ + 64 * 128); P_##6 = *(const uint4*)(gQK + (size_t)(item) * 8192); } while (0)
#define SC_WRITE(P_, st) do { unsigned char* d_ = lds + (st) * SC_STAGE; \
        *(uint4*)(d_ + SC_KC + dA) = P_##0; *(uint4*)(d_ + SC_KC + dA + 32 * 272) = P_##1; *(uint4*)(d_ + SC_QD + dA) = P_##2; *(uint4*)(d_ + SC_QD + dA + 32 * 272) = P_##3; \
        *(uint4*)(d_ + SC_KDT + dB) = P_##4; *(uint4*)(d_ + SC_KDT + dB + 64 * 144) = P_##5; *(uint4*)(d_ + SC_QK + dB) = P_##6; } while (0)
    f32x4 S[8];
#pragma unroll
    for (int u = 0; u < 8; ++u) S[u] = (f32x4){0.f, 0.f, 0.f, 0.f};
    float* ORAW = (float*)(p.ws + (mode ? WS_T1 : WS_ORAW));
    const int item0 = (b * 128) * 8 + h;
    __syncthreads();
    SC_LOAD(a, item0); SC_WRITE(a, 0); SC_LOAD(a, item0 + 8);
    uint2 vn0[4], vn1[4]; float gl0, gl1;
    {
        const u16* vnt = (const u16*)(p.ws + WS_VNT) + (size_t)item0 * 8192 + c * 64 + 4 * fq;
#pragma unroll
        for (int t = 0; t < 4; ++t) { vn0[t] = *(const uint2*)(vnt + 16 * t); vn1[t] = *(const uint2*)(vnt + 8 * 8192 + 16 * t); }
        gl0 = ((const float*)(p.ws + WS_GLAST))[item0]; gl1 = ((const float*)(p.ws + WS_GLAST))[item0 + 8];
    }
    float* obuf = (float*)(lds + 2 * SC_STAGE);
    const int orow = tid >> 3, ocol = (tid & 7) * 8;
    __syncthreads();
    auto compute = [&](int st, uint2 (&vn)[4], const float gl) __attribute__((always_inline)) {
        const unsigned char* sb_ = lds + (st & 1) * SC_STAGE;
        const unsigned char* kc = sb_ + SC_KC + fr * 272 + fq * 16;
        const unsigned char* qd = sb_ + SC_QD + fr * 272 + fq * 16;
        const unsigned char* kdt = sb_ + SC_KDT + fr * 144 + fq * 16;
        const unsigned char* qk = sb_ + SC_QK + fr * 144 + fq * 16;
        bf16x8 ga[8], gb[8];
#define SC_RD(dst, base, pitch, t0, nk) do { _Pragma("unroll") for (int i_ = 0; i_ < 8; ++i_) dst[i_] = ld2s(base + ((t0) + i_ / (nk)) * 16 * (pitch) + (i_ % (nk)) * 64); } while (0)
        SC_RD(ga, kc, 272, 0, 4);
        SC_RD(gb, kc, 272, 2, 4);
        bf16x8 sb[4];
#pragma unroll
        for (int ks = 0; ks < 4; ++ks) sb[ks] = pkfrag(S[2 * ks], S[2 * ks + 1]);
        __builtin_amdgcn_sched_barrier(0);
        f32x4 w[4];
#pragma unroll
        for (int t = 0; t < 2; ++t) {
            f32x4 acc = {0.f, 0.f, 0.f, 0.f};
#pragma unroll
            for (int ks = 0; ks < 4; ++ks) acc = __builtin_amdgcn_mfma_f32_16x16x32_bf16(ga[t * 4 + ks], sb[ks], acc, 0, 0, 0);
            w[t][0] = bflo(vn[t].x) - acc[0]; w[t][1] = bfhi(vn[t].x) - acc[1]; w[t][2] = bflo(vn[t].y) - acc[2]; w[t][3] = bfhi(vn[t].y) - acc[3];
        }
        __builtin_amdgcn_sched_barrier(0);
        SC_RD(ga, kdt, 144, 0, 2);
        __builtin_amdgcn_sched_barrier(0);
#pragma unroll
        for (int t = 2; t < 4; ++t) {
            f32x4 acc = {0.f, 0.f, 0.f, 0.f};
#pragma unroll
            for (int ks = 0; ks < 4; ++ks) acc = __builtin_amdgcn_mfma_f32_16x16x32_bf16(gb[(t - 2) * 4 + ks], sb[ks], acc, 0, 0, 0);
            w[t][0] = bflo(vn[t].x) - acc[0]; w[t][1] = bfhi(vn[t].x) - acc[1]; w[t][2] = bflo(vn[t].y) - acc[2]; w[t][3] = bfhi(vn[t].y) - acc[3];
        }
        bf16x8 wb[2];
        wb[0] = pkfrag(w[0], w[1]); wb[1] = pkfrag(w[2], w[3]);
        __builtin_amdgcn_sched_barrier(0);
        SC_RD(gb, kdt, 144, 4, 2);
        __builtin_amdgcn_sched_barrier(0);
#pragma unroll
        for (int u = 0; u < 4; ++u) {
            f32x4 acc = S[u] * gl;
#pragma unroll
            for (int k2 = 0; k2 < 2; ++k2) acc = __builtin_amdgcn_mfma_f32_16x16x32_bf16(ga[u * 2 + k2], wb[k2], acc, 0, 0, 0);
            S[u] = acc;
        }
        __builtin_amdgcn_sched_barrier(0);
        SC_RD(ga, qd, 272, 0, 4);
        __builtin_amdgcn_sched_barrier(0);
#pragma unroll
        for (int u = 4; u < 8; ++u) {
            f32x4 acc = S[u] * gl;
#pragma unroll
            for (int k2 = 0; k2 < 2; ++k2) acc = __builtin_amdgcn_mfma_f32_16x16x32_bf16(gb[(u - 4) * 2 + k2], wb[k2], acc, 0, 0, 0);
            S[u] = acc;
        }
        __builtin_amdgcn_sched_barrier(0);
        SC_RD(gb, qd, 272, 2, 4);
        __builtin_amdgcn_sched_barrier(0);
        float* ob = obuf + (st & 1) * 4352 + (wid & 3) * 16 + fr;
        f32x4 o[4];
#pragma unroll
        for (int t = 0; t < 2; ++t) {
            o[t] = (f32x4){0.f, 0.f, 0.f, 0.f};
#pragma unroll
            for (int ks = 0; ks < 4; ++ks) o[t] = __builtin_amdgcn_mfma_f32_16x16x32_bf16(ga[t * 4 + ks], sb[ks], o[t], 0, 0, 0);
        }
        __builtin_amdgcn_sched_barrier(0);
        SC_RD(ga, qk, 144, 0, 2);
        __builtin_amdgcn_sched_barrier(0);
#pragma unroll
        for (int t = 2; t < 4; ++t) {
            o[t] = (f32x4){0.f, 0.f, 0.f, 0.f};
#pragma unroll
            for (int ks = 0; ks < 4; ++ks) o[t] = __builtin_amdgcn_mfma_f32_16x16x32_bf16(gb[(t - 2) * 4 + ks], sb[ks], o[t], 0, 0, 0);
        }
        __builtin_amdgcn_sched_barrier(0);
#pragma unroll
        for (int t = 0; t < 4; ++t) {
#pragma unroll
            for (int k2 = 0; k2 < 2; ++k2) o[t] = __builtin_amdgcn_mfma_f32_16x16x32_bf16(ga[t * 2 + k2], wb[k2], o[t], 0, 0, 0);
#pragma unroll
            for (int r = 0; r < 4; ++r) ob[(16 * t + 4 * fq + r) * 68] = o[t][r];
        }
#undef SC_RD
    };
#define SC_HALF(sc, LS, WS, VN, GL) do { \
        const int sp_ = (sc) > 0 ? (sc) - 1 : 0, sn_ = (sc) + 2 < 128 ? (sc) + 2 : 127; \
        const float4 ov_ = *(const float4*)(obuf + (sp_ & 1) * 4352 + orow * 68 + ocol), ow_ = *(const float4*)(obuf + (sp_ & 1) * 4352 + orow * 68 + ocol + 4); \
        if (mode != 2) SC_LOAD(LS, item0 + sn_ * 8); \
        { float* od_ = ORAW + (size_t)((b * 128 + sp_) * 64 + orow) * 1024 + h * 128 + cq * 64 + ocol; *(float4*)od_ = ov_; *(float4*)(od_ + 4) = ow_; }     \
        if (comp) compute(sc, VN, GL); \
        if (mode != 2) SC_WRITE(WS, ((sc) + 1) & 1); \
        { const u16* vnt_ = (const u16*)(p.ws + WS_VNT) + (size_t)(item0 + sn_ * 8) * 8192 + c * 64 + 4 * fq; \
          _Pragma("unroll") for (int t = 0; t < 4; ++t) VN[t] = *(const uint2*)(vnt_ + 16 * t); \
          GL = ((const float*)(p.ws + WS_GLAST))[item0 + sn_ * 8]; } \
        __syncthreads(); } while (0)
    for (int st = 0; st < 128; st += 2) { SC_HALF(st, b, a, vn0, gl0); SC_HALF(st + 1, a, b, vn1, gl1); }
#undef SC_HALF
    { float* od_ = ORAW + (size_t)((b * 128 + 127) * 64 + orow) * 1024 + h * 128 + cq * 64 + ocol; const float* os_ = obuf + 4352 + orow * 68 + ocol;
      *(float4*)od_ = *(const float4*)os_; *(float4*)(od_ + 4) = *(const float4*)(os_ + 4); }
#undef SC_LOAD
#undef SC_WRITE
    if (comp) {
        float* s_out = mode ? (float*)(p.ws + WS_T1) : p.out + O_SSMP + ((size_t)(l * 2 + b) * 8 + h) * 16384;
#pragma unroll
        for (int u = 0; u < 8; ++u)
#pragma unroll
            for (int r = 0; r < 4; ++r) s_out[(size_t)(16 * u + 4 * fq + r) * 128 + c] = S[u][r];
    }
}
__device__ __forceinline__ void phase_post2(const Params& p, int l) {
    const int wid = tidx() >> 6, lane = tidx() & 63;
    const float* ORAW = (const float*)(p.ws + WS_ORAW); const u16* P = (const u16*)(p.ws + WS_P); u16* OAN = (u16*)(p.ws + WS_OAN);
    const float2 gw = *(const float2*)(p.in[15] + l * 128 + 2 * lane);
    for (int it = bidx() * 8 + wid; it < NTOK * 8; it += gridDim.x * 8) {
        const int tok = it >> 3, h = it & 7;
        const float2 o = *(const float2*)(ORAW + (size_t)tok * 1024 + h * 128 + 2 * lane);
        const float ss = wave_sum(o.x * o.x + o.y * o.y);
        const float rstd = rsqrtf(ss * (1.f / 128.f) + EPSF);
        const unsigned z = *(const unsigned*)(P + (size_t)tok * LDP + 3072 + h * 128 + 2 * lane);
        *(unsigned*)(OAN + (size_t)tok * 1024 + h * 128 + 2 * lane) = pk2(o.x * rstd * gw.x * siluf(bflo(z)), o.y * rstd * gw.y * siluf(bfhi(z)));
    }
}

__device__ __forceinline__ void phase_final(const Params& p) {
    const int wid = tidx() >> 6, lane = tidx() & 63;
    const float* X = (const float*)(p.ws + WS_X); const float* fw = p.in[21];
    for (int tok = bidx() * 8 + wid; tok < NTOK; tok += gridDim.x * 8) {
        const float4* xr = (const float4*)(X + (size_t)tok * 1024);
        float4 v[4]; float ss = 0.f;
#pragma unroll
        for (int i = 0; i < 4; ++i) { v[i] = xr[lane + 64 * i]; ss += v[i].x * v[i].x + v[i].y * v[i].y + v[i].z * v[i].z + v[i].w * v[i].w; }
        ss = wave_sum(ss);
        const float rstd = rsqrtf(ss * (1.f / 1024.f) + EPSF);
#pragma unroll
        for (int i = 0; i < 4; ++i) { const float4 w = ((const float4*)fw)[lane + 64 * i];
            ((float4*)(p.out + O_Y + (size_t)tok * 1024))[lane + 64 * i] = make_float4(v[i].x * rstd * w.x, v[i].y * rstd * w.y, v[i].z * rstd * w.z, v[i].w * rstd * w.w); }
    }
}

__device__ __forceinline__ float lam_of(const Params& p, int l, int lane) {
    const float* lq = p.in[16] + l * 256;
    const float a = wave_sum(lq[lane] * lq[64 + lane]), b = wave_sum(lq[128 + lane] * lq[192 + lane]);
    return __expf(a) - __expf(b) + lam_init_of(l);
}
__device__ __forceinline__ void attn_store(const Params& p, int l, int tok, int h, int hh, const f32x16 (&d)[4], float ss) {
    ss += __shfl_xor(ss, 32);
    const float sc = rsqrtf(ss * (1.f / 128.f) + EPSF) * (1.f - lam_init_of(l));
    const u16* zp = (const u16*)(p.ws + WS_P) + (size_t)tok * LDP + 7168 + h * 128;
    u16* op = (u16*)(p.ws + WS_OBN) + (size_t)tok * 1024 + h * 128;
    const float* dw = p.in[17] + l * 128;
#pragma unroll
    for (int t = 0; t < 4; ++t)
#pragma unroll
        for (int g = 0; g < 4; ++g) {
            const int vc = 32 * t + 8 * g + 4 * hh;
            const uint2 z = *(const uint2*)(zp + vc); const float4 w = *(const float4*)(dw + vc);
            const float o0 = d[t][4 * g] * sc * w.x * siluf(bflo(z.x)), o1 = d[t][4 * g + 1] * sc * w.y * siluf(bfhi(z.x));
            const float o2 = d[t][4 * g + 2] * sc * w.z * siluf(bflo(z.y)), o3 = d[t][4 * g + 3] * sc * w.w * siluf(bfhi(z.y));
            *(uint2*)(op + vc) = make_uint2(pk2(o0, o1), pk2(o2, o3));
        }
}

constexpr int AT_KPITCH = 272, AT_VPITCH = 144, AT_KBYTES = 64 * AT_KPITCH, AT_VBYTES = 128 * AT_VPITCH, AT_VBASE = 2 * AT_KBYTES;

__device__ __forceinline__ void attn_prompt_item(const Params& p, int l, int b, int h, int qb, unsigned char* lds) {
    const int tid = tidx(), wid = __builtin_amdgcn_readfirstlane(tid >> 6), lane = tid & 63;
    const int m = wid & 1, rg = wid >> 1, ql = lane & 31, hh = lane >> 5;
    const bool late = wid >= 4;
    const int tokq = b * 8192 + qb * 128 + rg * 32 + ql;
    const u16* QB = (const u16*)(p.ws + WS_QB);
    bf16x8 qf[4];
#pragma unroll
    for (int s = 0; s < 4; ++s) qf[s] = *(const bf16x8*)(QB + (size_t)tokq * 1024 + h * 128 + m * 64 + 16 * s + 8 * hh);
    const int ntb = 2 * qb + 2, ntw = 2 * qb + 1 + (rg >> 1);
    f32x16 O[4];
#pragma unroll
    for (int t = 0; t < 4; ++t)
#pragma unroll
        for (int r = 0; r < 16; ++r) O[t][r] = 0.f;
    float mrun = -1e30f, lrun = 0.f;
    const u16* KBp = (const u16*)(p.ws + WS_KB) + (size_t)(b * 8192) * 1024 + h * 128;
    const u16* VTp = (const u16*)(p.ws + WS_VT) + (size_t)((b * 8 + h) * 128) * 8192;
    const int krow0 = tid >> 4, kseg = tid & 15;
    const int vrow0 = tid >> 3, vseg = tid & 7;
    uint4 kr0, kr1, vr0, vr1;
#define AT_LOAD(j) do { \
        kr0 = *(const uint4*)(KBp + (size_t)((j) * 64 + krow0) * 1024 + kseg * 8); kr1 = *(const uint4*)(KBp + (size_t)((j) * 64 + krow0 + 32) * 1024 + kseg * 8); \
        vr0 = *(const uint4*)(VTp + (size_t)(vrow0) * 8192 + (j) * 64 + vseg * 8); vr1 = *(const uint4*)(VTp + (size_t)(vrow0 + 64) * 8192 + (j) * 64 + vseg * 8); } while (0)
#define AT_WRITE(ks_, vs_) do { unsigned char* kb = lds + (ks_) * AT_KBYTES; unsigned char* vb = lds + AT_VBASE + (vs_) * AT_VBYTES; \
        *(uint4*)(kb + (krow0) * AT_KPITCH + kseg * 16) = kr0; *(uint4*)(kb + (krow0 + 32) * AT_KPITCH + kseg * 16) = kr1; \
        *(uint4*)(vb + (vrow0) * AT_VPITCH + vseg * 16) = vr0; *(uint4*)(vb + (vrow0 + 64) * AT_VPITCH + vseg * 16) = vr1; } while (0)
    auto pv = [&](const unsigned char* vb, const bf16x8 f0, const bf16x8 f1, const bf16x8 f2, const bf16x8 f3) __attribute__((always_inline)) {
        const unsigned char* vl = vb + ql * AT_VPITCH + hh * 16;
        bf16x8 va[4], vc[4];
#define AT_VRD(dst, k) do { _Pragma("unroll") for (int t = 0; t < 4; ++t) dst[t] = *(const bf16x8*)(vl + (32 * t) * AT_VPITCH + (k) * 32); } while (0)
#define AT_VMM(src, f) do { _Pragma("unroll") for (int t = 0; t < 4; ++t) O[t] = __builtin_amdgcn_mfma_f32_32x32x16_bf16(src[t], f, O[t], 0, 0, 0); } while (0)
        AT_VRD(va, 0); AT_VRD(vc, 1);
        __builtin_amdgcn_sched_barrier(0);
        AT_VMM(va, f0);
        __builtin_amdgcn_sched_barrier(0);
        AT_VRD(va, 2);
        __builtin_amdgcn_sched_barrier(0);
        AT_VMM(vc, f1);
        __builtin_amdgcn_sched_barrier(0);
        AT_VRD(vc, 3);
        __builtin_amdgcn_sched_barrier(0);
        AT_VMM(va, f2); AT_VMM(vc, f3);
        __builtin_amdgcn_sched_barrier(0);
#undef AT_VRD
#undef AT_VMM
    };
    typedef unsigned u32x4 __attribute__((ext_vector_type(4)));
    u32x4 pp0 = {0, 0, 0, 0}, pp1 = {0, 0, 0, 0}, pp2 = {0, 0, 0, 0}, pp3 = {0, 0, 0, 0};
    __syncthreads();
    AT_LOAD(0); AT_WRITE(0, 0);
    __syncthreads();
    int vcur = 0;
    for (int j = 0; j < ntb; ++j) {
        const int vprev = vcur == 0 ? 2 : vcur - 1, vnext = vcur == 2 ? 0 : vcur + 1;
        if (j + 1 < ntb) AT_LOAD(j + 1);
        if (late && j >= 1) pv(lds + AT_VBASE + vprev * AT_VBYTES, __builtin_bit_cast(bf16x8, pp0), __builtin_bit_cast(bf16x8, pp1), __builtin_bit_cast(bf16x8, pp2), __builtin_bit_cast(bf16x8, pp3));
        if (j < ntw) {
            const unsigned char* kb = lds + (j & 1) * AT_KBYTES;
            bf16x8 kf[8];
#pragma unroll
            for (int kt = 0; kt < 2; ++kt)
#pragma unroll
                for (int s = 0; s < 4; ++s) kf[kt * 4 + s] = *(const bf16x8*)(kb + (32 * kt + ql) * AT_KPITCH + m * 128 + s * 32 + hh * 16);
            __builtin_amdgcn_sched_barrier(0);
            f32x16 st[2];
#pragma unroll
            for (int kt = 0; kt < 2; ++kt)
#pragma unroll
                for (int r = 0; r < 16; ++r) st[kt][r] = 0.f;
#pragma unroll
            for (int s = 0; s < 4; ++s) {
                st[0] = __builtin_amdgcn_mfma_f32_32x32x16_bf16(kf[s], qf[s], st[0], 0, 0, 0);
                st[1] = __builtin_amdgcn_mfma_f32_32x32x16_bf16(kf[4 + s], qf[s], st[1], 0, 0, 0);
            }
            __builtin_amdgcn_sched_barrier(0);
            float mx = st[0][0];
#pragma unroll
            for (int r = 1; r < 16; ++r) mx = fmaxf(mx, st[0][r]);
#pragma unroll
            for (int r = 0; r < 16; ++r) mx = fmaxf(mx, st[1][r]);
            mx = fmaxf(mx, __shfl_xor(mx, 32));
            if (__any(mx > mrun)) {
                const float mnew_ = fmaxf(mrun, mx), alpha = __builtin_amdgcn_exp2f(mrun - mnew_);
                mrun = mnew_; lrun *= alpha;
#pragma unroll
                for (int t = 0; t < 4; ++t) O[t] *= alpha;
            }
            const float mnew = mrun;
#define AT_PFRAG(dst, kt, s2) do { float e0 = __builtin_amdgcn_exp2f(st[kt][8 * s2 + 0] - mnew), e1 = __builtin_amdgcn_exp2f(st[kt][8 * s2 + 1] - mnew), \
        e2 = __builtin_amdgcn_exp2f(st[kt][8 * s2 + 2] - mnew), e3 = __builtin_amdgcn_exp2f(st[kt][8 * s2 + 3] - mnew), \
        e4 = __builtin_amdgcn_exp2f(st[kt][8 * s2 + 4] - mnew), e5 = __builtin_amdgcn_exp2f(st[kt][8 * s2 + 5] - mnew), \
        e6 = __builtin_amdgcn_exp2f(st[kt][8 * s2 + 6] - mnew), e7 = __builtin_amdgcn_exp2f(st[kt][8 * s2 + 7] - mnew); \
        lrun += ((e0 + e1) + (e2 + e3)) + ((e4 + e5) + (e6 + e7)); \
        dst.x = pk2(e0, e1); dst.y = pk2(e2, e3); dst.z = pk2(e4, e5); dst.w = pk2(e6, e7); } while (0)
            AT_PFRAG(pp0, 0, 0); AT_PFRAG(pp1, 0, 1); AT_PFRAG(pp2, 1, 0); AT_PFRAG(pp3, 1, 1);
#undef AT_PFRAG
            __builtin_amdgcn_sched_barrier(0);
            if (!late) pv(lds + AT_VBASE + vcur * AT_VBYTES, __builtin_bit_cast(bf16x8, pp0), __builtin_bit_cast(bf16x8, pp1), __builtin_bit_cast(bf16x8, pp2), __builtin_bit_cast(bf16x8, pp3));
        }
        if (j + 1 < ntb) AT_WRITE((j + 1) & 1, vnext);
        __syncthreads();
        vcur = vnext;
    }
    if (late) { const int vlast = vcur == 0 ? 2 : vcur - 1;
        pv(lds + AT_VBASE + vlast * AT_VBYTES, __builtin_bit_cast(bf16x8, pp0), __builtin_bit_cast(bf16x8, pp1), __builtin_bit_cast(bf16x8, pp2), __builtin_bit_cast(bf16x8, pp3)); }
    __syncthreads();
#undef AT_LOAD
#undef AT_WRITE
    const float inv = 1.f / (lrun + __shfl_xor(lrun, 32));
    float* xb = (float*)lds + rg * 4096;
    if (m == 1) {
#pragma unroll
        for (int t = 0; t < 4; ++t)
#pragma unroll
            for (int r = 0; r < 16; ++r) xb[(t * 16 + r) * 64 + lane] = O[t][r] * inv;
    }
    __syncthreads();
    if (m == 0) {
        const float lam = lam_of(p, l, lane);
        float ss = 0.f;
#pragma unroll
        for (int t = 0; t < 4; ++t)
#pragma unroll
            for (int r = 0; r < 16; ++r) { const float d = O[t][r] * inv - lam * xb[(t * 16 + r) * 64 + lane]; O[t][r] = d; ss += d * d; }
        attn_store(p, l, tokq, h, hh, O, ss);
    }
}

__device__ __forceinline__ void attn_sample_item(const Params& p, int l, int b, int h, unsigned char* lds) {
    const int tid = tidx(), wid = __builtin_amdgcn_readfirstlane(tid >> 6), lane = tid & 63, ql = lane & 31, hh = lane >> 5;
    const int t = wid & 3, kh = wid >> 2;
    const int tok0 = NPT + b * 32, tokq = tok0 + ql;
    const u16* QB = (const u16*)(p.ws + WS_QB); const u16* KB = (const u16*)(p.ws + WS_KB); const u16* P = (const u16*)(p.ws + WS_P);
    const float* CK = p.in[4] + ((size_t)(l * 16 + b) * 8 + h) * 1024 * 128;
    const float* CV = p.in[5] + ((size_t)(l * 16 + b) * 8 + h) * 1024 * 128;
    float* xo = (float*)lds;
    float* xss = (float*)(lds + 32768);
    typedef unsigned u32x4 __attribute__((ext_vector_type(4)));
    f32x16 O1;
#pragma unroll
    for (int r = 0; r < 16; ++r) O1[r] = 0.f;
    f32x16 O;
    __syncthreads();
    for (int m = 0; m < 2; ++m) {
        bf16x8 qf[4];
#pragma unroll
        for (int s = 0; s < 4; ++s) qf[s] = *(const bf16x8*)(QB + (size_t)tokq * 1024 + h * 128 + m * 64 + 16 * s + 8 * hh);
#pragma unroll
        for (int r = 0; r < 16; ++r) O[r] = 0.f;
        float mrun = -1e30f, lrun = 0.f;
        const int kt0 = kh ? 17 : 0, kt1 = kh ? 33 : 17;
        for (int kt = kt0; kt < kt1; ++kt) {
            f32x16 st;
#pragma unroll
            for (int r = 0; r < 16; ++r) st[r] = 0.f;
            if (kt < 32) {
                const float* kp = CK + (size_t)(kt * 32 + ql) * 128 + m * 64 + 8 * hh;
#pragma unroll
                for (int s = 0; s < 4; ++s) {
                    const float4 x = *(const float4*)(kp + 16 * s), y = *(const float4*)(kp + 16 * s + 4);
                    u32x4 w; w.x = pk2(x.x, x.y); w.y = pk2(x.z, x.w); w.z = pk2(y.x, y.y); w.w = pk2(y.z, y.w);
                    st = __builtin_amdgcn_mfma_f32_32x32x16_bf16(__builtin_bit_cast(bf16x8, w), qf[s], st, 0, 0, 0);
                }
            } else {
                const u16* kp = KB + (size_t)(tok0 + ql) * 1024 + h * 128 + m * 64 + 8 * hh;
#pragma unroll
                for (int s = 0; s < 4; ++s) st = __builtin_amdgcn_mfma_f32_32x32x16_bf16(*(const bf16x8*)(kp + 16 * s), qf[s], st, 0, 0, 0);
            }
            float mx = st[0];
#pragma unroll
            for (int r = 1; r < 16; ++r) mx = fmaxf(mx, st[r]);
            mx = fmaxf(mx, __shfl_xor(mx, 32));
            const float mnew = fmaxf(mrun, mx), alpha = __builtin_amdgcn_exp2f(mrun - mnew);
            mrun = mnew; lrun *= alpha;
            O *= alpha;
            float e[16];
#pragma unroll
            for (int r = 0; r < 16; ++r) { e[r] = __builtin_amdgcn_exp2f(st[r] - mnew); lrun += e[r]; }
#pragma unroll
            for (int s2 = 0; s2 < 2; ++s2) {
                u32x4 pw; pw.x = pk2(e[8 * s2], e[8 * s2 + 1]); pw.y = pk2(e[8 * s2 + 2], e[8 * s2 + 3]); pw.z = pk2(e[8 * s2 + 4], e[8 * s2 + 5]); pw.w = pk2(e[8 * s2 + 6], e[8 * s2 + 7]);
                float v[8];
                if (kt < 32) {
                    const float* vp = CV + (size_t)(kt * 32 + 16 * s2 + 4 * hh) * 128 + 32 * t + ql;
#pragma unroll
                    for (int i = 0; i < 4; ++i) { v[i] = vp[i * 128]; v[4 + i] = vp[(8 + i) * 128]; }
                } else {
                    const u16* vp = P + (size_t)(tok0 + 16 * s2 + 4 * hh) * LDP + 6144 + h * 128 + 32 * t + ql;
#pragma unroll
                    for (int i = 0; i < 4; ++i) { v[i] = bf2f(vp[(size_t)i * LDP]); v[4 + i] = bf2f(vp[(size_t)(8 + i) * LDP]); }
                }
                u32x4 w; w.x = pk2(v[0], v[1]); w.y = pk2(v[2], v[3]); w.z = pk2(v[4], v[5]); w.w = pk2(v[6], v[7]);
                O = __builtin_amdgcn_mfma_f32_32x32x16_bf16(__builtin_bit_cast(bf16x8, w), __builtin_bit_cast(bf16x8, pw), O, 0, 0, 0);
            }
        }
        float* sl = xo + t * 1152;
        if (kh == 1) {
#pragma unroll
            for (int r = 0; r < 16; ++r) sl[r * 64 + lane] = O[r];
            sl[1024 + lane] = mrun; sl[1088 + lane] = lrun;
        }
        __syncthreads();
        if (kh == 0) {
            const float mo = sl[1024 + lane], lo = sl[1088 + lane];
            const float mnew = fmaxf(mrun, mo), a = __builtin_amdgcn_exp2f(mrun - mnew), ao = __builtin_amdgcn_exp2f(mo - mnew);
            lrun = lrun * a + lo * ao;
            const float inv = 1.f / (lrun + __shfl_xor(lrun, 32));
#pragma unroll
            for (int r = 0; r < 16; ++r) O[r] = (O[r] * a + sl[r * 64 + lane] * ao) * inv;
            if (m == 0) O1 = O;
        }
        __syncthreads();
    }
    float ss = 0.f;
    if (kh == 0) {
        const float lam = lam_of(p, l, lane);
#pragma unroll
        for (int r = 0; r < 16; ++r) { const float d = O1[r] - lam * O[r]; O[r] = d; ss += d * d; }
        ss += __shfl_xor(ss, 32);
        if (hh == 0) xss[t * 32 + ql] = ss;
    }
    __syncthreads();
    if (kh == 0) {
        const float tot = xss[ql] + xss[32 + ql] + xss[64 + ql] + xss[96 + ql];
        const float sc = rsqrtf(tot * (1.f / 128.f) + EPSF) * (1.f - lam_init_of(l));
        const u16* zp = (const u16*)(p.ws + WS_P) + (size_t)tokq * LDP + 7168 + h * 128;
        u16* op = (u16*)(p.ws + WS_OBN) + (size_t)tokq * 1024 + h * 128;
        const float* dw = p.in[17] + l * 128;
#pragma unroll
        for (int g = 0; g < 4; ++g) {
            const int vc = 32 * t + 8 * g + 4 * hh;
            const uint2 z = *(const uint2*)(zp + vc); const float4 w = *(const float4*)(dw + vc);
            const float o0 = O[4 * g] * sc * w.x * siluf(bflo(z.x)), o1 = O[4 * g + 1] * sc * w.y * siluf(bfhi(z.x));
            const float o2 = O[4 * g + 2] * sc * w.z * siluf(bflo(z.y)), o3 = O[4 * g + 3] * sc * w.w * siluf(bfhi(z.y));
            *(uint2*)(op + vc) = make_uint2(pk2(o0, o1), pk2(o2, o3));
        }
    }
}

__device__ __forceinline__ void phase_cat(const Params& p, int l, unsigned char* lds, int sub) {
    const int bid = bidx(), nb = gridDim.x;
    uint4 t0, t1, t2, t3, t4, t5; float gpre, bpre;
    if (bid < NITEM) gdn_chunk_load(p, bid, t0, t1, t2, t3, t4, t5, gpre, bpre);
#if defined(REP_SUB)
    if (sub != 7) { for (int it = bid; it < NITEM; it += nb) gdn_chunk_item(p, it, it + nb < NITEM ? it + nb : -1, lds, t0, t1, t2, t3, t4, t5, gpre, bpre, REP_SUB); return; }
#endif
    for (int it = bid; it < NITEM; it += nb) gdn_chunk_item(p, it, it + nb < NITEM ? it + nb : -1, lds, t0, t1, t2, t3, t4, t5, gpre, bpre);
}
constexpr int QCTR_OFF = 12288;
__device__ __forceinline__ int queue_pop(unsigned* ctr, unsigned char* lds) {
    __syncthreads();
    if (tidx() == 0) *(volatile int*)(lds + LDS_BYTES - 16) = (int)atomicAdd(ctr, 1u);
    __syncthreads();
    return *(volatile int*)(lds + LDS_BYTES - 16);
}
__device__ __forceinline__ void phase_scan(const Params& p, int l, unsigned char* lds, int sub) {
    const int wid = __builtin_amdgcn_readfirstlane(tidx() >> 6), bid = bidx(), nb = gridDim.x;
    const int npb = nb > 32 ? 32 : nb;
    if (bid < npb) for (int it = bid; it < 32; it += npb) gdn_scan_block(p, l, it >> 4, (it >> 1) & 7, it & 1, lds);
    unsigned* ctr = (unsigned*)(p.ws + WS_GLAST + QCTR_OFF) + l;
    for (;;) {
        const int it = queue_pop(ctr, lds);
        if (it >= 128 + 1024 + 128) break;
        if (it < 128) attn_sample_item(p, l, it >> 3, it & 7, lds);
        else if (it < 128 + 1024) { const int j = it - 128, qb = 63 - (j >> 4), bh = j & 15; attn_prompt_item(p, l, bh >> 3, bh & 7, qb, lds); }
        else {
            const int wi = (it - 1152) * 8 + wid, cb = wi & 7, h = (wi >> 3) & 7, b = wi >> 6;
            const size_t so = ((size_t)(l * 16 + b) * 8 + h) * 16384;
            gdn_scan_item(p, l, 256 + b, 1, h, cb, p.in[6] + so, p.out + O_SSMS + so, 32);
        }
    }
}

#define XB_TMO      128
#define XB_XCNT(j)  (256  + 64 * (j))
#define XB_XSUB(j)  (1280 + 64 * (j))
#define XB_XGEN(j)  (2304 + 64 * (j))
#define XB_TOP      3328
#define XB_TOPGEN   3392
#define XCD_BAR_WORDS 3456
#define XB_SPIN_CAP (1u << 18)
#define LAS __attribute__((address_space(3)))

__device__ __forceinline__ unsigned xb_ld(unsigned* p)              { return __hip_atomic_load(p, __ATOMIC_RELAXED, __HIP_MEMORY_SCOPE_AGENT); }
__device__ __forceinline__ unsigned xb_add(unsigned* p, unsigned v) { return __hip_atomic_fetch_add(p, v, __ATOMIC_RELAXED, __HIP_MEMORY_SCOPE_AGENT); }
__device__ __forceinline__ unsigned xb_xcc_id() { return (unsigned)__builtin_amdgcn_s_getreg((3 << 11) | 20) & 0xFu; }
#define XB_SPIN(cond, bar) do { unsigned _sp = 0; while (cond) { __builtin_amdgcn_s_sleep(1); \
    if ((++_sp & 255u) == 0u) { if (xb_ld(&(bar)[XB_TMO])) break; if (_sp > XB_SPIN_CAP) { atomicAdd(&(bar)[XB_TMO], 1u); break; } } } } while (0)

struct XcdBarrier {
    unsigned* bar; unsigned x;
    volatile LAS unsigned* st;
};

__device__ __forceinline__ XcdBarrier xcd_barrier_post(unsigned* bar, volatile LAS unsigned* st) {
    XcdBarrier b; b.bar = bar; b.x = xb_xcc_id(); b.st = st;
    if (tidx() == 0) (void)xb_add(&bar[XB_XCNT(b.x)], 1u);
    return b;
}
__device__ __forceinline__ void xcd_barrier_complete(unsigned* bar, unsigned x, unsigned& nloc, unsigned& nx) {
    const unsigned G = gridDim.x * gridDim.y * gridDim.z;
    unsigned sum, cnt, mine, sp = 0u;
    for (;;) {
        sum = 0u; cnt = 0u; mine = 0u;
#pragma unroll
        for (unsigned j = 0; j < 16; ++j) { const unsigned c = xb_ld(&bar[XB_XCNT(j)]); sum += c; cnt += (c > 0u) ? 1u : 0u; mine = (j == x) ? c : mine; }
        if (sum == G) break;
        __builtin_amdgcn_s_sleep(1);
        if ((++sp & 255u) == 0u) { if (xb_ld(&bar[XB_TMO])) break; if (sp > XB_SPIN_CAP) { atomicAdd(&bar[XB_TMO], 1u); break; } }
    }
    nloc = mine > 0u ? mine : 1u; nx = cnt > 0u ? cnt : 1u;
}

__device__ __forceinline__ void xcd_barrier(const XcdBarrier& b) {
    asm volatile("s_waitcnt vmcnt(0)" ::: "memory");
    __syncthreads();
    if (tidx() == 0) {
        unsigned* bar = b.bar;
        __builtin_amdgcn_s_waitcnt(0);
        unsigned nloc = b.st[0], nx = b.st[1];
        if (nloc == 0u) { xcd_barrier_complete(bar, b.x, nloc, nx); b.st[0] = nloc; b.st[1] = nx; }
        const unsigned old = xb_add(&bar[XB_XSUB(b.x)], 1u);
        const unsigned gen = old / nloc;
        if (old + 1u == (gen + 1u) * nloc) {
            __builtin_amdgcn_fence(__ATOMIC_RELEASE, "agent");
            asm volatile("s_waitcnt vmcnt(0)" ::: "memory");
            const unsigned og = xb_add(&bar[XB_TOP], 1u);
            const unsigned tg = og / nx;
            if (og + 1u == (tg + 1u) * nx) xb_add(&bar[XB_TOPGEN], 1u);
            else XB_SPIN(xb_ld(&bar[XB_TOPGEN]) == tg, bar);
            __builtin_amdgcn_fence(__ATOMIC_ACQUIRE, "agent");
            xb_add(&bar[XB_XGEN(b.x)], 1u);
            asm volatile("s_waitcnt vmcnt(0)" ::: "memory");
        } else {
            XB_SPIN(xb_ld(&bar[XB_XGEN(b.x)]) == gen, bar);
            __builtin_amdgcn_fence(__ATOMIC_ACQUIRE, "agent");
            asm volatile("s_waitcnt vmcnt(0)" ::: "memory");
        }
    }
    __syncthreads();
}

__global__ void __launch_bounds__(512, 2) fwd_kernel(Params p) {
    extern __shared__ __attribute__((aligned(16))) unsigned char lds[];
    cg::grid_group grid = cg::this_grid();
    if (tidx() == 0) { *(volatile unsigned*)(lds + LDS_BYTES - 32) = 0u; *(volatile unsigned*)(lds + LDS_BYTES - 28) = 0u; }
    __syncthreads();
    XcdBarrier xb = xcd_barrier_post((unsigned*)(p.ws + WS_BAR), (volatile LAS unsigned*)(lds + LDS_BYTES - 32));
    for (int ph = p.ph_lo; ph < p.ph_hi; ++ph) {
#ifdef REP_KIND
      const int nrep = ((ph == 0 ? 0 : (ph == 33 ? 9 : 1 + ((ph - 1) & 7))) == REP_KIND) ? 2 : 1;
      for (int rep = 0; rep < nrep; ++rep) {
        if (rep) grid.sync();
#endif
#ifndef ONLY
#define ONLY -1
#endif
#define EN(k) (ONLY < 0 || ONLY == (k))
#if defined(REP_KIND) && defined(REP_SUB)
#define CATSUB (rep ? REP_SUB : 7)
#else
#define CATSUB 7
#endif
        if (ph == 0) { if (EN(0)) phase_prep(p, lds); }
        else if (ph == 33) { if (EN(9)) phase_final(p); }
        else {
            const int l = (ph - 1) >> 3, k = (ph - 1) & 7;
            const u16* WTIN = (const u16*)(p.ws + WS_WTIN) + (size_t)l * LDP * 1024;
            if (k == 0) { if (EN(1)) phase_norm(p, l); }
            else if (k == 1) { if (EN(2)) { EpiP E; E.O = (u16*)(p.ws + WS_P); run_gemm(lds, (const u16*)(p.ws + WS_H), WTIN, NTOK, LDP, E); } }
            else if (k == 2) { if (EN(3)) phase_post1(p, l, lds); }
            else if (k == 3) { if (EN(4)) phase_cat(p, l, lds, CATSUB); }
            else if (k == 4) { if (EN(5)) phase_scan(p, l, lds, CATSUB); }
            else if (k == 5) { if (EN(6)) phase_post2(p, l); }
            else if (k == 6) { if (EN(7)) {
                EpiG2<0> E0; E0.P = (const u16*)(p.ws + WS_P); E0.T1 = (float*)(p.ws + WS_T1); E0.MG = (u16*)(p.ws + WS_MERGED);
                run_gemm(lds, (const u16*)(p.ws + WS_OAN), (const u16*)(p.ws + WS_WTPA) + (size_t)l * 1048576, NTOK, 1024, E0);
                __syncthreads();
                EpiG2<1> E1; E1.P = E0.P; E1.T1 = E0.T1; E1.MG = E0.MG;
                run_gemm(lds, (const u16*)(p.ws + WS_OBN), (const u16*)(p.ws + WS_WTPB) + (size_t)l * 1048576, NTOK, 1024, E1); }
            } else if (EN(8)) {
                EpiG3 E; E.X = (float*)(p.ws + WS_X); E.MODL = (const float*)(p.ws + WS_MOD) + (size_t)l * 18 * 3072;
                run_gemm(lds, (const u16*)(p.ws + WS_MERGED), (const u16*)(p.ws + WS_WTOUT) + (size_t)l * 1048576, NTOK, 1024, E);
            }
        }
#ifdef REP_KIND
      }
#endif
        if (ph + 1 < p.ph_hi) { if (ph == p.ph_lo) grid.sync(); else xcd_barrier(xb); }
#ifdef EXTRA_SYNC
        if (ph + 1 < p.ph_hi) { xcd_barrier(xb); xcd_barrier(xb); xcd_barrier(xb); }
#endif
    }
}

#ifndef MEGA
#define MEGA 1
#endif
extern "C" void kernel_launch(void* const* d_in, const int* in_sizes, int n_in, void* d_out, int out_size, void* d_ws, size_t ws_size, hipStream_t stream) {
    static int grid = 0;
    if (grid == 0) {
        int dev = 0, cus = 0;
        hipGetDevice(&dev);
        hipDeviceGetAttribute(&cus, hipDeviceAttributeMultiprocessorCount, dev);
        if (hipFuncSetAttribute((const void*)fwd_kernel, hipFuncAttributeMaxDynamicSharedMemorySize, LDS_BYTES) != hipSuccess) fprintf(stderr, "hipFuncSetAttribute failed\n");
        int per_cu = 0;
        hipOccupancyMaxActiveBlocksPerMultiprocessor(&per_cu, (const void*)fwd_kernel, 512, LDS_BYTES);
        if (per_cu < 1) fprintf(stderr, "occupancy query says %d blocks per CU\n", per_cu);
        (void)hipGetLastError();
        grid = cus > 0 ? cus : 256;
        if (ws_size < WS_END) fprintf(stderr, "workspace too small: %zu < %zu\n", ws_size, (size_t)WS_END);
    }
    Params p{};
    for (int i = 0; i < 22; ++i) p.in[i] = (const float*)d_in[i];
    p.out = (float*)d_out; p.ws = (unsigned char*)d_ws;
#if MEGA
    p.ph_lo = 0; p.ph_hi = 34;
    if (hipMemsetAsync((unsigned char*)d_ws + WS_BAR, 0, XCD_BAR_WORDS * 4, stream) != hipSuccess) fprintf(stderr, "memset of barrier words failed\n");
    void* args[] = {&p};
    hipError_t e = hipLaunchCooperativeKernel((const void*)fwd_kernel, dim3(grid), dim3(512), args, LDS_BYTES, stream);
    if (e != hipSuccess) fprintf(stderr, "cooperative launch failed: %s (grid %d)\n", hipGetErrorString(e), grid);
#else
    for (int ph = 0; ph < 34; ++ph) {
        p.ph_lo = ph; p.ph_hi = ph + 1;
        hipLaunchKernelGGL(fwd_kernel, dim3(grid), dim3(512), LDS_BYTES, stream, p);
    }
#endif
}
```

```cpp
#include <hip/hip_runtime.h>
#include <hip/hip_cooperative_groups.h>
#include <cstdio>
namespace cg = cooperative_groups;

typedef unsigned short u16;

constexpr int DM = 1024, NPT = 16384, NTOK = 16896, SEQ = 8192, LDP = 10496;
constexpr float EPSF = 1e-6f;
constexpr float QSCALE = 0.125f * 1.44269504088896340736f;

constexpr size_t O_Y = 0, O_KP = 17301504, O_VP = 84410368, O_SSMP = 151519232, O_CONVP = 152567808,
                 O_KS = 152641536, O_VS = 154738688, O_SSMS = 156835840, O_CONVS = 165224448;

constexpr size_t SZ_TOKBF = (size_t)NTOK * 1024 * 2;
constexpr size_t WS_WTIN = 0;
constexpr size_t WS_WTPA = WS_WTIN + (size_t)4 * LDP * 1024 * 2;
constexpr size_t WS_WTPB = WS_WTPA + (size_t)4 * 1024 * 1024 * 2;
constexpr size_t WS_WTOUT = WS_WTPB + (size_t)4 * 1024 * 1024 * 2;
constexpr size_t WS_MOD = WS_WTOUT + (size_t)4 * 1024 * 1024 * 2;
constexpr size_t WS_CS = WS_MOD + (size_t)4 * 18 * 3072 * 4;
constexpr size_t WS_X = WS_CS + (size_t)8192 * 32 * 8;
constexpr size_t WS_P = WS_X + (size_t)NTOK * 1024 * 4;
constexpr size_t WS_BETA = WS_P + (size_t)NTOK * LDP * 2;
constexpr size_t WS_GLOG = WS_BETA + (size_t)NTOK * 8 * 4;
constexpr size_t WS_R1 = WS_GLOG + (size_t)NTOK * 8 * 4;
constexpr size_t WS_QA = WS_R1, WS_KA = WS_R1 + SZ_TOKBF, WS_VA = WS_R1 + 2 * SZ_TOKBF;
constexpr size_t WS_T1 = WS_R1, WS_MERGED = WS_R1 + 2 * SZ_TOKBF;
constexpr size_t WS_QB = WS_R1 + 3 * SZ_TOKBF;
constexpr size_t WS_OAN = WS_QB;
constexpr size_t WS_KB = WS_QB + SZ_TOKBF;
constexpr size_t WS_VT = WS_KB + SZ_TOKBF;
constexpr int NITEM = 2176;
constexpr size_t WS_VNT = WS_VT + (size_t)2 * 8 * 128 * 8192 * 2;
constexpr size_t WS_KCUM = WS_VNT + (size_t)NITEM * 16384;
constexpr size_t WS_QD = WS_KCUM + (size_t)NITEM * 16384;
constexpr size_t WS_KDT = WS_QD + (size_t)NITEM * 16384;
constexpr size_t WS_QKM = WS_KDT + (size_t)NITEM * 16384;
constexpr size_t WS_GLAST = WS_QKM + (size_t)NITEM * 8192;
constexpr size_t WS_ORAW = WS_GLAST + 16384;
constexpr size_t WS_H = WS_ORAW;
constexpr size_t WS_OBN = WS_ORAW + (size_t)NTOK * 1024 * 4;
constexpr size_t WS_BAR = WS_OBN + SZ_TOKBF;
constexpr size_t WS_END = WS_BAR + 16384;
static_assert(WS_END <= (size_t)1073741824, "workspace too large");
static_assert(WS_P % 256 == 0 && WS_R1 % 256 == 0 && WS_VNT % 256 == 0 && WS_ORAW % 256 == 0 && WS_OBN % 256 == 0, "align");

constexpr int LDS_BYTES = 163840;

struct Params {
    const float* in[22];
    float* out;
    unsigned char* ws;
    int ph_lo, ph_hi;
};

typedef short bf16x8 __attribute__((ext_vector_type(8)));
typedef float f32x4 __attribute__((ext_vector_type(4)));
typedef float f32x16 __attribute__((ext_vector_type(16)));

__device__ __forceinline__ float bf2f(u16 b) { return __uint_as_float(((unsigned)b) << 16); }
__device__ __forceinline__ float bflo(unsigned w) { return __uint_as_float(w << 16); }
__device__ __forceinline__ float bfhi(unsigned w) { return __uint_as_float(w & 0xffff0000u); }
__device__ __forceinline__ unsigned pk2(float lo, float hi) { unsigned r; asm("v_cvt_pk_bf16_f32 %0, %1, %2" : "=v"(r) : "v"(lo), "v"(hi)); return r; }
__device__ __forceinline__ u16 f2bf(float f) { return (u16)(pk2(f, 0.f) & 0xffffu); }
__device__ __forceinline__ float wave_sum(float v) {
#pragma unroll
    for (int o = 32; o; o >>= 1) v += __shfl_xor(v, o);
    return v;
}
__device__ __forceinline__ float siluf(float x) { return x / (1.f + __expf(-x)); }
__device__ __forceinline__ float sigmf(float x) { return 1.f / (1.f + __expf(-x)); }
__device__ __forceinline__ int seq_of(int tok) { return tok < NPT ? (tok >> 13) : 2 + ((tok - NPT) >> 5); }
__device__ __forceinline__ int pos_of(int tok) { return tok < NPT ? (tok & 8191) : 1024 + ((tok - NPT) & 31); }
__device__ __forceinline__ float lam_init_of(int l) { return 0.8f - 0.6f * __expf(-0.3f * (float)l); }

__device__ __forceinline__ int tidx() { int t = (int)__builtin_amdgcn_workitem_id_x(); asm volatile("" : "+v"(t)); return t; }
__device__ __forceinline__ int bidx() { int b = (int)__builtin_amdgcn_workgroup_id_x(); asm volatile("" : "+s"(b)); return b; }

__device__ __forceinline__ int permk(int x) { const int e = x & 31, q = e >> 2; return (x & ~31) | ((q < 4 ? 2 * q : 2 * (q - 4) + 1) << 2) | (e & 3); }

namespace pg8 {
#define PG8_LAS __attribute__((address_space(3)))
typedef unsigned short bf16_t;
typedef unsigned u32x4 __attribute__((ext_vector_type(4)));
constexpr int BM = 256, BK = 64, HALF = 128, HTB = HALF * BK * 2  , STAGE_BYTES = 8 * HTB, NXCD = 8, WGM = 8;

__host__ __device__ __forceinline__ int lds_byte(int r, int c) { const int st = (r >> 4) * 2 + (c >> 5), rr = r & 15, cc = c & 31, ob = rr * 64 + cc * 2; return st * 1024 + (ob ^ (((ob >> 9) & 1) << 5)); }
__host__ __device__ __forceinline__ void stage_rc(int b, int& R, int& C) { const int st = b / 1024, sb = b % 1024, swz = sb ^ (((sb >> 9) & 1) << 5); R = (st >> 1) * 16 + swz / 64; C = (st & 1) * 32 + (swz % 64) / 2; }
__host__ __device__ __forceinline__ int perm32(int rho) { const int n = rho >> 4, i = rho & 15; return 8 * (i >> 2) + 4 * n + (i & 3); }

struct Unit { int pm, pn; };
struct Gemm { const bf16_t* A; const bf16_t* Bt; int M, N, K; };

struct StaticOrder {
    int nM, nN, nwg, G, c;
    __host__ __device__ void init(int M, int N, int G_, int c_) { nM = M / BM; nN = N / BM; nwg = nM * nN; G = G_; c = c_; }
    __host__ __device__ bool next(int i, Unit& u) const {
        const long L = (long)i * G + c; if (L >= nwg) return false;
        int wgid = (int)L; { const int q = nwg / NXCD, r = nwg % NXCD, xcd = wgid % NXCD, off = wgid / NXCD; wgid = (xcd < r ? xcd * (q + 1) : r * (q + 1) + (xcd - r) * q) + off; }
        const int nig = WGM * nN, gid = wgid / nig, fm = gid * WGM, gsz = (nM - fm) < WGM ? (nM - fm) : WGM;
        u.pm = fm + ((wgid % nig) % gsz); u.pn = (wgid % nig) / gsz; return true;
    }
    __device__ __forceinline__ void a_ready(const Unit&) const {}
    __device__ __forceinline__ void done(const Unit&) const {}
};

template <class Epi, class Sched, bool STAMP = false>
__device__ __forceinline__ void gemm_phase(PG8_LAS unsigned char* lds, const Gemm g, const Sched& S, const Epi& E, unsigned long long* stamps) {
    const int tid = tidx(), wid = __builtin_amdgcn_readfirstlane(tid >> 6), lane = tid & 63, wr = wid >> 2, wc = wid & 3, fr = lane & 15, fq = lane >> 4;
    const int K = g.K, nt = K / BK;
    int ts_lo = 0, ts_hi = 0, nts = 0; const unsigned long long rt_entry = STAMP ? (unsigned long long)wall_clock64() : 0ull;
#define PG8_STAMP() do { if (STAMP && wid == 0 && nts < 64) { const unsigned long long _c = (unsigned long long)clock64(); \
        ts_lo = (lane == nts) ? (int)(unsigned)_c : ts_lo; ts_hi = (lane == nts) ? (int)(unsigned)(_c >> 32) : ts_hi; ++nts; } } while (0)
    PG8_STAMP();
    unsigned voffA[2], voffB[2];
#pragma unroll
    for (int i = 0; i < 2; ++i) { int R, C; stage_rc(tid * 16 + i * 8192, R, C); const int Rb = Epi::PERM ? ((R & ~31) + perm32(R & 31)) : R;
        voffA[i] = (unsigned)(R * K + C) * 2u; voffB[i] = (unsigned)(Rb * K + C) * 2u; }
    const size_t kstep = (size_t)(BK * 2);
    const size_t hstep = (size_t)HALF * K * 2;
    const size_t tstep = 2 * hstep;
    const unsigned ldsw = (unsigned)wid * 1024u;
    const int aoff = lds_byte(wr * 64 + fr, fq * 8), boff = lds_byte(wc * 32 + fr, fq * 8);
#define PG8_SA(b, h) (((b) * 2 + (h)) * HTB)
#define PG8_SB(b, h) ((4 + (b) * 2 + (h)) * HTB)
#define PG8_STAGE(bufoff, gbase, voff) do { _Pragma("unroll") for (int _i = 0; _i < 2; ++_i) \
        __builtin_amdgcn_global_load_lds((const unsigned*)((const char*)(gbase) + (voff)[_i]), (PG8_LAS unsigned*)(lds + (bufoff) + ldsw + _i * 8192), 16, 0, 0); } while (0)
#define PG8_LDA(dst, b, h) do { _Pragma("unroll") for (int m = 0; m < 4; ++m) _Pragma("unroll") for (int k = 0; k < 2; ++k) dst[m][k] = *(const PG8_LAS bf16x8*)(lds + PG8_SA(b, h) + aoff + m * 2048 + k * 1024); } while (0)
#define PG8_LDB(dst, b, h) do { _Pragma("unroll") for (int n = 0; n < 2; ++n) _Pragma("unroll") for (int k = 0; k < 2; ++k) dst[n][k] = *(const PG8_LAS bf16x8*)(lds + PG8_SB(b, h) + boff + n * 2048 + k * 1024); } while (0)
#define PG8_MMA(ai, bj, At, Bt) do { __builtin_amdgcn_s_setprio(1); _Pragma("unroll") for (int k = 0; k < 2; ++k) _Pragma("unroll") for (int m = 0; m < 4; ++m) _Pragma("unroll") for (int n = 0; n < 2; ++n) \
        acc[ai][bj][m][n] = __builtin_amdgcn_mfma_f32_16x16x32_bf16(Bt[n][k], At[m][k], acc[ai][bj][m][n], 0, 0, 0); __builtin_amdgcn_s_setprio(0); } while (0)
#define PG8_WAIT_V(n) asm volatile("s_waitcnt vmcnt(" #n ")" ::: "memory")
#define PG8_WAIT_L(n) asm volatile("s_waitcnt lgkmcnt(" #n ")" ::: "memory")
#define PG8_BAR __builtin_amdgcn_s_barrier()
#define PG8_SCHED __builtin_amdgcn_sched_barrier(0)
    Unit cur, nxt; int ui = 0;
    if (!S.next(0, cur)) return;
    f32x4 acc[2][2][4][2];
#pragma unroll
    for (int a = 0; a < 2; ++a)
#pragma unroll
        for (int b = 0; b < 2; ++b)
#pragma unroll
            for (int m = 0; m < 4; ++m)
#pragma unroll
                for (int n = 0; n < 2; ++n) acc[a][b][m][n] = (f32x4){0.f, 0.f, 0.f, 0.f};
    bf16x8 At[4][2], B0[2][2], B1[2][2];
    const char* cA = (const char*)g.A + (size_t)cur.pm * tstep; const char* cB = (const char*)g.Bt + (size_t)cur.pn * tstep;
    S.a_ready(cur);
    PG8_STAGE(PG8_SB(0, 0), cB, voffB); PG8_STAGE(PG8_SA(0, 0), cA, voffA); PG8_STAGE(PG8_SB(0, 1), cB + hstep, voffB); PG8_STAGE(PG8_SA(0, 1), cA + hstep, voffA);
    if (wr == 1) PG8_BAR;
    PG8_WAIT_V(4); PG8_BAR;
    PG8_STAGE(PG8_SB(1, 0), cB + kstep, voffB); PG8_STAGE(PG8_SA(1, 0), cA + kstep, voffA); PG8_STAGE(PG8_SB(1, 1), cB + hstep + kstep, voffB);
    PG8_WAIT_V(6); PG8_BAR;
    PG8_STAMP();
    for (;;) {
        const bool has_next = S.next(ui + 1, nxt);
        const char* nA = has_next ? (const char*)g.A + (size_t)nxt.pm * tstep : cA; const char* nB = has_next ? (const char*)g.Bt + (size_t)nxt.pn * tstep : cB;
        for (int t = 0; t < nt; t += 2) {
            const bool last = (t == nt - 2);
            const char* a1 = cA + (size_t)(t + 1) * kstep;
            const char* a2 = last ? nA : cA + (size_t)(t + 2) * kstep; const char* b2 = last ? nB : cB + (size_t)(t + 2) * kstep;
            const char* a3 = a2 + kstep; const char* b3 = b2 + kstep;
            if (last && has_next) S.a_ready(nxt);
            PG8_LDB(B0, 0, 0); PG8_SCHED; PG8_LDA(At, 0, 0); PG8_STAGE(PG8_SA(1, 1), a1 + hstep, voffA);
            PG8_WAIT_L(8); PG8_BAR; PG8_WAIT_L(0); PG8_MMA(0, 0, At, B0); PG8_BAR; PG8_SCHED;
            PG8_LDB(B1, 0, 1); PG8_STAGE(PG8_SB(0, 0), b2, voffB);
            PG8_BAR; PG8_WAIT_L(0); PG8_MMA(0, 1, At, B1); PG8_BAR;
            PG8_LDA(At, 0, 1); PG8_STAGE(PG8_SA(0, 0), a2, voffA);
            PG8_BAR; PG8_WAIT_L(0); PG8_MMA(1, 0, At, B0); PG8_BAR; PG8_SCHED;
            PG8_STAGE(PG8_SB(0, 1), b2 + hstep, voffB);
            PG8_WAIT_V(6); PG8_BAR; PG8_MMA(1, 1, At, B1); PG8_BAR;
            PG8_LDB(B0, 1, 0); PG8_SCHED; PG8_LDA(At, 1, 0); PG8_STAGE(PG8_SA(0, 1), a2 + hstep, voffA);
            PG8_WAIT_L(8); PG8_BAR; PG8_WAIT_L(0); PG8_MMA(0, 0, At, B0); PG8_BAR; PG8_SCHED;
            PG8_LDB(B1, 1, 1); PG8_STAGE(PG8_SB(1, 0), b3, voffB);
            PG8_BAR; PG8_WAIT_L(0); PG8_MMA(0, 1, At, B1); PG8_BAR;
            PG8_LDA(At, 1, 1); PG8_STAGE(PG8_SA(1, 0), a3, voffA);
            PG8_BAR; PG8_WAIT_L(0); PG8_MMA(1, 0, At, B0); PG8_BAR; PG8_SCHED;
            PG8_STAGE(PG8_SB(1, 1), b3 + hstep, voffB);
            PG8_WAIT_V(6); PG8_BAR; PG8_MMA(1, 1, At, B1); PG8_BAR;
        }
        PG8_STAMP();
        if constexpr (!Epi::AFTER_DRAIN) { E(acc, cur, wr, wc, fr, fq); S.done(cur); }
        PG8_STAMP();
        if (!has_next) break;
#pragma unroll
        for (int a = 0; a < 2; ++a)
#pragma unroll
            for (int b = 0; b < 2; ++b)
#pragma unroll
                for (int m = 0; m < 4; ++m)
#pragma unroll
                    for (int n = 0; n < 2; ++n) acc[a][b][m][n] = (f32x4){0.f, 0.f, 0.f, 0.f};
        cur = nxt; cA = nA; cB = nB; ++ui;
    }
    PG8_WAIT_V(0);
    if (wr == 0) PG8_BAR;
    PG8_BAR;
    if constexpr (Epi::AFTER_DRAIN) { E.fused(acc, cur, wr, wc, fr, fq, lds, wid, lane); S.done(cur); }
    PG8_STAMP();
    if (STAMP && wid == 0) { stamps[lane] = lane < nts ? (((unsigned long long)(unsigned)ts_hi << 32) | (unsigned)ts_lo) : 0ull;
        if (lane == 62) stamps[62] = rt_entry; if (lane == 63) stamps[63] = (unsigned long long)wall_clock64(); }
#undef PG8_STAMP
#undef PG8_SA
#undef PG8_SB
#undef PG8_STAGE
#undef PG8_LDA
#undef PG8_LDB
#undef PG8_MMA
#undef PG8_WAIT_V
#undef PG8_WAIT_L
#undef PG8_BAR
#undef PG8_SCHED
}
}

struct EpiP {
    static constexpr bool PERM = true, AFTER_DRAIN = false;
    u16* O;
    __device__ __forceinline__ void operator()(const f32x4 (&acc)[2][2][4][2], const pg8::Unit& u, int wr, int wc, int fr, int fq) const {
        const int row0 = u.pm * 256 + wr * 64 + fr, col0 = u.pn * 256 + wc * 32 + 8 * fq;
#pragma unroll
        for (int ai = 0; ai < 2; ++ai)
#pragma unroll
            for (int m = 0; m < 4; ++m) { u16* rowp = O + (size_t)(row0 + ai * 128 + m * 16) * LDP + col0;
#pragma unroll
                for (int bj = 0; bj < 2; ++bj) { const f32x4 v0 = acc[ai][bj][m][0], v1 = acc[ai][bj][m][1];
                    uint4 w; w.x = pk2(v0[0], v0[1]); w.y = pk2(v0[2], v0[3]); w.z = pk2(v1[0], v1[1]); w.w = pk2(v1[2], v1[3]);
                    *(uint4*)(rowp + bj * 128) = w; } }
    }
};
template <int MODE> struct EpiG2 {
    static constexpr bool PERM = true, AFTER_DRAIN = false;
    const u16* P; float* T1; u16* MG;
    __device__ __forceinline__ void operator()(const f32x4 (&acc)[2][2][4][2], const pg8::Unit& u, int wr, int wc, int fr, int fq) const {
        const int row0 = u.pm * 256 + wr * 64 + fr, col0 = u.pn * 256 + wc * 32 + 8 * fq;
#pragma unroll
        for (int aq = 0; aq < 4; ++aq) {
            const int ai = aq >> 1, m0 = (aq & 1) * 2;
            uint4 g[4]; float4 ta[4], tb[4];
#pragma unroll
            for (int m = m0; m < m0 + 2; ++m)
#pragma unroll
                for (int bj = 0; bj < 2; ++bj) {
                    const size_t row = (size_t)(row0 + ai * 128 + m * 16); const int col = col0 + bj * 128;
                    g[(m - m0) * 2 + bj] = *(const uint4*)(P + row * LDP + (MODE == 0 ? 8192 : 9216) + col);
                    if (MODE == 1) { const float* tp = T1 + row * 1024 + col; ta[(m - m0) * 2 + bj] = *(const float4*)tp; tb[(m - m0) * 2 + bj] = *(const float4*)(tp + 4); }
                }
            __builtin_amdgcn_sched_barrier(0);
#pragma unroll
            for (int m = m0; m < m0 + 2; ++m)
#pragma unroll
                for (int bj = 0; bj < 2; ++bj) {
                    const size_t row = (size_t)(row0 + ai * 128 + m * 16); const int col = col0 + bj * 128;
                    const uint4 gg = g[(m - m0) * 2 + bj];
                    const f32x4 v0 = acc[ai][bj][m][0], v1 = acc[ai][bj][m][1];
                    const float r0 = sigmf(bflo(gg.x)) * v0[0], r1 = sigmf(bfhi(gg.x)) * v0[1], r2 = sigmf(bflo(gg.y)) * v0[2], r3 = sigmf(bfhi(gg.y)) * v0[3];
                    const float r4 = sigmf(bflo(gg.z)) * v1[0], r5 = sigmf(bfhi(gg.z)) * v1[1], r6 = sigmf(bflo(gg.w)) * v1[2], r7 = sigmf(bfhi(gg.w)) * v1[3];
                    if (MODE == 0) { float* tp = T1 + row * 1024 + col; *(float4*)tp = make_float4(r0, r1, r2, r3); *(float4*)(tp + 4) = make_float4(r4, r5, r6, r7); }
                    else { const float4 x = ta[(m - m0) * 2 + bj], y = tb[(m - m0) * 2 + bj];
                        uint4 w; w.x = pk2(x.x + r0, x.y + r1); w.y = pk2(x.z + r2, x.w + r3); w.z = pk2(y.x + r4, y.y + r5); w.w = pk2(y.z + r6, y.w + r7);
                        *(uint4*)(MG + row * 1024 + col) = w; }
                }
        }
    }
};
struct EpiG3 {
    static constexpr bool PERM = false, AFTER_DRAIN = false;
    float* X; const float* MODL;
    __device__ __forceinline__ void operator()(const f32x4 (&acc)[2][2][4][2], const pg8::Unit& u, int wr, int wc, int fr, int fq) const {
        const int row0 = u.pm * 256 + wr * 64 + fr, col0 = u.pn * 256 + wc * 32 + 4 * fq;
#pragma unroll
        for (int ai = 0; ai < 2; ++ai)
#pragma unroll
            for (int m = 0; m < 4; ++m) { const int row = row0 + ai * 128 + m * 16; const float* gp = MODL + seq_of(row) * 3072 + 2048;
#pragma unroll
                for (int bj = 0; bj < 2; ++bj)
#pragma unroll
                    for (int n = 0; n < 2; ++n) { const int col = col0 + bj * 128 + n * 16;
                        const float4 g = *(const float4*)(gp + col); float4* xp = (float4*)(X + (size_t)row * 1024 + col); float4 x = *xp; const f32x4 a = acc[ai][bj][m][n];
                        x.x += g.x * a[0]; x.y += g.y * a[1]; x.z += g.z * a[2]; x.w += g.w * a[3]; *xp = x; } }
    }
};

template <class Epi> __device__ __forceinline__ void run_gemm(unsigned char* lds, const u16* A, const u16* Bt, int M, int N, const Epi& E) {
    pg8::Gemm g; g.A = A; g.Bt = Bt; g.M = M; g.N = N; g.K = 1024;
    pg8::StaticOrder S; S.init(M, N, (int)gridDim.x, (int)bidx());
    pg8::gemm_phase<Epi, pg8::StaticOrder, false>((PG8_LAS unsigned char*)lds, g, S, E, nullptr);
}

__device__ __forceinline__ void phase_prep(const Params& p, unsigned char* lds) {
    float* ldsf = (float*)lds;
    const int tid = tidx(), nb = gridDim.x, bid = bidx(), wid = tid >> 6, lane = tid & 63;
    if (bid == 0 && tid < 4) ((unsigned*)(p.ws + WS_GLAST + 12288))[tid] = 0u;
    {
        const float4* xp = (const float4*)p.in[0]; const float4* xs = (const float4*)p.in[1];
        float4* X = (float4*)(p.ws + WS_X);
        const size_t n4p = (size_t)NPT * 256, n4 = (size_t)NTOK * 256;
        for (size_t i = (size_t)bid * 512 + tid; i < n4; i += (size_t)nb * 512) X[i] = i < n4p ? xp[i] : xs[i - n4p];
        float2* CS = (float2*)(p.ws + WS_CS);
        for (int i = bid * 512 + tid; i < 8192 * 32; i += nb * 512) {
            const int pos = i >> 5, d = i & 31;
            const float inv = powf(10000.0f, -(float)d / 32.0f);
            const float ang = (float)pos * inv;
            const float kf = rintf(ang * 0.636619772367581343f);
            float r = fmaf(-kf, 1.5707962512969971f, ang); r = fmaf(-kf, 7.5497894158615964e-08f, r); r = fmaf(-kf, 5.3903029534742384e-15f, r);
            const float sr = sinf(r), cr = cosf(r);
            const int q = ((int)kf) & 3;
            float s, c;
            if (q == 0) { s = sr; c = cr; } else if (q == 1) { s = cr; c = -sr; } else if (q == 2) { s = -sr; c = -cr; } else { s = -cr; c = sr; }
            CS[i] = make_float2(c, s);
        }
    }
    {
        const int NT_IN = LDP / 64, per_layer = (NT_IN + 48) * 16;
        for (int it = bid; it < 4 * per_layer; it += nb) {
            const int l = it / per_layer, r = it % per_layer, kt = r & 15; int ntile = r >> 4;
            const float* src; u16* dst; int ldn; bool is_in;
            if (ntile < NT_IN) { is_in = true; src = p.in[11] + (size_t)l * 1024 * 10256; ldn = 10256; dst = (u16*)(p.ws + WS_WTIN) + (size_t)l * LDP * 1024; }
            else { const int q = (ntile - NT_IN) >> 4; ntile = (ntile - NT_IN) & 15; is_in = false; src = p.in[18 + q] + (size_t)l * 1024 * 1024; ldn = 1024;
                   dst = (u16*)(p.ws + (q == 0 ? WS_WTPA : (q == 1 ? WS_WTPB : WS_WTOUT))) + (size_t)l * 1024 * 1024; }
            const int n0 = ntile * 64, k0 = kt * 64;
            __syncthreads();
#pragma unroll
            for (int i = 0; i < 2; ++i) {
                const int kk = (tid >> 4) + 32 * i, nn = (tid & 15) * 4, np = n0 + nn; int sc = np;
                if (is_in) sc = np < 4096 ? np : (np < 10240 ? np + 16 : (np < 10256 ? np - 10240 + 4096 : -1));
                float4 v = make_float4(0.f, 0.f, 0.f, 0.f);
                if (sc >= 0) v = *(const float4*)(src + (size_t)(k0 + kk) * ldn + sc);
                ldsf[kk * 65 + nn] = v.x; ldsf[kk * 65 + nn + 1] = v.y; ldsf[kk * 65 + nn + 2] = v.z; ldsf[kk * 65 + nn + 3] = v.w;
            }
            __syncthreads();
#pragma unroll
            for (int i = 0; i < 4; ++i) {
                const int nn = (tid >> 5) + 16 * i, kk = 2 * (tid & 31);
                *(unsigned*)(dst + (size_t)(n0 + nn) * 1024 + k0 + kk) = pk2(ldsf[kk * 65 + nn], ldsf[(kk + 1) * 65 + nn]);
            }
        }
    }
    {
        __syncthreads();
        for (int i = tid; i < 18 * 1024; i += 512) ldsf[i] = i < 2048 ? p.in[2][i] : p.in[3][i - 2048];
        float* part = ldsf + 18432;
        float* MOD = (float*)(p.ws + WS_MOD);
        __syncthreads();
        for (int it = bid; it < 4 * 48; it += nb) {
            const int l = it / 48, j0 = (it % 48) * 64;
            const float* W = p.in[9] + (size_t)l * 1024 * 3072 + j0 + lane;
            float acc[18];
#pragma unroll
            for (int s = 0; s < 18; ++s) acc[s] = 0.f;
            for (int k = wid * 128; k < wid * 128 + 128; ++k) {
                const float w = W[(size_t)k * 3072];
#pragma unroll
                for (int s = 0; s < 18; ++s) acc[s] = fmaf(ldsf[s * 1024 + k], w, acc[s]);
            }
#pragma unroll
            for (int s = 0; s < 18; ++s) part[(wid * 18 + s) * 64 + lane] = acc[s];
            __syncthreads();
            for (int o = tid; o < 1152; o += 512) {
                const int s = o >> 6, j = o & 63; float v = p.in[10][l * 3072 + j0 + j];
#pragma unroll
                for (int w = 0; w < 8; ++w) v += part[(w * 18 + s) * 64 + j];
                MOD[(size_t)(l * 18 + s) * 3072 + j0 + j] = v;
            }
            __syncthreads();
        }
    }
}

__device__ __forceinline__ void phase_norm(const Params& p, int l) {
    const int wid = tidx() >> 6, lane = tidx() & 63;
    const float* X = (const float*)(p.ws + WS_X);
    const float* nw = p.in[8] + l * 1024;
    const float* MODL = (const float*)(p.ws + WS_MOD) + (size_t)l * 18 * 3072;
    u16* H = (u16*)(p.ws + WS_H);
    for (int tok = bidx() * 8 + wid; tok < NTOK; tok += gridDim.x * 8) {
        const float4* xr = (const float4*)(X + (size_t)tok * 1024);
        float4 v[4]; float ss = 0.f;
#pragma unroll
        for (int i = 0; i < 4; ++i) { v[i] = xr[lane + 64 * i]; ss += v[i].x * v[i].x + v[i].y * v[i].y + v[i].z * v[i].z + v[i].w * v[i].w; }
        ss = wave_sum(ss);
        const float rstd = rsqrtf(ss * (1.f / 1024.f) + EPSF);
        const float* ms = MODL + seq_of(tok) * 3072;
#pragma unroll
        for (int i = 0; i < 4; ++i) {
            const int c = (lane + 64 * i) * 4;
            const float4 w = *(const float4*)(nw + c), sh = *(const float4*)(ms + c), sc = *(const float4*)(ms + 1024 + c);
            const float h0 = v[i].x * rstd * w.x * (1.f + sc.x) + sh.x, h1 = v[i].y * rstd * w.y * (1.f + sc.y) + sh.y;
            const float h2 = v[i].z * rstd * w.z * (1.f + sc.z) + sh.z, h3 = v[i].w * rstd * w.w * (1.f + sc.w) + sh.w;
            *(uint2*)(H + (size_t)tok * 1024 + c) = make_uint2(pk2(h0, h1), pk2(h2, h3));
        }
    }
}

__device__ __forceinline__ void phase_post1(const Params& p, int l, unsigned char* lds) {
    const int tid = tidx(), wid = tid >> 6, lane = tid & 63, nb = gridDim.x, bid = bidx();
    const u16* P = (const u16*)(p.ws + WS_P);
    const int gw = bid * 8 + wid, nw = nb * 8;
    {
        const float* cw = p.in[12] + (size_t)l * 4 * 3072;
        for (int it = gw; it < 2112 * 6; it += nw) {
            const int tg = it / 6, sg = it % 6;
            const int tok0 = tg * 8, slot = sg * 4 + (lane >> 4), ch = slot * 128 + (lane & 15) * 8;
            const int t0 = tok0 < NPT ? (tok0 & 8191) : ((tok0 - NPT) & 31);
            float w[4][8], a[3][8];
#pragma unroll
            for (int j = 0; j < 4; ++j) { const float4 x = *(const float4*)(cw + j * 3072 + ch), y = *(const float4*)(cw + j * 3072 + ch + 4);
                w[j][0] = x.x; w[j][1] = x.y; w[j][2] = x.z; w[j][3] = x.w; w[j][4] = y.x; w[j][5] = y.y; w[j][6] = y.z; w[j][7] = y.w; }
            if (t0 == 0) {
                if (tok0 < NPT) {
#pragma unroll
                    for (int j = 0; j < 3; ++j)
#pragma unroll
                        for (int e = 0; e < 8; ++e) a[j][e] = 0.f;
                } else { const float* sc = p.in[7] + ((size_t)(l * 16 + ((tok0 - NPT) >> 5)) * 3) * 3072 + ch;
#pragma unroll
                    for (int j = 0; j < 3; ++j) { const float4 x = *(const float4*)(sc + j * 3072), y = *(const float4*)(sc + j * 3072 + 4);
                        a[j][0] = x.x; a[j][1] = x.y; a[j][2] = x.z; a[j][3] = x.w; a[j][4] = y.x; a[j][5] = y.y; a[j][6] = y.z; a[j][7] = y.w; } }
            } else {
#pragma unroll
                for (int j = 0; j < 3; ++j) { const uint4 u = *(const uint4*)(P + (size_t)(tok0 - 3 + j) * LDP + ch);
                    a[j][0] = bflo(u.x); a[j][1] = bfhi(u.x); a[j][2] = bflo(u.y); a[j][3] = bfhi(u.y); a[j][4] = bflo(u.z); a[j][5] = bfhi(u.z); a[j][6] = bflo(u.w); a[j][7] = bfhi(u.w); }
            }
            uint4 u[8];
#pragma unroll
            for (int i = 0; i < 8; ++i) u[i] = *(const uint4*)(P + (size_t)(tok0 + i) * LDP + ch);
            float y[8][8], ss[8];
#pragma unroll
            for (int i = 0; i < 8; ++i) {
                const float c[8] = {bflo(u[i].x), bfhi(u[i].x), bflo(u[i].y), bfhi(u[i].y), bflo(u[i].z), bfhi(u[i].z), bflo(u[i].w), bfhi(u[i].w)};
                float acc = 0.f;
#pragma unroll
                for (int e = 0; e < 8; ++e) {
                    const float v = siluf(w[0][e] * a[0][e] + w[1][e] * a[1][e] + w[2][e] * a[2][e] + w[3][e] * c[e]);
                    a[0][e] = a[1][e]; a[1][e] = a[2][e]; a[2][e] = c[e];
                    y[i][e] = v; acc += v * v;
                }
                ss[i] = acc;
            }
            if (sg < 4) {
#pragma unroll
                for (int o = 8; o; o >>= 1)
#pragma unroll
                    for (int i = 0; i < 8; ++i) ss[i] += __shfl_xor(ss[i], o);
                const float post = sg < 2 ? 0.08838834764831845f : 1.f;
#pragma unroll
                for (int i = 0; i < 8; ++i) { const float sc = rsqrtf(ss[i] + EPSF) * post;
#pragma unroll
                    for (int e = 0; e < 8; ++e) y[i][e] *= sc; }
            }
            u16* dst = (u16*)(p.ws + (sg < 2 ? WS_QA : (sg < 4 ? WS_KA : WS_VA))) + (slot & 7) * 128 + (lane & 15) * 8;
#pragma unroll
            for (int i = 0; i < 8; ++i)
                *(uint4*)(dst + (size_t)(tok0 + i) * 1024) = make_uint4(pk2(y[i][0], y[i][1]), pk2(y[i][2], y[i][3]), pk2(y[i][4], y[i][5]), pk2(y[i][6], y[i][7]));
        }
    }
    for (int idx = bid * 512 + tid; idx < 18 * 9216; idx += nb * 512) {
        const int s = idx / 9216, r = idx % 9216, j = r / 3072, c = r % 3072;
        const int tok = s < 2 ? s * 8192 + 8189 + j : NPT + (s - 2) * 32 + 29 + j;
        const float v = bf2f(P[(size_t)tok * LDP + c]);
        if (s < 2) p.out[O_CONVP + ((size_t)(l * 2 + s) * 3 + j) * 3072 + c] = v;
        else p.out[O_CONVS + ((size_t)(l * 16 + s - 2) * 3 + j) * 3072 + c] = v;
    }
    {
        float* BETA = (float*)(p.ws + WS_BETA); float* GLOG = (float*)(p.ws + WS_GLOG);
        for (int idx = bid * 512 + tid; idx < NTOK * 8; idx += nb * 512) {
            const int tok = idx >> 3, h = idx & 7;
            const float ba = bf2f(P[(size_t)tok * LDP + 10240 + h]), aa = bf2f(P[(size_t)tok * LDP + 10248 + h]);
            BETA[idx] = sigmf(ba);
            const float x = aa + p.in[14][l * 8 + h];
            const float sp = fmaxf(x, 0.f) + log1pf(__expf(-fabsf(x)));
            GLOG[idx] = -__expf(p.in[13][l * 8 + h]) * sp;
        }
    }
    {
        const float4* CS4 = (const float4*)(p.ws + WS_CS);
        u16* QB = (u16*)(p.ws + WS_QB); u16* KB = (u16*)(p.ws + WS_KB);
        const int hs = lane >> 4, mq = (lane >> 3) & 1, d4 = (lane & 7) * 4, vc = (lane & 15) * 8;
        for (int it = gw; it < NTOK * 2; it += nw) {
            const int tok = it >> 1, h = (it & 1) * 4 + hs;
            const float4 csa = CS4[(pos_of(tok) * 32 + d4) >> 1], csb = CS4[((pos_of(tok) * 32 + d4) >> 1) + 1];
            const float cc[4] = {csa.x, csa.z, csb.x, csb.z}, sn[4] = {csa.y, csa.w, csb.y, csb.w};
            const u16* pr = P + (size_t)tok * LDP;
            const int cb = h * 128 + mq * 64 + d4;
            const uint2 q1 = *(const uint2*)(pr + 4096 + cb), q2 = *(const uint2*)(pr + 4096 + cb + 32);
            const uint2 k1 = *(const uint2*)(pr + 5120 + cb), k2 = *(const uint2*)(pr + 5120 + cb + 32);
            const uint4 vv = *(const uint4*)(pr + 6144 + h * 128 + vc);
            const float q1f[4] = {bflo(q1.x), bfhi(q1.x), bflo(q1.y), bfhi(q1.y)}, q2f[4] = {bflo(q2.x), bfhi(q2.x), bflo(q2.y), bfhi(q2.y)};
            const float k1f[4] = {bflo(k1.x), bfhi(k1.x), bflo(k1.y), bfhi(k1.y)}, k2f[4] = {bflo(k2.x), bfhi(k2.x), bflo(k2.y), bfhi(k2.y)};
            float qa[4], qb[4], ka[4], kb[4];
#pragma unroll
            for (int e = 0; e < 4; ++e) {
                qa[e] = (q1f[e] * cc[e] - q2f[e] * sn[e]) * QSCALE; qb[e] = (q1f[e] * sn[e] + q2f[e] * cc[e]) * QSCALE;
                ka[e] = k1f[e] * cc[e] - k2f[e] * sn[e]; kb[e] = k1f[e] * sn[e] + k2f[e] * cc[e];
            }
            *(uint2*)(QB + (size_t)tok * 1024 + cb) = make_uint2(pk2(qa[0], qa[1]), pk2(qa[2], qa[3]));
            *(uint2*)(QB + (size_t)tok * 1024 + cb + 32) = make_uint2(pk2(qb[0], qb[1]), pk2(qb[2], qb[3]));
            *(uint2*)(KB + (size_t)tok * 1024 + cb) = make_uint2(pk2(ka[0], ka[1]), pk2(ka[2], ka[3]));
            *(uint2*)(KB + (size_t)tok * 1024 + cb + 32) = make_uint2(pk2(kb[0], kb[1]), pk2(kb[2], kb[3]));
            size_t orow; float* ko; float* vo;
            if (tok < NPT) { orow = ((size_t)(l * 2 + (tok >> 13)) * 8 + h) * 8192 + (tok & 8191); ko = p.out + O_KP; vo = p.out + O_VP; }
            else { const int r = tok - NPT; orow = ((size_t)(l * 16 + (r >> 5)) * 8 + h) * 32 + (r & 31); ko = p.out + O_KS; vo = p.out + O_VS; }
            *(float4*)(ko + orow * 128 + mq * 64 + d4) = make_float4(ka[0], ka[1], ka[2], ka[3]);
            *(float4*)(ko + orow * 128 + mq * 64 + d4 + 32) = make_float4(kb[0], kb[1], kb[2], kb[3]);
            *(float4*)(vo + orow * 128 + vc) = make_float4(bflo(vv.x), bfhi(vv.x), bflo(vv.y), bfhi(vv.y));
            *(float4*)(vo + orow * 128 + vc + 4) = make_float4(bflo(vv.z), bfhi(vv.z), bflo(vv.w), bfhi(vv.w));
        }
    }
    {
        u16* T = (u16*)lds;
        u16* VT = (u16*)(p.ws + WS_VT);
        uint4 pre0 = make_uint4(0, 0, 0, 0), pre1 = pre0;
#define VT_LOAD(it_) do { const int tt_ = (it_) & 127, h_ = ((it_) >> 7) & 7, b_ = (it_) >> 10; \
        pre0 = *(const uint4*)(P + (size_t)(b_ * 8192 + tt_ * 64 + (tid >> 4)) * LDP + 6144 + h_ * 128 + (tid & 15) * 8); \
        pre1 = *(const uint4*)(P + (size_t)(b_ * 8192 + tt_ * 64 + 32 + (tid >> 4)) * LDP + 6144 + h_ * 128 + (tid & 15) * 8); } while (0)
        if (bid < 2048) VT_LOAD(bid);
        for (int it = bid; it < 2048; it += nb) {
            const int tt = it & 127, h = (it >> 7) & 7, b = it >> 10;
            __syncthreads();
            *(uint4*)(T + (tid >> 4) * 136 + (tid & 15) * 8) = pre0; *(uint4*)(T + (32 + (tid >> 4)) * 136 + (tid & 15) * 8) = pre1;
            __syncthreads();
            if (it + nb < 2048) VT_LOAD(it + nb);
            const int c = tid & 127, tq = tid >> 7;
            unsigned w[8];
#pragma unroll
            for (int i = 0; i < 8; ++i) w[i] = (unsigned)T[(tq * 16 + 2 * i) * 136 + c] | ((unsigned)T[(tq * 16 + 2 * i + 1) * 136 + c] << 16);
            u16* o = VT + ((size_t)((b * 8 + h) * 128 + c)) * 8192 + tt * 64 + tq * 16;
            *(uint4*)o = make_uint4(w[0], w[1], w[4], w[5]); *(uint4*)(o + 8) = make_uint4(w[2], w[3], w[6], w[7]);
        }
#undef VT_LOAD
    }
}

__device__ __forceinline__ void gdn_chunk_load(const Params& p, int item, uint4& t0, uint4& t1, uint4& t2, uint4& t3, uint4& t4, uint4& t5, float& g, float& bt) {
    const int tid = tidx(), lane = tid & 63;
    const int ch = item >> 3, h = item & 7;
    const int tok0 = ch < 256 ? ch * 64 : NPT + (ch - 256) * 32, L = ch < 256 ? 64 : 32;
    const int row = (tid >> 4) & 31, seg = tid & 15;
    const uint4 z = make_uint4(0, 0, 0, 0);
    const size_t o0 = (size_t)(tok0 + row) * 1024 + h * 128 + seg * 8, o1 = o0 + (size_t)32 * 1024;
    const bool v1 = (row + 32) < L;
    t0 = *(const uint4*)((const u16*)(p.ws + WS_KA) + o0); t2 = *(const uint4*)((const u16*)(p.ws + WS_QA) + o0); t4 = *(const uint4*)((const u16*)(p.ws + WS_VA) + o0);
    t1 = z; t3 = z; t5 = z;
    if (v1) { t1 = *(const uint4*)((const u16*)(p.ws + WS_KA) + o1); t3 = *(const uint4*)((const u16*)(p.ws + WS_QA) + o1); t5 = *(const uint4*)((const u16*)(p.ws + WS_VA) + o1); }
    g = 0.f; bt = 0.f;
    if (tid < 64 && lane < L) { g = ((const float*)(p.ws + WS_GLOG))[(size_t)(tok0 + lane) * 8 + h]; bt = ((const float*)(p.ws + WS_BETA))[(size_t)(tok0 + lane) * 8 + h]; }
}
__device__ __forceinline__ void gdn_chunk_item(const Params& p, int item, int next_item, unsigned char* lds,
                                               uint4& t0, uint4& t1, uint4& t2, uint4& t3, uint4& t4, uint4& t5, float& gpre, float& bpre, const int skip = 0) {
    const int tid = tidx(), wid = tid >> 6, lane = tid & 63, fr = lane & 15, fq = lane >> 4;
    u16* kT = (u16*)lds; u16* qT = kT + 64 * 136; u16* vT = qT + 64 * 136;
    float* AT = (float*)(lds + 52224); float* Gs = (float*)(lds + 69632); float* Bs = Gs + 64;
    __syncthreads();
    {
        const int row = (tid >> 4) & 31, seg = tid & 15;
        *(uint4*)(kT + row * 136 + seg * 8) = t0; *(uint4*)(kT + (row + 32) * 136 + seg * 8) = t1;
        *(uint4*)(qT + row * 136 + seg * 8) = t2; *(uint4*)(qT + (row + 32) * 136 + seg * 8) = t3;
        *(uint4*)(vT + row * 136 + seg * 8) = t4; *(uint4*)(vT + (row + 32) * 136 + seg * 8) = t5;
    }
    if (wid == 0) {
        float g = gpre;
#pragma unroll
        for (int o = 1; o < 64; o <<= 1) { const float t = __shfl_up(g, o); if (lane >= o) g += t; }
        Gs[lane] = g;
        Bs[lane] = bpre;
    }
    __syncthreads();
    if (next_item >= 0) gdn_chunk_load(p, next_item, t0, t1, t2, t3, t4, t5, gpre, bpre);
    u16* QKM = (u16*)(p.ws + WS_QKM) + (size_t)item * 4096;
    if (!(skip & 2))
#pragma unroll
    for (int u = 0; u < 4; ++u) {
        const int id = wid * 4 + u, which = id >> 4, ti = (id >> 2) & 3, tj = id & 3;
        f32x4 acc = {0.f, 0.f, 0.f, 0.f};
        const u16* Ab = (which ? qT : kT) + (ti * 16 + fr) * 136 + fq * 8;
        const u16* Bb = kT + (tj * 16 + fr) * 136 + fq * 8;
#pragma unroll
        for (int ks = 0; ks < 4; ++ks) acc = __builtin_amdgcn_mfma_f32_16x16x32_bf16(*(const bf16x8*)(Ab + ks * 32), *(const bf16x8*)(Bb + ks * 32), acc, 0, 0, 0);
        const int j = tj * 16 + fr; const float Gj = Gs[j];
#pragma unroll
        for (int r = 0; r < 4; ++r) {
            const int i = ti * 16 + 4 * fq + r; const float Gi = Gs[i];
            if (which == 0) AT[j * 68 + i] = (i > j) ? Bs[i] * acc[r] * __expf(Gi - Gj) : 0.f;
            else QKM[i * 64 + permk(j)] = f2bf((i >= j) ? acc[r] * __expf(Gi - Gj) : 0.f);
        }
    }
    __syncthreads();
    if (tid < 256) { if (!(skip & 1)) {
        const int c = tid;
        int zoff; asm volatile("v_mov_b32 %0, 0" : "=v"(zoff));
        const float* ATz = AT + zoff;
        float* xs = (float*)(lds + 70144) + c;
        const u16* src = c < 128 ? (vT + c) : (kT + c - 128);
        for (int bk = 0; bk < 4; ++bk) {
            float w[16];
#pragma unroll
            for (int ii = 0; ii < 16; ++ii) { const int i = 16 * bk + ii; const float sc = c < 128 ? Bs[i] : Bs[i] * __expf(Gs[i]); w[ii] = sc * bf2f(src[i * 136]); }
#pragma unroll 4
            for (int j = 0; j < 16 * bk; ++j) {
                const float xj = xs[j * 256];
                const float4* ar = (const float4*)(ATz + j * 68 + 16 * bk);
#pragma unroll
                for (int q = 0; q < 4; ++q) { const float4 a4 = ar[q];
                    w[4 * q] = fmaf(-a4.x, xj, w[4 * q]); w[4 * q + 1] = fmaf(-a4.y, xj, w[4 * q + 1]); w[4 * q + 2] = fmaf(-a4.z, xj, w[4 * q + 2]); w[4 * q + 3] = fmaf(-a4.w, xj, w[4 * q + 3]); }
            }
            const float* ad = ATz + (16 * bk) * 69;
            float dg[15][16];
#pragma unroll
            for (int jj = 0; jj < 15; ++jj)
#pragma unroll
                for (int q = (jj + 1) >> 2; q < 4; ++q) { const float4 a4 = *(const float4*)(ad + jj * 68 + 4 * q);
                    dg[jj][4 * q] = a4.x; dg[jj][4 * q + 1] = a4.y; dg[jj][4 * q + 2] = a4.z; dg[jj][4 * q + 3] = a4.w; }
#pragma unroll
            for (int jj = 0; jj < 15; ++jj) {
                const float xj = w[jj];
#pragma unroll
                for (int ii = jj + 1; ii < 16; ++ii) w[ii] = fmaf(-dg[jj][ii], xj, w[ii]);
            }
            if (bk < 3) {
#pragma unroll
                for (int ii = 0; ii < 16; ++ii) xs[(16 * bk + ii) * 256] = w[ii];
            }
            if (c < 128) {
                u16* o = (u16*)(p.ws + WS_VNT) + (size_t)item * 8192 + c * 64 + 16 * bk;
                *(uint4*)o = make_uint4(pk2(w[0], w[1]), pk2(w[2], w[3]), pk2(w[4], w[5]), pk2(w[6], w[7]));
                *(uint4*)(o + 8) = make_uint4(pk2(w[8], w[9]), pk2(w[10], w[11]), pk2(w[12], w[13]), pk2(w[14], w[15]));
            } else {
                u16* o = (u16*)(p.ws + WS_KCUM) + (size_t)item * 8192 + permk(c - 128) + (16 * bk) * 128;
#pragma unroll
                for (int ii = 0; ii < 16; ++ii) o[ii * 128] = f2bf(w[ii]);
            }
        }
    } } else if (!(skip & 4)) {
        const int e = tid - 256;
        u16* QD = (u16*)(p.ws + WS_QD) + (size_t)item * 8192;
        u16* KDT = (u16*)(p.ws + WS_KDT) + (size_t)item * 8192;
        const float Gl = Gs[63];
#pragma unroll 4
        for (int k = 0; k < 16; ++k) {
            const int idx = e + 256 * k;
            { const int i = idx >> 6, dp = (idx & 63) * 2; const float s = __expf(Gs[i]);
              const unsigned u = *(const unsigned*)(qT + i * 136 + dp);
              *(unsigned*)(QD + i * 128 + permk(dp)) = pk2(bflo(u) * s, bfhi(u) * s); }
            { const int d = idx >> 5, jp = (idx & 31) * 2;
              const float v0 = bf2f(kT[jp * 136 + d]) * __expf(Gl - Gs[jp]), v1 = bf2f(kT[(jp + 1) * 136 + d]) * __expf(Gl - Gs[jp + 1]);
              *(unsigned*)(KDT + d * 64 + permk(jp)) = pk2(v0, v1); }
        }
        if (e == 0) ((float*)(p.ws + WS_GLAST))[item] = __expf(Gl);
    }
}

__device__ __forceinline__ bf16x8 ld2(const u16* a) { return *(const bf16x8*)a; }
__device__ __forceinline__ bf16x8 pkfrag(const f32x4& a, const f32x4& b) {
    typedef unsigned u32x4 __attribute__((ext_vector_type(4)));
    u32x4 w; w.x = pk2(a[0], a[1]); w.y = pk2(a[2], a[3]); w.z = pk2(b[0], b[1]); w.w = pk2(b[2], b[3]);
    return __builtin_bit_cast(bf16x8, w);
}
__device__ __forceinline__ void gdn_scan_item(const Params& p, int l, int ch0, int nsteps, int h, int cb, const float* s_init, float* s_out, int L) {
    const int lane = tidx() & 63, fr = lane & 15, fq = lane >> 4, c = cb * 16 + fr;
    f32x4 S[8];
#pragma unroll
    for (int u = 0; u < 8; ++u)
#pragma unroll
        for (int r = 0; r < 4; ++r) S[u][r] = s_init ? s_init[(size_t)(16 * u + 4 * fq + r) * 128 + c] : 0.f;
    float* ORAW = (float*)(p.ws + WS_ORAW);
    for (int st = 0; st < nsteps; ++st) {
        const int ch = ch0 + st, item = ch * 8 + h;
        const int tok0 = ch < 256 ? ch * 64 : NPT + (ch - 256) * 32;
        const u16* kc = (const u16*)(p.ws + WS_KCUM) + (size_t)item * 8192 + fr * 128 + 8 * fq;
        const u16* qd = (const u16*)(p.ws + WS_QD) + (size_t)item * 8192 + fr * 128 + 8 * fq;
        const u16* kdt = (const u16*)(p.ws + WS_KDT) + (size_t)item * 8192 + fr * 64 + 8 * fq;
        const u16* qk = (const u16*)(p.ws + WS_QKM) + (size_t)item * 4096 + fr * 64 + 8 * fq;
        const u16* vnt = (const u16*)(p.ws + WS_VNT) + (size_t)item * 8192 + c * 64 + 4 * fq;
        const float gl = ((const float*)(p.ws + WS_GLAST))[item];
        bf16x8 sb[4];
#pragma unroll
        for (int ks = 0; ks < 4; ++ks) sb[ks] = pkfrag(S[2 * ks], S[2 * ks + 1]);
        f32x4 w[4];
#pragma unroll
        for (int t = 0; t < 4; ++t) {
            f32x4 acc = {0.f, 0.f, 0.f, 0.f};
#pragma unroll
            for (int ks = 0; ks < 4; ++ks) acc = __builtin_amdgcn_mfma_f32_16x16x32_bf16(ld2(kc + t * 16 * 128 + ks * 32), sb[ks], acc, 0, 0, 0);
            const uint2 vn = *(const uint2*)(vnt + 16 * t);
            w[t][0] = bflo(vn.x) - acc[0]; w[t][1] = bfhi(vn.x) - acc[1]; w[t][2] = bflo(vn.y) - acc[2]; w[t][3] = bfhi(vn.y) - acc[3];
        }
        bf16x8 wb[2];
        wb[0] = pkfrag(w[0], w[1]); wb[1] = pkfrag(w[2], w[3]);
#pragma unroll
        for (int t = 0; t < 4; ++t) {
            f32x4 acc = {0.f, 0.f, 0.f, 0.f};
#pragma unroll
            for (int ks = 0; ks < 4; ++ks) acc = __builtin_amdgcn_mfma_f32_16x16x32_bf16(ld2(qd + t * 16 * 128 + ks * 32), sb[ks], acc, 0, 0, 0);
#pragma unroll
            for (int k2 = 0; k2 < 2; ++k2) acc = __builtin_amdgcn_mfma_f32_16x16x32_bf16(ld2(qk + t * 16 * 64 + k2 * 32), wb[k2], acc, 0, 0, 0);
#pragma unroll
            for (int r = 0; r < 4; ++r) { const int row = 16 * t + 4 * fq + r; if (row < L) ORAW[(size_t)(tok0 + row) * 1024 + h * 128 + c] = acc[r]; }
        }
#pragma unroll
        for (int u = 0; u < 8; ++u) {
            f32x4 acc = S[u] * gl;
#pragma unroll
            for (int k2 = 0; k2 < 2; ++k2) acc = __builtin_amdgcn_mfma_f32_16x16x32_bf16(ld2(kdt + u * 16 * 64 + k2 * 32), wb[k2], acc, 0, 0, 0);
            S[u] = acc;
        }
    }
#pragma unroll
    for (int u = 0; u < 8; ++u)
#pragma unroll
        for (int r = 0; r < 4; ++r) s_out[(size_t)(16 * u + 4 * fq + r) * 128 + c] = S[u][r];
}
constexpr int SC_KC = 0, SC_QD = 17408, SC_KDT = 34816, SC_QK = 53248, SC_STAGE = 62464;
__device__ __forceinline__ bf16x8 ld2s(const unsigned char* a) { return *(const bf16x8*)a; }
__device__ __forceinline__ void gdn_scan_block(const Params& p, int l, int b, int h, int cq, unsigned char* lds, const int mode = 0) {
    const int tid = tidx(), wid = __builtin_amdgcn_readfirstlane(tid >> 6), lane = tid & 63, fr = lane & 15, fq = lane >> 4;
    const int c = cq * 64 + (wid & 3) * 16 + fr;
    const bool comp = wid < 4 && mode != 1;
    const int rowA = tid >> 4, segA = tid & 15;
    const int rowB = tid >> 3, segB = tid & 7;
    const int sA = (rowA * 128 + segA * 8) * 2, dA = rowA * 272 + segA * 16;
    const int sB = (rowB * 64 + segB * 8) * 2, dB = rowB * 144 + segB * 16;
    const unsigned char* gKC = p.ws + WS_KCUM + sA; const unsigned char* gQD = p.ws + WS_QD + sA;
    const unsigned char* gKDT = p.ws + WS_KDT + sB; const unsigned char* gQK = p.ws + WS_QKM + sB;
    uint4 a0, a1, a2, a3, a4, a5, a6, b0, b1, b2, b3, b4, b5, b6;
#define SC_LOAD(P_, item) do { const size_t o_ = (size_t)(item) * 16384; \
        P_##0 = *(const uint4*)(gKC + o_); P_##1 = *(const uint4*)(gKC + o_ + 32 * 256); P_##2 = *(const uint4*)(gQD + o_); P_##3 = *(const uint4*)(gQD + o_ + 32 * 256); \
        P_##4 = *(const uint4*)(gKDT + o_); P_##5 = *(const uint4*)(gKDT + o_ + 64 * 128); P_##6 = *(const uint4*)(gQK + (size_t)(item) * 8192); } while (0)
#define SC_WRITE(P_, st) do { unsigned char* d_ = lds + (st) * SC_STAGE; \
        *(uint4*)(d_ + SC_KC + dA) = P_##0; *(uint4*)(d_ + SC_KC + dA + 32 * 272) = P_##1; *(uint4*)(d_ + SC_QD + dA) = P_##2; *(uint4*)(d_ + SC_QD + dA + 32 * 272) = P_##3; \
        *(uint4*)(d_ + SC_KDT + dB) = P_##4; *(uint4*)(d_ + SC_KDT + dB + 64 * 144) = P_##5; *(uint4*)(d_ + SC_QK + dB) = P_##6; } while (0)
    f32x4 S[8];
#pragma unroll
    for (int u = 0; u < 8; ++u) S[u] = (f32x4){0.f, 0.f, 0.f, 0.f};
    float* ORAW = (float*)(p.ws + (mode ? WS_T1 : WS_ORAW));
    const int item0 = (b * 128) * 8 + h;
    __syncthreads();
    SC_LOAD(a, item0); SC_WRITE(a, 0); SC_LOAD(a, item0 + 8);
    uint2 vn0[4], vn1[4]; float gl0, gl1;
    {
        const u16* vnt = (const u16*)(p.ws + WS_VNT) + (size_t)item0 * 8192 + c * 64 + 4 * fq;
#pragma unroll
        for (int t = 0; t < 4; ++t) { vn0[t] = *(const uint2*)(vnt + 16 * t); vn1[t] = *(const uint2*)(vnt + 8 * 8192 + 16 * t); }
        gl0 = ((const float*)(p.ws + WS_GLAST))[item0]; gl1 = ((const float*)(p.ws + WS_GLAST))[item0 + 8];
    }
    float* obuf = (float*)(lds + 2 * SC_STAGE);
    const int orow = tid >> 3, ocol = (tid & 7) * 8;
    __syncthreads();
    auto compute = [&](int st, uint2 (&vn)[4], const float gl) __attribute__((always_inline)) {
        const unsigned char* sb_ = lds + (st & 1) * SC_STAGE;
        const unsigned char* kc = sb_ + SC_KC + fr * 272 + fq * 16;
        const unsigned char* qd = sb_ + SC_QD + fr * 272 + fq * 16;
        const unsigned char* kdt = sb_ + SC_KDT + fr * 144 + fq * 16;
        const unsigned char* qk = sb_ + SC_QK + fr * 144 + fq * 16;
        bf16x8 ga[8], gb[8];
#define SC_RD(dst, base, pitch, t0, nk) do { _Pragma("unroll") for (int i_ = 0; i_ < 8; ++i_) dst[i_] = ld2s(base + ((t0) + i_ / (nk)) * 16 * (pitch) + (i_ % (nk)) * 64); } while (0)
        SC_RD(ga, kc, 272, 0, 4);
        SC_RD(gb, kc, 272, 2, 4);
        bf16x8 sb[4];
#pragma unroll
        for (int ks = 0; ks < 4; ++ks) sb[ks] = pkfrag(S[2 * ks], S[2 * ks + 1]);
        __builtin_amdgcn_sched_barrier(0);
        f32x4 w[4];
#pragma unroll
        for (int t = 0; t < 2; ++t) {
            f32x4 acc = {0.f, 0.f, 0.f, 0.f};
#pragma unroll
            for (int ks = 0; ks < 4; ++ks) acc = __builtin_amdgcn_mfma_f32_16x16x32_bf16(ga[t * 4 + ks], sb[ks], acc, 0, 0, 0);
            w[t][0] = bflo(vn[t].x) - acc[0]; w[t][1] = bfhi(vn[t].x) - acc[1]; w[t][2] = bflo(vn[t].y) - acc[2]; w[t][3] = bfhi(vn[t].y) - acc[3];
        }
        __builtin_amdgcn_sched_barrier(0);
        SC_RD(ga, kdt, 144, 0, 2);
        __builtin_amdgcn_sched_barrier(0);
#pragma unroll
        for (int t = 2; t < 4; ++t) {
            f32x4 acc = {0.f, 0.f, 0.f, 0.f};
#pragma unroll
            for (int ks = 0; ks < 4; ++ks) acc = __builtin_amdgcn_mfma_f32_16x16x32_bf16(gb[(t - 2) * 4 + ks], sb[ks], acc, 0, 0, 0);
            w[t][0] = bflo(vn[t].x) - acc[0]; w[t][1] = bfhi(vn[t].x) - acc[1]; w[t][2] = bflo(vn[t].y) - acc[2]; w[t][3] = bfhi(vn[t].y) - acc[3];
        }
        bf16x8 wb[2];
        wb[0] = pkfrag(w[0], w[1]); wb[1] = pkfrag(w[2], w[3]);
        __builtin_amdgcn_sched_barrier(0);
        SC_RD(gb, kdt, 144, 4, 2);
        __builtin_amdgcn_sched_barrier(0);
#pragma unroll
        for (int u = 0; u < 4; ++u) {
            f32x4 acc = S[u] * gl;
#pragma unroll
            for (int k2 = 0; k2 < 2; ++k2) acc = __builtin_amdgcn_mfma_f32_16x16x32_bf16(ga[u * 2 + k2], wb[k2], acc, 0, 0, 0);
            S[u] = acc;
        }
        __builtin_amdgcn_sched_barrier(0);
        SC_RD(ga, qd, 272, 0, 4);
        __builtin_amdgcn_sched_barrier(0);
#pragma unroll
        for (int u = 4; u < 8; ++u) {
            f32x4 acc = S[u] * gl;
#pragma unroll
            for (int k2 = 0; k2 < 2; ++k2) acc = __builtin_amdgcn_mfma_f32_16x16x32_bf16(gb[(u - 4) * 2 + k2], wb[k2], acc, 0, 0, 0);
            S[u] = acc;
        }
        __builtin_amdgcn_sched_barrier(0);
        SC_RD(gb, qd, 272, 2, 4);
        __builtin_amdgcn_sched_barrier(0);
        float* ob = obuf + (st & 1) * 4352 + (wid & 3) * 16 + fr;
        f32x4 o[4];
#pragma unroll
        for (int t = 0; t < 2; ++t) {
            o[t] = (f32x4){0.f, 0.f, 0.f, 0.f};
#pragma unroll
            for (int ks = 0; ks < 4; ++ks) o[t] = __builtin_amdgcn_mfma_f32_16x16x32_bf16(ga[t * 4 + ks], sb[ks], o[t], 0, 0, 0);
        }
        __builtin_amdgcn_sched_barrier(0);
        SC_RD(ga, qk, 144, 0, 2);
        __builtin_amdgcn_sched_barrier(0);
#pragma unroll
        for (int t = 2; t < 4; ++t) {
            o[t] = (f32x4){0.f, 0.f, 0.f, 0.f};
#pragma unroll
            for (int ks = 0; ks < 4; ++ks) o[t] = __builtin_amdgcn_mfma_f32_16x16x32_bf16(gb[(t - 2) * 4 + ks], sb[ks], o[t], 0, 0, 0);
        }
        __builtin_amdgcn_sched_barrier(0);
#pragma unroll
        for (int t = 0; t < 4; ++t) {
#pragma unroll
            for (int k2 = 0; k2 < 2; ++k2) o[t] = __builtin_amdgcn_mfma_f32_16x16x32_bf16(ga[t * 2 + k2], wb[k2], o[t], 0, 0, 0);
#pragma unroll
            for (int r = 0; r < 4; ++r) ob[(16 * t + 4 * fq + r) * 68] = o[t][r];
        }
#undef SC_RD
    };
#define SC_HALF(sc, LS, WS, VN, GL) do { \
        const int sp_ = (sc) > 0 ? (sc) - 1 : 0, sn_ = (sc) + 2 < 128 ? (sc) + 2 : 127; \
        const float4 ov_ = *(const float4*)(obuf + (sp_ & 1) * 4352 + orow * 68 + ocol), ow_ = *(const float4*)(obuf + (sp_ & 1) * 4352 + orow * 68 + ocol + 4); \
        if (mode != 2) SC_LOAD(LS, item0 + sn_ * 8); \
        { float* od_ = ORAW + (size_t)((b * 128 + sp_) * 64 + orow) * 1024 + h * 128 + cq * 64 + ocol; *(float4*)od_ = ov_; *(float4*)(od_ + 4) = ow_; }     \
        if (comp) compute(sc, VN, GL); \
        if (mode != 2) SC_WRITE(WS, ((sc) + 1) & 1); \
        { const u16* vnt_ = (const u16*)(p.ws + WS_VNT) + (size_t)(item0 + sn_ * 8) * 8192 + c * 64 + 4 * fq; \
          _Pragma("unroll") for (int t = 0; t < 4; ++t) VN[t] = *(const uint2*)(vnt_ + 16 * t); \
          GL = ((const float*)(p.ws + WS_GLAST))[item0 + sn_ * 8]; } \
        __syncthreads(); } while (0)
    for (int st = 0; st < 128; st += 2) { SC_HALF(st, b, a, vn0, gl0); SC_HALF(st + 1, a, b, vn1, gl1); }
#undef SC_HALF
    { float* od_ = ORAW + (size_t)((b * 128 + 127) * 64 + orow) * 1024 + h * 128 + cq * 64 + ocol; const float* os_ = obuf + 4352 + orow * 68 + ocol;
      *(float4*)od_ = *(const float4*)os_; *(float4*)(od_ + 4) = *(const float4*)(os_ + 4); }
#undef SC_LOAD
#undef SC_WRITE
    if (comp) {
        float* s_out = mode ? (float*)(p.ws + WS_T1) : p.out + O_SSMP + ((size_t)(l * 2 + b) * 8 + h) * 16384;
#pragma unroll
        for (int u = 0; u < 8; ++u)
#pragma unroll
            for (int r = 0; r < 4; ++r) s_out[(size_t)(16 * u + 4 * fq + r) * 128 + c] = S[u][r];
    }
}
__device__ __forceinline__ void phase_post2(const Params& p, int l) {
    const int wid = tidx() >> 6, lane = tidx() & 63, hs = lane >> 4, c8 = (lane & 15) * 8;
    const float* ORAW = (const float*)(p.ws + WS_ORAW); const u16* P = (const u16*)(p.ws + WS_P); u16* OAN = (u16*)(p.ws + WS_OAN);
    const float4 ga = *(const float4*)(p.in[15] + l * 128 + c8), gb = *(const float4*)(p.in[15] + l * 128 + c8 + 4);
    for (int it = bidx() * 8 + wid; it < NTOK * 2; it += gridDim.x * 8) {
        const int tok = it >> 1, h = (it & 1) * 4 + hs;
        const float* op = ORAW + (size_t)tok * 1024 + h * 128 + c8;
        const float4 x = *(const float4*)op, y = *(const float4*)(op + 4);
        const uint4 z = *(const uint4*)(P + (size_t)tok * LDP + 3072 + h * 128 + c8);
        float ss = x.x * x.x + x.y * x.y + x.z * x.z + x.w * x.w + y.x * y.x + y.y * y.y + y.z * y.z + y.w * y.w;
#pragma unroll
        for (int o = 8; o; o >>= 1) ss += __shfl_xor(ss, o);
        const float rstd = rsqrtf(ss * (1.f / 128.f) + EPSF);
        uint4 w;
        w.x = pk2(x.x * rstd * ga.x * siluf(bflo(z.x)), x.y * rstd * ga.y * siluf(bfhi(z.x)));
        w.y = pk2(x.z * rstd * ga.z * siluf(bflo(z.y)), x.w * rstd * ga.w * siluf(bfhi(z.y)));
        w.z = pk2(y.x * rstd * gb.x * siluf(bflo(z.z)), y.y * rstd * gb.y * siluf(bfhi(z.z)));
        w.w = pk2(y.z * rstd * gb.z * siluf(bflo(z.w)), y.w * rstd * gb.w * siluf(bfhi(z.w)));
        *(uint4*)(OAN + (size_t)tok * 1024 + h * 128 + c8) = w;
    }
}

__device__ __forceinline__ void phase_final(const Params& p) {
    const int wid = tidx() >> 6, lane = tidx() & 63;
    const float* X = (const float*)(p.ws + WS_X); const float* fw = p.in[21];
    for (int tok = bidx() * 8 + wid; tok < NTOK; tok += gridDim.x * 8) {
        const float4* xr = (const float4*)(X + (size_t)tok * 1024);
        float4 v[4]; float ss = 0.f;
#pragma unroll
        for (int i = 0; i < 4; ++i) { v[i] = xr[lane + 64 * i]; ss += v[i].x * v[i].x + v[i].y * v[i].y + v[i].z * v[i].z + v[i].w * v[i].w; }
        ss = wave_sum(ss);
        const float rstd = rsqrtf(ss * (1.f / 1024.f) + EPSF);
#pragma unroll
        for (int i = 0; i < 4; ++i) { const float4 w = ((const float4*)fw)[lane + 64 * i];
            ((float4*)(p.out + O_Y + (size_t)tok * 1024))[lane + 64 * i] = make_float4(v[i].x * rstd * w.x, v[i].y * rstd * w.y, v[i].z * rstd * w.z, v[i].w * rstd * w.w); }
    }
}

__device__ __forceinline__ float lam_of(const Params& p, int l, int lane) {
    const float* lq = p.in[16] + l * 256;
    const float a = wave_sum(lq[lane] * lq[64 + lane]), b = wave_sum(lq[128 + lane] * lq[192 + lane]);
    return __expf(a) - __expf(b) + lam_init_of(l);
}
__device__ __forceinline__ void attn_store(const Params& p, int l, int tok, int h, int hh, const f32x16 (&d)[4], float ss) {
    ss += __shfl_xor(ss, 32);
    const float sc = rsqrtf(ss * (1.f / 128.f) + EPSF) * (1.f - lam_init_of(l));
    const u16* zp = (const u16*)(p.ws + WS_P) + (size_t)tok * LDP + 7168 + h * 128;
    u16* op = (u16*)(p.ws + WS_OBN) + (size_t)tok * 1024 + h * 128;
    const float* dw = p.in[17] + l * 128;
#pragma unroll
    for (int t = 0; t < 4; ++t)
#pragma unroll
        for (int g = 0; g < 4; ++g) {
            const int vc = 32 * t + 8 * g + 4 * hh;
            const uint2 z = *(const uint2*)(zp + vc); const float4 w = *(const float4*)(dw + vc);
            const float o0 = d[t][4 * g] * sc * w.x * siluf(bflo(z.x)), o1 = d[t][4 * g + 1] * sc * w.y * siluf(bfhi(z.x));
            const float o2 = d[t][4 * g + 2] * sc * w.z * siluf(bflo(z.y)), o3 = d[t][4 * g + 3] * sc * w.w * siluf(bfhi(z.y));
            *(uint2*)(op + vc) = make_uint2(pk2(o0, o1), pk2(o2, o3));
        }
}

constexpr int AT_KPITCH = 272, AT_VPITCH = 144, AT_KBYTES = 64 * AT_KPITCH, AT_VBYTES = 128 * AT_VPITCH, AT_VBASE = 2 * AT_KBYTES;

__device__ __forceinline__ void attn_prompt_item(const Params& p, int l, int b, int h, int qb, unsigned char* lds) {
    const int tid = tidx(), wid = __builtin_amdgcn_readfirstlane(tid >> 6), lane = tid & 63;
    const int m = wid & 1, rg = wid >> 1, ql = lane & 31, hh = lane >> 5;
    const bool late = wid >= 4;
    const int tokq = b * 8192 + qb * 128 + rg * 32 + ql;
    const u16* QB = (const u16*)(p.ws + WS_QB);
    bf16x8 qf[4];
#pragma unroll
    for (int s = 0; s < 4; ++s) qf[s] = *(const bf16x8*)(QB + (size_t)tokq * 1024 + h * 128 + m * 64 + 16 * s + 8 * hh);
    const int ntb = 2 * qb + 2, ntw = 2 * qb + 1 + (rg >> 1);
    f32x16 O[4];
#pragma unroll
    for (int t = 0; t < 4; ++t)
#pragma unroll
        for (int r = 0; r < 16; ++r) O[t][r] = 0.f;
    float mrun = -1e30f, lrun = 0.f;
    const u16* KBp = (const u16*)(p.ws + WS_KB) + (size_t)(b * 8192) * 1024 + h * 128;
    const u16* VTp = (const u16*)(p.ws + WS_VT) + (size_t)((b * 8 + h) * 128) * 8192;
    const int krow0 = tid >> 4, kseg = tid & 15;
    const int vrow0 = tid >> 3, vseg = tid & 7;
    uint4 kr0, kr1, vr0, vr1;
#define AT_LOAD(j) do { \
        kr0 = *(const uint4*)(KBp + (size_t)((j) * 64 + krow0) * 1024 + kseg * 8); kr1 = *(const uint4*)(KBp + (size_t)((j) * 64 + krow0 + 32) * 1024 + kseg * 8); \
        vr0 = *(const uint4*)(VTp + (size_t)(vrow0) * 8192 + (j) * 64 + vseg * 8); vr1 = *(const uint4*)(VTp + (size_t)(vrow0 + 64) * 8192 + (j) * 64 + vseg * 8); } while (0)
#define AT_WRITE(ks_, vs_) do { unsigned char* kb = lds + (ks_) * AT_KBYTES; unsigned char* vb = lds + AT_VBASE + (vs_) * AT_VBYTES; \
        *(uint4*)(kb + (krow0) * AT_KPITCH + kseg * 16) = kr0; *(uint4*)(kb + (krow0 + 32) * AT_KPITCH + kseg * 16) = kr1; \
        *(uint4*)(vb + (vrow0) * AT_VPITCH + vseg * 16) = vr0; *(uint4*)(vb + (vrow0 + 64) * AT_VPITCH + vseg * 16) = vr1; } while (0)
    auto pv = [&](const unsigned char* vb, const bf16x8 f0, const bf16x8 f1, const bf16x8 f2, const bf16x8 f3) __attribute__((always_inline)) {
        const unsigned char* vl = vb + ql * AT_VPITCH + hh * 16;
        bf16x8 va[4], vc[4];
#define AT_VRD(dst, k) do { _Pragma("unroll") for (int t = 0; t < 4; ++t) dst[t] = *(const bf16x8*)(vl + (32 * t) * AT_VPITCH + (k) * 32); } while (0)
#define AT_VMM(src, f) do { _Pragma("unroll") for (int t = 0; t < 4; ++t) O[t] = __builtin_amdgcn_mfma_f32_32x32x16_bf16(src[t], f, O[t], 0, 0, 0); } while (0)
        AT_VRD(va, 0); AT_VRD(vc, 1);
        __builtin_amdgcn_sched_barrier(0);
        AT_VMM(va, f0);
        __builtin_amdgcn_sched_barrier(0);
        AT_VRD(va, 2);
        __builtin_amdgcn_sched_barrier(0);
        AT_VMM(vc, f1);
        __builtin_amdgcn_sched_barrier(0);
        AT_VRD(vc, 3);
        __builtin_amdgcn_sched_barrier(0);
        AT_VMM(va, f2); AT_VMM(vc, f3);
        __builtin_amdgcn_sched_barrier(0);
#undef AT_VRD
#undef AT_VMM
    };
    typedef unsigned u32x4 __attribute__((ext_vector_type(4)));
    u32x4 pp0 = {0, 0, 0, 0}, pp1 = {0, 0, 0, 0}, pp2 = {0, 0, 0, 0}, pp3 = {0, 0, 0, 0};
    __syncthreads();
    AT_LOAD(0); AT_WRITE(0, 0);
    __syncthreads();
    int vcur = 0;
    for (int j = 0; j < ntb; ++j) {
        const int vprev = vcur == 0 ? 2 : vcur - 1, vnext = vcur == 2 ? 0 : vcur + 1;
        if (j + 1 < ntb) AT_LOAD(j + 1);
        if (late && j >= 1) pv(lds + AT_VBASE + vprev * AT_VBYTES, __builtin_bit_cast(bf16x8, pp0), __builtin_bit_cast(bf16x8, pp1), __builtin_bit_cast(bf16x8, pp2), __builtin_bit_cast(bf16x8, pp3));
        if (j < ntw) {
            const unsigned char* kb = lds + (j & 1) * AT_KBYTES;
            bf16x8 kf[8];
#pragma unroll
            for (int kt = 0; kt < 2; ++kt)
#pragma unroll
                for (int s = 0; s < 4; ++s) kf[kt * 4 + s] = *(const bf16x8*)(kb + (32 * kt + ql) * AT_KPITCH + m * 128 + s * 32 + hh * 16);
            __builtin_amdgcn_sched_barrier(0);
            f32x16 st[2];
#pragma unroll
            for (int kt = 0; kt < 2; ++kt)
#pragma unroll
                for (int r = 0; r < 16; ++r) st[kt][r] = 0.f;
#pragma unroll
            for (int s = 0; s < 4; ++s) {
                st[0] = __builtin_amdgcn_mfma_f32_32x32x16_bf16(kf[s], qf[s], st[0], 0, 0, 0);
                st[1] = __builtin_amdgcn_mfma_f32_32x32x16_bf16(kf[4 + s], qf[s], st[1], 0, 0, 0);
            }
            __builtin_amdgcn_sched_barrier(0);
            float mx = st[0][0];
#pragma unroll
            for (int r = 1; r < 16; ++r) mx = fmaxf(mx, st[0][r]);
#pragma unroll
            for (int r = 0; r < 16; ++r) mx = fmaxf(mx, st[1][r]);
            mx = fmaxf(mx, __shfl_xor(mx, 32));
            if (__any(mx > mrun)) {
                const float mnew_ = fmaxf(mrun, mx), alpha = __builtin_amdgcn_exp2f(mrun - mnew_);
                mrun = mnew_; lrun *= alpha;
#pragma unroll
                for (int t = 0; t < 4; ++t) O[t] *= alpha;
            }
            const float mnew = mrun;
#define AT_PFRAG(dst, kt, s2) do { float e0 = __builtin_amdgcn_exp2f(st[kt][8 * s2 + 0] - mnew), e1 = __builtin_amdgcn_exp2f(st[kt][8 * s2 + 1] - mnew), \
        e2 = __builtin_amdgcn_exp2f(st[kt][8 * s2 + 2] - mnew), e3 = __builtin_amdgcn_exp2f(st[kt][8 * s2 + 3] - mnew), \
        e4 = __builtin_amdgcn_exp2f(st[kt][8 * s2 + 4] - mnew), e5 = __builtin_amdgcn_exp2f(st[kt][8 * s2 + 5] - mnew), \
        e6 = __builtin_amdgcn_exp2f(st[kt][8 * s2 + 6] - mnew), e7 = __builtin_amdgcn_exp2f(st[kt][8 * s2 + 7] - mnew); \
        lrun += ((e0 + e1) + (e2 + e3)) + ((e4 + e5) + (e6 + e7)); \
        dst.x = pk2(e0, e1); dst.y = pk2(e2, e3); dst.z = pk2(e4, e5); dst.w = pk2(e6, e7); } while (0)
            AT_PFRAG(pp0, 0, 0); AT_PFRAG(pp1, 0, 1); AT_PFRAG(pp2, 1, 0); AT_PFRAG(pp3, 1, 1);
#undef AT_PFRAG
            __builtin_amdgcn_sched_barrier(0);
            if (!late) pv(lds + AT_VBASE + vcur * AT_VBYTES, __builtin_bit_cast(bf16x8, pp0), __builtin_bit_cast(bf16x8, pp1), __builtin_bit_cast(bf16x8, pp2), __builtin_bit_cast(bf16x8, pp3));
        }
        if (j + 1 < ntb) AT_WRITE((j + 1) & 1, vnext);
        __syncthreads();
        vcur = vnext;
    }
    if (late) { const int vlast = vcur == 0 ? 2 : vcur - 1;
        pv(lds + AT_VBASE + vlast * AT_VBYTES, __builtin_bit_cast(bf16x8, pp0), __builtin_bit_cast(bf16x8, pp1), __builtin_bit_cast(bf16x8, pp2), __builtin_bit_cast(bf16x8, pp3)); }
    __syncthreads();
#undef AT_LOAD
#undef AT_WRITE
    const float inv = 1.f / (lrun + __shfl_xor(lrun, 32));
    float* xb = (float*)lds + rg * 4096;
    if (m == 1) {
#pragma unroll
        for (int t = 0; t < 4; ++t)
#pragma unroll
            for (int r = 0; r < 16; ++r) xb[(t * 16 + r) * 64 + lane] = O[t][r] * inv;
    }
    __syncthreads();
    if (m == 0) {
        const float lam = lam_of(p, l, lane);
        float ss = 0.f;
#pragma unroll
        for (int t = 0; t < 4; ++t)
#pragma unroll
            for (int r = 0; r < 16; ++r) { const float d = O[t][r] * inv - lam * xb[(t * 16 + r) * 64 + lane]; O[t][r] = d; ss += d * d; }
        attn_store(p, l, tokq, h, hh, O, ss);
    }
}

__device__ __forceinline__ void attn_sample_item(const Params& p, int l, int b, int h, unsigned char* lds) {
    const int tid = tidx(), wid = __builtin_amdgcn_readfirstlane(tid >> 6), lane = tid & 63, ql = lane & 31, hh = lane >> 5;
    const int t = wid & 3, kh = wid >> 2;
    const int tok0 = NPT + b * 32, tokq = tok0 + ql;
    const u16* QB = (const u16*)(p.ws + WS_QB); const u16* KB = (const u16*)(p.ws + WS_KB); const u16* P = (const u16*)(p.ws + WS_P);
    const float* CK = p.in[4] + ((size_t)(l * 16 + b) * 8 + h) * 1024 * 128;
    const float* CV = p.in[5] + ((size_t)(l * 16 + b) * 8 + h) * 1024 * 128;
    float* xo = (float*)lds;
    float* xss = (float*)(lds + 32768);
    typedef unsigned u32x4 __attribute__((ext_vector_type(4)));
    f32x16 O1;
#pragma unroll
    for (int r = 0; r < 16; ++r) O1[r] = 0.f;
    f32x16 O;
    __syncthreads();
    for (int m = 0; m < 2; ++m) {
        bf16x8 qf[4];
#pragma unroll
        for (int s = 0; s < 4; ++s) qf[s] = *(const bf16x8*)(QB + (size_t)tokq * 1024 + h * 128 + m * 64 + 16 * s + 8 * hh);
#pragma unroll
        for (int r = 0; r < 16; ++r) O[r] = 0.f;
        float mrun = -1e30f, lrun = 0.f;
        const int kt0 = kh ? 17 : 0, kt1 = kh ? 33 : 17;
        for (int kt = kt0; kt < kt1; ++kt) {
            f32x16 st;
#pragma unroll
            for (int r = 0; r < 16; ++r) st[r] = 0.f;
            if (kt < 32) {
                const float* kp = CK + (size_t)(kt * 32 + ql) * 128 + m * 64 + 8 * hh;
#pragma unroll
                for (int s = 0; s < 4; ++s) {
                    const float4 x = *(const float4*)(kp + 16 * s), y = *(const float4*)(kp + 16 * s + 4);
                    u32x4 w; w.x = pk2(x.x, x.y); w.y = pk2(x.z, x.w); w.z = pk2(y.x, y.y); w.w = pk2(y.z, y.w);
                    st = __builtin_amdgcn_mfma_f32_32x32x16_bf16(__builtin_bit_cast(bf16x8, w), qf[s], st, 0, 0, 0);
                }
            } else {
                const u16* kp = KB + (size_t)(tok0 + ql) * 1024 + h * 128 + m * 64 + 8 * hh;
#pragma unroll
                for (int s = 0; s < 4; ++s) st = __builtin_amdgcn_mfma_f32_32x32x16_bf16(*(const bf16x8*)(kp + 16 * s), qf[s], st, 0, 0, 0);
            }
            float mx = st[0];
#pragma unroll
            for (int r = 1; r < 16; ++r) mx = fmaxf(mx, st[r]);
            mx = fmaxf(mx, __shfl_xor(mx, 32));
            const float mnew = fmaxf(mrun, mx), alpha = __builtin_amdgcn_exp2f(mrun - mnew);
            mrun = mnew; lrun *= alpha;
            O *= alpha;
            float e[16];
#pragma unroll
            for (int r = 0; r < 16; ++r) { e[r] = __builtin_amdgcn_exp2f(st[r] - mnew); lrun += e[r]; }
#pragma unroll
            for (int s2 = 0; s2 < 2; ++s2) {
                u32x4 pw; pw.x = pk2(e[8 * s2], e[8 * s2 + 1]); pw.y = pk2(e[8 * s2 + 2], e[8 * s2 + 3]); pw.z = pk2(e[8 * s2 + 4], e[8 * s2 + 5]); pw.w = pk2(e[8 * s2 + 6], e[8 * s2 + 7]);
                float v[8];
                if (kt < 32) {
                    const float* vp = CV + (size_t)(kt * 32 + 16 * s2 + 4 * hh) * 128 + 32 * t + ql;
#pragma unroll
                    for (int i = 0; i < 4; ++i) { v[i] = vp[i * 128]; v[4 + i] = vp[(8 + i) * 128]; }
                } else {
                    const u16* vp = P + (size_t)(tok0 + 16 * s2 + 4 * hh) * LDP + 6144 + h * 128 + 32 * t + ql;
#pragma unroll
                    for (int i = 0; i < 4; ++i) { v[i] = bf2f(vp[(size_t)i * LDP]); v[4 + i] = bf2f(vp[(size_t)(8 + i) * LDP]); }
                }
                u32x4 w; w.x = pk2(v[0], v[1]); w.y = pk2(v[2], v[3]); w.z = pk2(v[4], v[5]); w.w = pk2(v[6], v[7]);
                O = __builtin_amdgcn_mfma_f32_32x32x16_bf16(__builtin_bit_cast(bf16x8, w), __builtin_bit_cast(bf16x8, pw), O, 0, 0, 0);
            }
        }
        float* sl = xo + t * 1152;
        if (kh == 1) {
#pragma unroll
            for (int r = 0; r < 16; ++r) sl[r * 64 + lane] = O[r];
            sl[1024 + lane] = mrun; sl[1088 + lane] = lrun;
        }
        __syncthreads();
        if (kh == 0) {
            const float mo = sl[1024 + lane], lo = sl[1088 + lane];
            const float mnew = fmaxf(mrun, mo), a = __builtin_amdgcn_exp2f(mrun - mnew), ao = __builtin_amdgcn_exp2f(mo - mnew);
            lrun = lrun * a + lo * ao;
            const float inv = 1.f / (lrun + __shfl_xor(lrun, 32));
#pragma unroll
            for (int r = 0; r < 16; ++r) O[r] = (O[r] * a + sl[r * 64 + lane] * ao) * inv;
            if (m == 0) O1 = O;
        }
        __syncthreads();
    }
    float ss = 0.f;
    if (kh == 0) {
        const float lam = lam_of(p, l, lane);
#pragma unroll
        for (int r = 0; r < 16; ++r) { const float d = O1[r] - lam * O[r]; O[r] = d; ss += d * d; }
        ss += __shfl_xor(ss, 32);
        if (hh == 0) xss[t * 32 + ql] = ss;
    }
    __syncthreads();
    if (kh == 0) {
        const float tot = xss[ql] + xss[32 + ql] + xss[64 + ql] + xss[96 + ql];
        const float sc = rsqrtf(tot * (1.f / 128.f) + EPSF) * (1.f - lam_init_of(l));
        const u16* zp = (const u16*)(p.ws + WS_P) + (size_t)tokq * LDP + 7168 + h * 128;
        u16* op = (u16*)(p.ws + WS_OBN) + (size_t)tokq * 1024 + h * 128;
        const float* dw = p.in[17] + l * 128;
#pragma unroll
        for (int g = 0; g < 4; ++g) {
            const int vc = 32 * t + 8 * g + 4 * hh;
            const uint2 z = *(const uint2*)(zp + vc); const float4 w = *(const float4*)(dw + vc);
            const float o0 = O[4 * g] * sc * w.x * siluf(bflo(z.x)), o1 = O[4 * g + 1] * sc * w.y * siluf(bfhi(z.x));
            const float o2 = O[4 * g + 2] * sc * w.z * siluf(bflo(z.y)), o3 = O[4 * g + 3] * sc * w.w * siluf(bfhi(z.y));
            *(uint2*)(op + vc) = make_uint2(pk2(o0, o1), pk2(o2, o3));
        }
    }
}

__device__ __forceinline__ void phase_cat(const Params& p, int l, unsigned char* lds, int sub) {
    const int bid = bidx(), nb = gridDim.x;
    uint4 t0, t1, t2, t3, t4, t5; float gpre, bpre;
    if (bid < NITEM) gdn_chunk_load(p, bid, t0, t1, t2, t3, t4, t5, gpre, bpre);
#if defined(REP_SUB)
    if (sub != 7) { for (int it = bid; it < NITEM; it += nb) gdn_chunk_item(p, it, it + nb < NITEM ? it + nb : -1, lds, t0, t1, t2, t3, t4, t5, gpre, bpre, REP_SUB); return; }
#endif
    for (int it = bid; it < NITEM; it += nb) gdn_chunk_item(p, it, it + nb < NITEM ? it + nb : -1, lds, t0, t1, t2, t3, t4, t5, gpre, bpre);
}
constexpr int QCTR_OFF = 12288;
__device__ __forceinline__ int queue_pop(unsigned* ctr, unsigned char* lds) {
    __syncthreads();
    if (tidx() == 0) *(volatile int*)(lds + LDS_BYTES - 16) = (int)atomicAdd(ctr, 1u);
    __syncthreads();
    return *(volatile int*)(lds + LDS_BYTES - 16);
}
__device__ __forceinline__ void phase_scan(const Params& p, int l, unsigned char* lds, int sub) {
    const int wid = __builtin_amdgcn_readfirstlane(tidx() >> 6), bid = bidx(), nb = gridDim.x;
    const int npb = nb > 32 ? 32 : nb;
    if (bid < npb) for (int it = bid; it < 32; it += npb) gdn_scan_block(p, l, it >> 4, (it >> 1) & 7, it & 1, lds);
    unsigned* ctr = (unsigned*)(p.ws + WS_GLAST + QCTR_OFF) + l;
    for (;;) {
        const int it = queue_pop(ctr, lds);
        if (it >= 128 + 1024 + 128) break;
        if (it < 128) attn_sample_item(p, l, it >> 3, it & 7, lds);
        else if (it < 128 + 1024) { const int j = it - 128, qb = 63 - (j >> 4), bh = j & 15; attn_prompt_item(p, l, bh >> 3, bh & 7, qb, lds); }
        else {
            const int wi = (it - 1152) * 8 + wid, cb = wi & 7, h = (wi >> 3) & 7, b = wi >> 6;
            const size_t so = ((size_t)(l * 16 + b) * 8 + h) * 16384;
            gdn_scan_item(p, l, 256 + b, 1, h, cb, p.in[6] + so, p.out + O_SSMS + so, 32);
        }
    }
}

#define XB_TMO      128
#define XB_XCNT(j)  (256  + 64 * (j))
#define XB_XSUB(j)  (1280 + 64 * (j))
#define XB_XGEN(j)  (2304 + 64 * (j))
#define XB_TOP      3328
#define XB_TOPGEN   3392
#define XCD_BAR_WORDS 3456
#define XB_SPIN_CAP (1u << 18)
#define LAS __attribute__((address_space(3)))

__device__ __forceinline__ unsigned xb_ld(unsigned* p)              { return __hip_atomic_load(p, __ATOMIC_RELAXED, __HIP_MEMORY_SCOPE_AGENT); }
__device__ __forceinline__ unsigned xb_add(unsigned* p, unsigned v) { return __hip_atomic_fetch_add(p, v, __ATOMIC_RELAXED, __HIP_MEMORY_SCOPE_AGENT); }
__device__ __forceinline__ unsigned xb_xcc_id() { return (unsigned)__builtin_amdgcn_s_getreg((3 << 11) | 20) & 0xFu; }
#define XB_SPIN(cond, bar) do { unsigned _sp = 0; while (cond) { __builtin_amdgcn_s_sleep(1); \
    if ((++_sp & 255u) == 0u) { if (xb_ld(&(bar)[XB_TMO])) break; if (_sp > XB_SPIN_CAP) { atomicAdd(&(bar)[XB_TMO], 1u); break; } } } } while (0)

struct XcdBarrier {
    unsigned* bar; unsigned x;
    volatile LAS unsigned* st;
};

__device__ __forceinline__ XcdBarrier xcd_barrier_post(unsigned* bar, volatile LAS unsigned* st) {
    XcdBarrier b; b.bar = bar; b.x = xb_xcc_id(); b.st = st;
    if (tidx() == 0) (void)xb_add(&bar[XB_XCNT(b.x)], 1u);
    return b;
}
__device__ __forceinline__ void xcd_barrier_complete(unsigned* bar, unsigned x, unsigned& nloc, unsigned& nx) {
    const unsigned G = gridDim.x * gridDim.y * gridDim.z;
    unsigned sum, cnt, mine, sp = 0u;
    for (;;) {
        sum = 0u; cnt = 0u; mine = 0u;
#pragma unroll
        for (unsigned j = 0; j < 16; ++j) { const unsigned c = xb_ld(&bar[XB_XCNT(j)]); sum += c; cnt += (c > 0u) ? 1u : 0u; mine = (j == x) ? c : mine; }
        if (sum == G) break;
        __builtin_amdgcn_s_sleep(1);
        if ((++sp & 255u) == 0u) { if (xb_ld(&bar[XB_TMO])) break; if (sp > XB_SPIN_CAP) { atomicAdd(&bar[XB_TMO], 1u); break; } }
    }
    nloc = mine > 0u ? mine : 1u; nx = cnt > 0u ? cnt : 1u;
}

__device__ __forceinline__ void xcd_barrier(const XcdBarrier& b) {
    asm volatile("s_waitcnt vmcnt(0)" ::: "memory");
    __syncthreads();
    if (tidx() == 0) {
        unsigned* bar = b.bar;
        __builtin_amdgcn_s_waitcnt(0);
        unsigned nloc = b.st[0], nx = b.st[1];
        if (nloc == 0u) { xcd_barrier_complete(bar, b.x, nloc, nx); b.st[0] = nloc; b.st[1] = nx; }
        const unsigned old = xb_add(&bar[XB_XSUB(b.x)], 1u);
        const unsigned gen = old / nloc;
        if (old + 1u == (gen + 1u) * nloc) {
            __builtin_amdgcn_fence(__ATOMIC_RELEASE, "agent");
            asm volatile("s_waitcnt vmcnt(0)" ::: "memory");
            const unsigned og = xb_add(&bar[XB_TOP], 1u);
            const unsigned tg = og / nx;
            if (og + 1u == (tg + 1u) * nx) xb_add(&bar[XB_TOPGEN], 1u);
            else XB_SPIN(xb_ld(&bar[XB_TOPGEN]) == tg, bar);
            __builtin_amdgcn_fence(__ATOMIC_ACQUIRE, "agent");
            xb_add(&bar[XB_XGEN(b.x)], 1u);
            asm volatile("s_waitcnt vmcnt(0)" ::: "memory");
        } else {
            XB_SPIN(xb_ld(&bar[XB_XGEN(b.x)]) == gen, bar);
            __builtin_amdgcn_fence(__ATOMIC_ACQUIRE, "agent");
            asm volatile("s_waitcnt vmcnt(0)" ::: "memory");
        }
    }
    __syncthreads();
}

__global__ void __launch_bounds__(512, 2) fwd_kernel(Params p) {
    extern __shared__ __attribute__((aligned(16))) unsigned char lds[];
    cg::grid_group grid = cg::this_grid();
    if (tidx() == 0) { *(volatile unsigned*)(lds + LDS_BYTES - 32) = 0u; *(volatile unsigned*)(lds + LDS_BYTES - 28) = 0u; }
    __syncthreads();
    XcdBarrier xb = xcd_barrier_post((unsigned*)(p.ws + WS_BAR), (volatile LAS unsigned*)(lds + LDS_BYTES - 32));
    for (int ph = p.ph_lo; ph < p.ph_hi; ++ph) {
#ifdef REP_KIND
      const int nrep = ((ph == 0 ? 0 : (ph == 33 ? 9 : 1 + ((ph - 1) & 7))) == REP_KIND) ? 2 : 1;
      for (int rep = 0; rep < nrep; ++rep) {
        if (rep) grid.sync();
#endif
#ifndef ONLY
#define ONLY -1
#endif
#define EN(k) (ONLY < 0 || ONLY == (k))
#if defined(REP_KIND) && defined(REP_SUB)
#define CATSUB (rep ? REP_SUB : 7)
#else
#define CATSUB 7
#endif
        if (ph == 0) { if (EN(0)) phase_prep(p, lds); }
        else if (ph == 33) { if (EN(9)) phase_final(p); }
        else {
            const int l = (ph - 1) >> 3, k = (ph - 1) & 7;
            const u16* WTIN = (const u16*)(p.ws + WS_WTIN) + (size_t)l * LDP * 1024;
            if (k == 0) { if (EN(1)) phase_norm(p, l); }
            else if (k == 1) { if (EN(2)) { EpiP E; E.O = (u16*)(p.ws + WS_P); run_gemm(lds, (const u16*)(p.ws + WS_H), WTIN, NTOK, LDP, E); } }
            else if (k == 2) { if (EN(3)) phase_post1(p, l, lds); }
            else if (k == 3) { if (EN(4)) phase_cat(p, l, lds, CATSUB); }
            else if (k == 4) { if (EN(5)) phase_scan(p, l, lds, CATSUB); }
            else if (k == 5) { if (EN(6)) phase_post2(p, l); }
            else if (k == 6) { if (EN(7)) {
                EpiG2<0> E0; E0.P = (const u16*)(p.ws + WS_P); E0.T1 = (float*)(p.ws + WS_T1); E0.MG = (u16*)(p.ws + WS_MERGED);
                run_gemm(lds, (const u16*)(p.ws + WS_OAN), (const u16*)(p.ws + WS_WTPA) + (size_t)l * 1048576, NTOK, 1024, E0);
                __syncthreads();
                EpiG2<1> E1; E1.P = E0.P; E1.T1 = E0.T1; E1.MG = E0.MG;
                run_gemm(lds, (const u16*)(p.ws + WS_OBN), (const u16*)(p.ws + WS_WTPB) + (size_t)l * 1048576, NTOK, 1024, E1); }
            } else if (EN(8)) {
                EpiG3 E; E.X = (float*)(p.ws + WS_X); E.MODL = (const float*)(p.ws + WS_MOD) + (size_t)l * 18 * 3072;
                run_gemm(lds, (const u16*)(p.ws + WS_MERGED), (const u16*)(p.ws + WS_WTOUT) + (size_t)l * 1048576, NTOK, 1024, E);
            }
        }
#ifdef REP_KIND
      }
#endif
        if (ph + 1 < p.ph_hi) { if (ph == p.ph_lo) grid.sync(); else xcd_barrier(xb); }
#ifdef EXTRA_SYNC
        if (ph + 1 < p.ph_hi) { xcd_barrier(xb); xcd_barrier(xb); xcd_barrier(xb); }
#endif
    }
}

#ifndef MEGA
#define MEGA 1
#endif
extern "C" void kernel_launch(void* const* d_in, const int* in_sizes, int n_in, void* d_out, int out_size, void* d_ws, size_t ws_size, hipStream_t stream) {
    static int grid = 0;
    if (grid == 0) {
        int dev = 0, cus = 0;
        hipGetDevice(&dev);
        hipDeviceGetAttribute(&cus, hipDeviceAttributeMultiprocessorCount, dev);
        if (hipFuncSetAttribute((const void*)fwd_kernel, hipFuncAttributeMaxDynamicSharedMemorySize, LDS_BYTES) != hipSuccess) fprintf(stderr, "hipFuncSetAttribute failed\n");
        int per_cu = 0;
        hipOccupancyMaxActiveBlocksPerMultiprocessor(&per_cu, (const void*)fwd_kernel, 512, LDS_BYTES);
        if (per_cu < 1) fprintf(stderr, "occupancy query says %d blocks per CU\n", per_cu);
        (void)hipGetLastError();
        grid = cus > 0 ? cus : 256;
        if (ws_size < WS_END) fprintf(stderr, "workspace too small: %zu < %zu\n", ws_size, (size_t)WS_END);
    }
    Params p{};
    for (int i = 0; i < 22; ++i) p.in[i] = (const float*)d_in[i];
    p.out = (float*)d_out; p.ws = (unsigned char*)d_ws;
#if MEGA
    p.ph_lo = 0; p.ph_hi = 34;
    if (hipMemsetAsync((unsigned char*)d_ws + WS_BAR, 0, XCD_BAR_WORDS * 4, stream) != hipSuccess) fprintf(stderr, "memset of barrier words failed\n");
    void* args[] = {&p};
    hipError_t e = hipLaunchCooperativeKernel((const void*)fwd_kernel, dim3(grid), dim3(512), args, LDS_BYTES, stream);
    if (e != hipSuccess) fprintf(stderr, "cooperative launch failed: %s (grid %d)\n", hipGetErrorString(e), grid);
#else
    for (int ph = 0; ph < 34; ++ph) {
        p.ph_lo = ph; p.ph_hi = ph + 1;
        hipLaunchKernelGGL(fwd_kernel, dim3(grid), dim3(512), LDS_BYTES, stream, p);
    }
#endif
}
```

```cpp
#include <hip/hip_runtime.h>
#include <hip/hip_cooperative_groups.h>
#include <cstdio>
namespace cg = cooperative_groups;

typedef unsigned short u16;

constexpr int DM = 1024, NPT = 16384, NTOK = 16896, SEQ = 8192, LDP = 10496;
constexpr float EPSF = 1e-6f;
constexpr float QSCALE = 0.125f * 1.44269504088896340736f;

constexpr size_t O_Y = 0, O_KP = 17301504, O_VP = 84410368, O_SSMP = 151519232, O_CONVP = 152567808,
                 O_KS = 152641536, O_VS = 154738688, O_SSMS = 156835840, O_CONVS = 165224448;

constexpr size_t SZ_TOKBF = (size_t)NTOK * 1024 * 2;
constexpr size_t WS_WTIN = 0;
constexpr size_t WS_WTPA = WS_WTIN + (size_t)4 * LDP * 1024 * 2;
constexpr size_t WS_WTPB = WS_WTPA + (size_t)4 * 1024 * 1024 * 2;
constexpr size_t WS_WTOUT = WS_WTPB + (size_t)4 * 1024 * 1024 * 2;
constexpr size_t WS_MOD = WS_WTOUT + (size_t)4 * 1024 * 1024 * 2;
constexpr size_t WS_CS = WS_MOD + (size_t)4 * 18 * 3072 * 4;
constexpr size_t WS_X = WS_CS + (size_t)8192 * 32 * 8;
constexpr size_t WS_P = WS_X + (size_t)NTOK * 1024 * 4;
constexpr size_t WS_BETA = WS_P + (size_t)NTOK * LDP * 2;
constexpr size_t WS_GLOG = WS_BETA + (size_t)NTOK * 8 * 4;
constexpr size_t WS_R1 = WS_GLOG + (size_t)NTOK * 8 * 4;
constexpr size_t WS_QA = WS_R1, WS_KA = WS_R1 + SZ_TOKBF, WS_VA = WS_R1 + 2 * SZ_TOKBF;
constexpr size_t WS_T1 = WS_R1, WS_MERGED = WS_R1 + 2 * SZ_TOKBF;
constexpr size_t WS_QB = WS_R1 + 3 * SZ_TOKBF;
constexpr size_t WS_OAN = WS_QB;
constexpr size_t WS_KB = WS_QB + SZ_TOKBF;
constexpr size_t WS_VT = WS_KB + SZ_TOKBF;
constexpr int NITEM = 2176;
constexpr size_t WS_VNT = WS_VT + (size_t)2 * 8 * 128 * 8192 * 2;
constexpr size_t WS_KCUM = WS_VNT + (size_t)NITEM * 16384;
constexpr size_t WS_QD = WS_KCUM + (size_t)NITEM * 16384;
constexpr size_t WS_KDT = WS_QD + (size_t)NITEM * 16384;
constexpr size_t WS_QKM = WS_KDT + (size_t)NITEM * 16384;
constexpr size_t WS_GLAST = WS_QKM + (size_t)NITEM * 8192;
constexpr size_t WS_ORAW = WS_GLAST + 16384;
constexpr size_t WS_H = WS_ORAW;
constexpr size_t WS_OBN = WS_ORAW + (size_t)NTOK * 1024 * 4;
constexpr size_t WS_BAR = WS_OBN + SZ_TOKBF;
constexpr size_t WS_END = WS_BAR + 16384;
static_assert(WS_END <= (size_t)1073741824, "workspace too large");
static_assert(WS_P % 256 == 0 && WS_R1 % 256 == 0 && WS_VNT % 256 == 0 && WS_ORAW % 256 == 0 && WS_OBN % 256 == 0, "align");

constexpr int LDS_BYTES = 163840;

struct Params {
    const float* in[22];
    float* out;
    unsigned char* ws;
    int ph_lo, ph_hi;
};

typedef short bf16x8 __attribute__((ext_vector_type(8)));
typedef float f32x4 __attribute__((ext_vector_type(4)));
typedef float f32x16 __attribute__((ext_vector_type(16)));

__device__ __forceinline__ float bf2f(u16 b) { return __uint_as_float(((unsigned)b) << 16); }
__device__ __forceinline__ float bflo(unsigned w) { return __uint_as_float(w << 16); }
__device__ __forceinline__ float bfhi(unsigned w) { return __uint_as_float(w & 0xffff0000u); }
__device__ __forceinline__ unsigned pk2(float lo, float hi) { unsigned r; asm("v_cvt_pk_bf16_f32 %0, %1, %2" : "=v"(r) : "v"(lo), "v"(hi)); return r; }
__device__ __forceinline__ u16 f2bf(float f) { return (u16)(pk2(f, 0.f) & 0xffffu); }
__device__ __forceinline__ float wave_sum(float v) {
#pragma unroll
    for (int o = 32; o; o >>= 1) v += __shfl_xor(v, o);
    return v;
}
__device__ __forceinline__ float siluf(float x) { return x / (1.f + __expf(-x)); }
__device__ __forceinline__ float sigmf(float x) { return 1.f / (1.f + __expf(-x)); }
__device__ __forceinline__ int seq_of(int tok) { return tok < NPT ? (tok >> 13) : 2 + ((tok - NPT) >> 5); }
__device__ __forceinline__ int pos_of(int tok) { return tok < NPT ? (tok & 8191) : 1024 + ((tok - NPT) & 31); }
__device__ __forceinline__ float lam_init_of(int l) { return 0.8f - 0.6f * __expf(-0.3f * (float)l); }

__device__ __forceinline__ int tidx() { int t = (int)__builtin_amdgcn_workitem_id_x(); asm volatile("" : "+v"(t)); return t; }
__device__ __forceinline__ int bidx() { int b = (int)__builtin_amdgcn_workgroup_id_x(); asm volatile("" : "+s"(b)); return b; }

__device__ __forceinline__ int permk(int x) { const int e = x & 31, q = e >> 2; return (x & ~31) | ((q < 4 ? 2 * q : 2 * (q - 4) + 1) << 2) | (e & 3); }

namespace pg8 {
#define PG8_LAS __attribute__((address_space(3)))
typedef unsigned short bf16_t;
typedef unsigned u32x4 __attribute__((ext_vector_type(4)));
constexpr int BM = 256, BK = 64, HALF = 128, HTB = HALF * BK * 2  , STAGE_BYTES = 8 * HTB, NXCD = 8, WGM = 4;

__host__ __device__ __forceinline__ int lds_byte(int r, int c) { const int st = (r >> 4) * 2 + (c >> 5), rr = r & 15, cc = c & 31, ob = rr * 64 + cc * 2; return st * 1024 + (ob ^ (((ob >> 9) & 1) << 5)); }
__host__ __device__ __forceinline__ void stage_rc(int b, int& R, int& C) { const int st = b / 1024, sb = b % 1024, swz = sb ^ (((sb >> 9) & 1) << 5); R = (st >> 1) * 16 + swz / 64; C = (st & 1) * 32 + (swz % 64) / 2; }
__host__ __device__ __forceinline__ int perm32(int rho) { const int n = rho >> 4, i = rho & 15; return 8 * (i >> 2) + 4 * n + (i & 3); }

struct Unit { int pm, pn; };
struct Gemm { const bf16_t* A; const bf16_t* Bt; int M, N, K; };

struct StaticOrder {
    int nM, nN, nwg, G, c;
    __host__ __device__ void init(int M, int N, int G_, int c_) { nM = M / BM; nN = N / BM; nwg = nM * nN; G = G_; c = c_; }
    __host__ __device__ bool next(int i, Unit& u) const {
        const long L = (long)i * G + c; if (L >= nwg) return false;
        int wgid = (int)L; { const int q = nwg / NXCD, r = nwg % NXCD, xcd = wgid % NXCD, off = wgid / NXCD; wgid = (xcd < r ? xcd * (q + 1) : r * (q + 1) + (xcd - r) * q) + off; }
        const int nig = WGM * nN, gid = wgid / nig, fm = gid * WGM, gsz = (nM - fm) < WGM ? (nM - fm) : WGM;
        u.pm = fm + ((wgid % nig) % gsz); u.pn = (wgid % nig) / gsz; return true;
    }
    __device__ __forceinline__ void a_ready(const Unit&) const {}
    __device__ __forceinline__ void done(const Unit&) const {}
};

template <class Epi, class Sched, bool STAMP = false>
__device__ __forceinline__ void gemm_phase(PG8_LAS unsigned char* lds, const Gemm g, const Sched& S, const Epi& E, unsigned long long* stamps) {
    const int tid = tidx(), wid = __builtin_amdgcn_readfirstlane(tid >> 6), lane = tid & 63, wr = wid >> 2, wc = wid & 3, fr = lane & 15, fq = lane >> 4;
    const int K = g.K, nt = K / BK;
    int ts_lo = 0, ts_hi = 0, nts = 0; const unsigned long long rt_entry = STAMP ? (unsigned long long)wall_clock64() : 0ull;
#define PG8_STAMP() do { if (STAMP && wid == 0 && nts < 64) { const unsigned long long _c = (unsigned long long)clock64(); \
        ts_lo = (lane == nts) ? (int)(unsigned)_c : ts_lo; ts_hi = (lane == nts) ? (int)(unsigned)(_c >> 32) : ts_hi; ++nts; } } while (0)
    PG8_STAMP();
    unsigned voffA[2], voffB[2];
#pragma unroll
    for (int i = 0; i < 2; ++i) { int R, C; stage_rc(tid * 16 + i * 8192, R, C); const int Rb = Epi::PERM ? ((R & ~31) + perm32(R & 31)) : R;
        voffA[i] = (unsigned)(R * K + C) * 2u; voffB[i] = (unsigned)(Rb * K + C) * 2u; }
    const size_t kstep = (size_t)(BK * 2);
    const size_t hstep = (size_t)HALF * K * 2;
    const size_t tstep = 2 * hstep;
    const unsigned ldsw = (unsigned)wid * 1024u;
    const int aoff = lds_byte(wr * 64 + fr, fq * 8), boff = lds_byte(wc * 32 + fr, fq * 8);
#define PG8_SA(b, h) (((b) * 2 + (h)) * HTB)
#define PG8_SB(b, h) ((4 + (b) * 2 + (h)) * HTB)
#define PG8_STAGE(bufoff, gbase, voff) do { _Pragma("unroll") for (int _i = 0; _i < 2; ++_i) \
        __builtin_amdgcn_global_load_lds((const unsigned*)((const char*)(gbase) + (voff)[_i]), (PG8_LAS unsigned*)(lds + (bufoff) + ldsw + _i * 8192), 16, 0, 0); } while (0)
#define PG8_LDA(dst, b, h) do { _Pragma("unroll") for (int m = 0; m < 4; ++m) _Pragma("unroll") for (int k = 0; k < 2; ++k) dst[m][k] = *(const PG8_LAS bf16x8*)(lds + PG8_SA(b, h) + aoff + m * 2048 + k * 1024); } while (0)
#define PG8_LDB(dst, b, h) do { _Pragma("unroll") for (int n = 0; n < 2; ++n) _Pragma("unroll") for (int k = 0; k < 2; ++k) dst[n][k] = *(const PG8_LAS bf16x8*)(lds + PG8_SB(b, h) + boff + n * 2048 + k * 1024); } while (0)
#define PG8_MMA(ai, bj, At, Bt) do { __builtin_amdgcn_s_setprio(1); _Pragma("unroll") for (int k = 0; k < 2; ++k) _Pragma("unroll") for (int m = 0; m < 4; ++m) _Pragma("unroll") for (int n = 0; n < 2; ++n) \
        acc[ai][bj][m][n] = __builtin_amdgcn_mfma_f32_16x16x32_bf16(Bt[n][k], At[m][k], acc[ai][bj][m][n], 0, 0, 0); __builtin_amdgcn_s_setprio(0); } while (0)
#define PG8_WAIT_V(n) asm volatile("s_waitcnt vmcnt(" #n ")" ::: "memory")
#define PG8_WAIT_L(n) asm volatile("s_waitcnt lgkmcnt(" #n ")" ::: "memory")
#define PG8_BAR __builtin_amdgcn_s_barrier()
#define PG8_SCHED __builtin_amdgcn_sched_barrier(0)
    Unit cur, nxt; int ui = 0;
    if (!S.next(0, cur)) return;
    f32x4 acc[2][2][4][2];
#pragma unroll
    for (int a = 0; a < 2; ++a)
#pragma unroll
        for (int b = 0; b < 2; ++b)
#pragma unroll
            for (int m = 0; m < 4; ++m)
#pragma unroll
                for (int n = 0; n < 2; ++n) acc[a][b][m][n] = (f32x4){0.f, 0.f, 0.f, 0.f};
    bf16x8 At[4][2], B0[2][2], B1[2][2];
    const char* cA = (const char*)g.A + (size_t)cur.pm * tstep; const char* cB = (const char*)g.Bt + (size_t)cur.pn * tstep;
    S.a_ready(cur);
    PG8_STAGE(PG8_SB(0, 0), cB, voffB); PG8_STAGE(PG8_SA(0, 0), cA, voffA); PG8_STAGE(PG8_SB(0, 1), cB + hstep, voffB); PG8_STAGE(PG8_SA(0, 1), cA + hstep, voffA);
    if (wr == 1) PG8_BAR;
    PG8_WAIT_V(4); PG8_BAR;
    PG8_STAGE(PG8_SB(1, 0), cB + kstep, voffB); PG8_STAGE(PG8_SA(1, 0), cA + kstep, voffA); PG8_STAGE(PG8_SB(1, 1), cB + hstep + kstep, voffB);
    PG8_WAIT_V(6); PG8_BAR;
    PG8_STAMP();
    for (;;) {
        const bool has_next = S.next(ui + 1, nxt);
        const char* nA = has_next ? (const char*)g.A + (size_t)nxt.pm * tstep : cA; const char* nB = has_next ? (const char*)g.Bt + (size_t)nxt.pn * tstep : cB;
        for (int t = 0; t < nt; t += 2) {
            const bool last = (t == nt - 2);
            const char* a1 = cA + (size_t)(t + 1) * kstep;
            const char* a2 = last ? nA : cA + (size_t)(t + 2) * kstep; const char* b2 = last ? nB : cB + (size_t)(t + 2) * kstep;
            const char* a3 = a2 + kstep; const char* b3 = b2 + kstep;
            if (last && has_next) S.a_ready(nxt);
            PG8_LDB(B0, 0, 0); PG8_SCHED; PG8_LDA(At, 0, 0); PG8_STAGE(PG8_SA(1, 1), a1 + hstep, voffA);
            PG8_WAIT_L(8); PG8_BAR; PG8_WAIT_L(0); PG8_MMA(0, 0, At, B0); PG8_BAR; PG8_SCHED;
            PG8_LDB(B1, 0, 1); PG8_STAGE(PG8_SB(0, 0), b2, voffB);
            PG8_BAR; PG8_WAIT_L(0); PG8_MMA(0, 1, At, B1); PG8_BAR;
            PG8_LDA(At, 0, 1); PG8_STAGE(PG8_SA(0, 0), a2, voffA);
            PG8_BAR; PG8_WAIT_L(0); PG8_MMA(1, 0, At, B0); PG8_BAR; PG8_SCHED;
            PG8_STAGE(PG8_SB(0, 1), b2 + hstep, voffB);
            PG8_WAIT_V(6); PG8_BAR; PG8_MMA(1, 1, At, B1); PG8_BAR;
            PG8_LDB(B0, 1, 0); PG8_SCHED; PG8_LDA(At, 1, 0); PG8_STAGE(PG8_SA(0, 1), a2 + hstep, voffA);
            PG8_WAIT_L(8); PG8_BAR; PG8_WAIT_L(0); PG8_MMA(0, 0, At, B0); PG8_BAR; PG8_SCHED;
            PG8_LDB(B1, 1, 1); PG8_STAGE(PG8_SB(1, 0), b3, voffB);
            PG8_BAR; PG8_WAIT_L(0); PG8_MMA(0, 1, At, B1); PG8_BAR;
            PG8_LDA(At, 1, 1); PG8_STAGE(PG8_SA(1, 0), a3, voffA);
            PG8_BAR; PG8_WAIT_L(0); PG8_MMA(1, 0, At, B0); PG8_BAR; PG8_SCHED;
            PG8_STAGE(PG8_SB(1, 1), b3 + hstep, voffB);
            PG8_WAIT_V(6); PG8_BAR; PG8_MMA(1, 1, At, B1); PG8_BAR;
        }
        PG8_STAMP();
        if constexpr (!Epi::AFTER_DRAIN) { E(acc, cur, wr, wc, fr, fq); S.done(cur); }
        PG8_STAMP();
        if (!has_next) break;
#pragma unroll
        for (int a = 0; a < 2; ++a)
#pragma unroll
            for (int b = 0; b < 2; ++b)
#pragma unroll
                for (int m = 0; m < 4; ++m)
#pragma unroll
                    for (int n = 0; n < 2; ++n) acc[a][b][m][n] = (f32x4){0.f, 0.f, 0.f, 0.f};
        cur = nxt; cA = nA; cB = nB; ++ui;
    }
    PG8_WAIT_V(0);
    if (wr == 0) PG8_BAR;
    PG8_BAR;
    if constexpr (Epi::AFTER_DRAIN) { E.fused(acc, cur, wr, wc, fr, fq, lds, wid, lane); S.done(cur); }
    PG8_STAMP();
    if (STAMP && wid == 0) { stamps[lane] = lane < nts ? (((unsigned long long)(unsigned)ts_hi << 32) | (unsigned)ts_lo) : 0ull;
        if (lane == 62) stamps[62] = rt_entry; if (lane == 63) stamps[63] = (unsigned long long)wall_clock64(); }
#undef PG8_STAMP
#undef PG8_SA
#undef PG8_SB
#undef PG8_STAGE
#undef PG8_LDA
#undef PG8_LDB
#undef PG8_MMA
#undef PG8_WAIT_V
#undef PG8_WAIT_L
#undef PG8_BAR
#undef PG8_SCHED
}
}

struct EpiP {
    static constexpr bool PERM = true, AFTER_DRAIN = false;
    u16* O;
    __device__ __forceinline__ void operator()(const f32x4 (&acc)[2][2][4][2], const pg8::Unit& u, int wr, int wc, int fr, int fq) const {
        const int row0 = u.pm * 256 + wr * 64 + fr, col0 = u.pn * 256 + wc * 32 + 8 * fq;
#pragma unroll
        for (int ai = 0; ai < 2; ++ai)
#pragma unroll
            for (int m = 0; m < 4; ++m) { u16* rowp = O + (size_t)(row0 + ai * 128 + m * 16) * LDP + col0;
#pragma unroll
                for (int bj = 0; bj < 2; ++bj) { const f32x4 v0 = acc[ai][bj][m][0], v1 = acc[ai][bj][m][1];
                    uint4 w; w.x = pk2(v0[0], v0[1]); w.y = pk2(v0[2], v0[3]); w.z = pk2(v1[0], v1[1]); w.w = pk2(v1[2], v1[3]);
                    *(uint4*)(rowp + bj * 128) = w; } }
    }
};
template <int MODE> struct EpiG2 {
    static constexpr bool PERM = true, AFTER_DRAIN = false;
    const u16* P; float* T1; u16* MG;
    __device__ __forceinline__ void operator()(const f32x4 (&acc)[2][2][4][2], const pg8::Unit& u, int wr, int wc, int fr, int fq) const {
        const int row0 = u.pm * 256 + wr * 64 + fr, col0 = u.pn * 256 + wc * 32 + 8 * fq;
#pragma unroll
        for (int aq = 0; aq < 4; ++aq) {
            const int ai = aq >> 1, m0 = (aq & 1) * 2;
            uint4 g[4]; float4 ta[4], tb[4];
#pragma unroll
            for (int m = m0; m < m0 + 2; ++m)
#pragma unroll
                for (int bj = 0; bj < 2; ++bj) {
                    const size_t row = (size_t)(row0 + ai * 128 + m * 16); const int col = col0 + bj * 128;
                    g[(m - m0) * 2 + bj] = *(const uint4*)(P + row * LDP + (MODE == 0 ? 8192 : 9216) + col);
                    if (MODE == 1) { const float* tp = T1 + row * 1024 + col; ta[(m - m0) * 2 + bj] = *(const float4*)tp; tb[(m - m0) * 2 + bj] = *(const float4*)(tp + 4); }
                }
            __builtin_amdgcn_sched_barrier(0);
#pragma unroll
            for (int m = m0; m < m0 + 2; ++m)
#pragma unroll
                for (int bj = 0; bj < 2; ++bj) {
                    const size_t row = (size_t)(row0 + ai * 128 + m * 16); const int col = col0 + bj * 128;
                    const uint4 gg = g[(m - m0) * 2 + bj];
                    const f32x4 v0 = acc[ai][bj][m][0], v1 = acc[ai][bj][m][1];
                    const float r0 = sigmf(bflo(gg.x)) * v0[0], r1 = sigmf(bfhi(gg.x)) * v0[1], r2 = sigmf(bflo(gg.y)) * v0[2], r3 = sigmf(bfhi(gg.y)) * v0[3];
                    const float r4 = sigmf(bflo(gg.z)) * v1[0], r5 = sigmf(bfhi(gg.z)) * v1[1], r6 = sigmf(bflo(gg.w)) * v1[2], r7 = sigmf(bfhi(gg.w)) * v1[3];
                    if (MODE == 0) { float* tp = T1 + row * 1024 + col; *(float4*)tp = make_float4(r0, r1, r2, r3); *(float4*)(tp + 4) = make_float4(r4, r5, r6, r7); }
                    else { const float4 x = ta[(m - m0) * 2 + bj], y = tb[(m - m0) * 2 + bj];
                        uint4 w; w.x = pk2(x.x + r0, x.y + r1); w.y = pk2(x.z + r2, x.w + r3); w.z = pk2(y.x + r4, y.y + r5); w.w = pk2(y.z + r6, y.w + r7);
                        *(uint4*)(MG + row * 1024 + col) = w; }
                }
        }
    }
};
struct EpiG3 {
    static constexpr bool PERM = false, AFTER_DRAIN = false;
    float* X; const float* MODL;
    __device__ __forceinline__ void operator()(const f32x4 (&acc)[2][2][4][2], const pg8::Unit& u, int wr, int wc, int fr, int fq) const {
        const int row0 = u.pm * 256 + wr * 64 + fr, col0 = u.pn * 256 + wc * 32 + 4 * fq;
#pragma unroll
        for (int ai = 0; ai < 2; ++ai)
#pragma unroll
            for (int m = 0; m < 4; ++m) { const int row = row0 + ai * 128 + m * 16; const float* gp = MODL + seq_of(row) * 3072 + 2048;
#pragma unroll
                for (int bj = 0; bj < 2; ++bj)
#pragma unroll
                    for (int n = 0; n < 2; ++n) { const int col = col0 + bj * 128 + n * 16;
                        const float4 g = *(const float4*)(gp + col); float4* xp = (float4*)(X + (size_t)row * 1024 + col); float4 x = *xp; const f32x4 a = acc[ai][bj][m][n];
                        x.x += g.x * a[0]; x.y += g.y * a[1]; x.z += g.z * a[2]; x.w += g.w * a[3]; *xp = x; } }
    }
};

template <class Epi> __device__ __forceinline__ void run_gemm(unsigned char* lds, const u16* A, const u16* Bt, int M, int N, const Epi& E) {
    pg8::Gemm g; g.A = A; g.Bt = Bt; g.M = M; g.N = N; g.K = 1024;
    pg8::StaticOrder S; S.init(M, N, (int)gridDim.x, (int)bidx());
    pg8::gemm_phase<Epi, pg8::StaticOrder, false>((PG8_LAS unsigned char*)lds, g, S, E, nullptr);
}

__device__ __forceinline__ void phase_prep(const Params& p, unsigned char* lds) {
    float* ldsf = (float*)lds;
    const int tid = tidx(), nb = gridDim.x, bid = bidx(), wid = tid >> 6, lane = tid & 63;
    if (bid == 0 && tid < 4) ((unsigned*)(p.ws + WS_GLAST + 12288))[tid] = 0u;
    {
        const float4* xp = (const float4*)p.in[0]; const float4* xs = (const float4*)p.in[1];
        float4* X = (float4*)(p.ws + WS_X);
        const size_t n4p = (size_t)NPT * 256, n4 = (size_t)NTOK * 256;
        for (size_t i = (size_t)bid * 512 + tid; i < n4; i += (size_t)nb * 512) X[i] = i < n4p ? xp[i] : xs[i - n4p];
        float2* CS = (float2*)(p.ws + WS_CS);
        for (int i = bid * 512 + tid; i < 8192 * 32; i += nb * 512) {
            const int pos = i >> 5, d = i & 31;
            const float inv = powf(10000.0f, -(float)d / 32.0f);
            const float ang = (float)pos * inv;
            const float kf = rintf(ang * 0.636619772367581343f);
            float r = fmaf(-kf, 1.5707962512969971f, ang); r = fmaf(-kf, 7.5497894158615964e-08f, r); r = fmaf(-kf, 5.3903029534742384e-15f, r);
            const float sr = sinf(r), cr = cosf(r);
            const int q = ((int)kf) & 3;
            float s, c;
            if (q == 0) { s = sr; c = cr; } else if (q == 1) { s = cr; c = -sr; } else if (q == 2) { s = -sr; c = -cr; } else { s = -cr; c = sr; }
            CS[i] = make_float2(c, s);
        }
    }
    {
        const int NT_IN = LDP / 64, per_layer = (NT_IN + 48) * 16;
        for (int it = bid; it < 4 * per_layer; it += nb) {
            const int l = it / per_layer, r = it % per_layer, kt = r & 15; int ntile = r >> 4;
            const float* src; u16* dst; int ldn; bool is_in;
            if (ntile < NT_IN) { is_in = true; src = p.in[11] + (size_t)l * 1024 * 10256; ldn = 10256; dst = (u16*)(p.ws + WS_WTIN) + (size_t)l * LDP * 1024; }
            else { const int q = (ntile - NT_IN) >> 4; ntile = (ntile - NT_IN) & 15; is_in = false; src = p.in[18 + q] + (size_t)l * 1024 * 1024; ldn = 1024;
                   dst = (u16*)(p.ws + (q == 0 ? WS_WTPA : (q == 1 ? WS_WTPB : WS_WTOUT))) + (size_t)l * 1024 * 1024; }
            const int n0 = ntile * 64, k0 = kt * 64;
            __syncthreads();
#pragma unroll
            for (int i = 0; i < 2; ++i) {
                const int kk = (tid >> 4) + 32 * i, nn = (tid & 15) * 4, np = n0 + nn; int sc = np;
                if (is_in) sc = np < 4096 ? np : (np < 10240 ? np + 16 : (np < 10256 ? np - 10240 + 4096 : -1));
                float4 v = make_float4(0.f, 0.f, 0.f, 0.f);
                if (sc >= 0) v = *(const float4*)(src + (size_t)(k0 + kk) * ldn + sc);
                ldsf[kk * 65 + nn] = v.x; ldsf[kk * 65 + nn + 1] = v.y; ldsf[kk * 65 + nn + 2] = v.z; ldsf[kk * 65 + nn + 3] = v.w;
            }
            __syncthreads();
#pragma unroll
            for (int i = 0; i < 4; ++i) {
                const int nn = (tid >> 5) + 16 * i, kk = 2 * (tid & 31);
                *(unsigned*)(dst + (size_t)(n0 + nn) * 1024 + k0 + kk) = pk2(ldsf[kk * 65 + nn], ldsf[(kk + 1) * 65 + nn]);
            }
        }
    }
    {
        __syncthreads();
        for (int i = tid; i < 18 * 1024; i += 512) ldsf[i] = i < 2048 ? p.in[2][i] : p.in[3][i - 2048];
        float* part = ldsf + 18432;
        float* MOD = (float*)(p.ws + WS_MOD);
        __syncthreads();
        for (int it = bid; it < 4 * 48; it += nb) {
            const int l = it / 48, j0 = (it % 48) * 64;
            const float* W = p.in[9] + (size_t)l * 1024 * 3072 + j0 + lane;
            float acc[18];
#pragma unroll
            for (int s = 0; s < 18; ++s) acc[s] = 0.f;
            for (int k = wid * 128; k < wid * 128 + 128; ++k) {
                const float w = W[(size_t)k * 3072];
#pragma unroll
                for (int s = 0; s < 18; ++s) acc[s] = fmaf(ldsf[s * 1024 + k], w, acc[s]);
            }
#pragma unroll
            for (int s = 0; s < 18; ++s) part[(wid * 18 + s) * 64 + lane] = acc[s];
            __syncthreads();
            for (int o = tid; o < 1152; o += 512) {
                const int s = o >> 6, j = o & 63; float v = p.in[10][l * 3072 + j0 + j];
#pragma unroll
                for (int w = 0; w < 8; ++w) v += part[(w * 18 + s) * 64 + j];
                MOD[(size_t)(l * 18 + s) * 3072 + j0 + j] = v;
            }
            __syncthreads();
        }
    }
}

__device__ __forceinline__ void phase_norm(const Params& p, int l) {
    const int wid = tidx() >> 6, lane = tidx() & 63;
    const float* X = (const float*)(p.ws + WS_X);
    const float* nw = p.in[8] + l * 1024;
    const float* MODL = (const float*)(p.ws + WS_MOD) + (size_t)l * 18 * 3072;
    u16* H = (u16*)(p.ws + WS_H);
    for (int tok = bidx() * 8 + wid; tok < NTOK; tok += gridDim.x * 8) {
        const float4* xr = (const float4*)(X + (size_t)tok * 1024);
        float4 v[4]; float ss = 0.f;
#pragma unroll
        for (int i = 0; i < 4; ++i) { v[i] = xr[lane + 64 * i]; ss += v[i].x * v[i].x + v[i].y * v[i].y + v[i].z * v[i].z + v[i].w * v[i].w; }
        ss = wave_sum(ss);
        const float rstd = rsqrtf(ss * (1.f / 1024.f) + EPSF);
        const float* ms = MODL + seq_of(tok) * 3072;
#pragma unroll
        for (int i = 0; i < 4; ++i) {
            const int c = (lane + 64 * i) * 4;
            const float4 w = *(const float4*)(nw + c), sh = *(const float4*)(ms + c), sc = *(const float4*)(ms + 1024 + c);
            const float h0 = v[i].x * rstd * w.x * (1.f + sc.x) + sh.x, h1 = v[i].y * rstd * w.y * (1.f + sc.y) + sh.y;
            const float h2 = v[i].z * rstd * w.z * (1.f + sc.z) + sh.z, h3 = v[i].w * rstd * w.w * (1.f + sc.w) + sh.w;
            *(uint2*)(H + (size_t)tok * 1024 + c) = make_uint2(pk2(h0, h1), pk2(h2, h3));
        }
    }
}

__device__ __forceinline__ void phase_post1(const Params& p, int l, unsigned char* lds) {
    const int tid = tidx(), wid = tid >> 6, lane = tid & 63, nb = gridDim.x, bid = bidx();
    const u16* P = (const u16*)(p.ws + WS_P);
    const int gw = bid * 8 + wid, nw = nb * 8;
    {
        const float* cw = p.in[12] + (size_t)l * 4 * 3072;
        for (int it = gw; it < 2112 * 6; it += nw) {
            const int tg = it / 6, sg = it % 6;
            const int tok0 = tg * 8, slot = sg * 4 + (lane >> 4), ch = slot * 128 + (lane & 15) * 8;
            const int t0 = tok0 < NPT ? (tok0 & 8191) : ((tok0 - NPT) & 31);
            float w[4][8], a[3][8];
#pragma unroll
            for (int j = 0; j < 4; ++j) { const float4 x = *(const float4*)(cw + j * 3072 + ch), y = *(const float4*)(cw + j * 3072 + ch + 4);
                w[j][0] = x.x; w[j][1] = x.y; w[j][2] = x.z; w[j][3] = x.w; w[j][4] = y.x; w[j][5] = y.y; w[j][6] = y.z; w[j][7] = y.w; }
            if (t0 == 0) {
                if (tok0 < NPT) {
#pragma unroll
                    for (int j = 0; j < 3; ++j)
#pragma unroll
                        for (int e = 0; e < 8; ++e) a[j][e] = 0.f;
                } else { const float* sc = p.in[7] + ((size_t)(l * 16 + ((tok0 - NPT) >> 5)) * 3) * 3072 + ch;
#pragma unroll
                    for (int j = 0; j < 3; ++j) { const float4 x = *(const float4*)(sc + j * 3072), y = *(const float4*)(sc + j * 3072 + 4);
                        a[j][0] = x.x; a[j][1] = x.y; a[j][2] = x.z; a[j][3] = x.w; a[j][4] = y.x; a[j][5] = y.y; a[j][6] = y.z; a[j][7] = y.w; } }
            } else {
#pragma unroll
                for (int j = 0; j < 3; ++j) { const uint4 u = *(const uint4*)(P + (size_t)(tok0 - 3 + j) * LDP + ch);
                    a[j][0] = bflo(u.x); a[j][1] = bfhi(u.x); a[j][2] = bflo(u.y); a[j][3] = bfhi(u.y); a[j][4] = bflo(u.z); a[j][5] = bfhi(u.z); a[j][6] = bflo(u.w); a[j][7] = bfhi(u.w); }
            }
            uint4 u[8];
#pragma unroll
            for (int i = 0; i < 8; ++i) u[i] = *(const uint4*)(P + (size_t)(tok0 + i) * LDP + ch);
            float y[8][8], ss[8];
#pragma unroll
            for (int i = 0; i < 8; ++i) {
                const float c[8] = {bflo(u[i].x), bfhi(u[i].x), bflo(u[i].y), bfhi(u[i].y), bflo(u[i].z), bfhi(u[i].z), bflo(u[i].w), bfhi(u[i].w)};
                float acc = 0.f;
#pragma unroll
                for (int e = 0; e < 8; ++e) {
                    const float v = siluf(w[0][e] * a[0][e] + w[1][e] * a[1][e] + w[2][e] * a[2][e] + w[3][e] * c[e]);
                    a[0][e] = a[1][e]; a[1][e] = a[2][e]; a[2][e] = c[e];
                    y[i][e] = v; acc += v * v;
                }
                ss[i] = acc;
            }
            if (sg < 4) {
#pragma unroll
                for (int o = 8; o; o >>= 1)
#pragma unroll
                    for (int i = 0; i < 8; ++i) ss[i] += __shfl_xor(ss[i], o);
                const float post = sg < 2 ? 0.08838834764831845f : 1.f;
#pragma unroll
                for (int i = 0; i < 8; ++i) { const float sc = rsqrtf(ss[i] + EPSF) * post;
#pragma unroll
                    for (int e = 0; e < 8; ++e) y[i][e] *= sc; }
            }
            u16* dst = (u16*)(p.ws + (sg < 2 ? WS_QA : (sg < 4 ? WS_KA : WS_VA))) + (slot & 7) * 128 + (lane & 15) * 8;
#pragma unroll
            for (int i = 0; i < 8; ++i)
                *(uint4*)(dst + (size_t)(tok0 + i) * 1024) = make_uint4(pk2(y[i][0], y[i][1]), pk2(y[i][2], y[i][3]), pk2(y[i][4], y[i][5]), pk2(y[i][6], y[i][7]));
        }
    }
    for (int idx = bid * 512 + tid; idx < 18 * 9216; idx += nb * 512) {
        const int s = idx / 9216, r = idx % 9216, j = r / 3072, c = r % 3072;
        const int tok = s < 2 ? s * 8192 + 8189 + j : NPT + (s - 2) * 32 + 29 + j;
        const float v = bf2f(P[(size_t)tok * LDP + c]);
        if (s < 2) p.out[O_CONVP + ((size_t)(l * 2 + s) * 3 + j) * 3072 + c] = v;
        else p.out[O_CONVS + ((size_t)(l * 16 + s - 2) * 3 + j) * 3072 + c] = v;
    }
    {
        float* BETA = (float*)(p.ws + WS_BETA); float* GLOG = (float*)(p.ws + WS_GLOG);
        for (int idx = bid * 512 + tid; idx < NTOK * 8; idx += nb * 512) {
            const int tok = idx >> 3, h = idx & 7;
            const float ba = bf2f(P[(size_t)tok * LDP + 10240 + h]), aa = bf2f(P[(size_t)tok * LDP + 10248 + h]);
            BETA[idx] = sigmf(ba);
            const float x = aa + p.in[14][l * 8 + h];
            const float sp = fmaxf(x, 0.f) + log1pf(__expf(-fabsf(x)));
            GLOG[idx] = -__expf(p.in[13][l * 8 + h]) * sp;
        }
    }
    {
        const float4* CS4 = (const float4*)(p.ws + WS_CS);
        u16* QB = (u16*)(p.ws + WS_QB); u16* KB = (u16*)(p.ws + WS_KB);
        const int hs = lane >> 4, mq = (lane >> 3) & 1, d4 = (lane & 7) * 4, vc = (lane & 15) * 8;
        for (int it = gw; it < NTOK * 2; it += nw) {
            const int tok = it >> 1, h = (it & 1) * 4 + hs;
            const float4 csa = CS4[(pos_of(tok) * 32 + d4) >> 1], csb = CS4[((pos_of(tok) * 32 + d4) >> 1) + 1];
            const float cc[4] = {csa.x, csa.z, csb.x, csb.z}, sn[4] = {csa.y, csa.w, csb.y, csb.w};
            const u16* pr = P + (size_t)tok * LDP;
            const int cb = h * 128 + mq * 64 + d4;
            const uint2 q1 = *(const uint2*)(pr + 4096 + cb), q2 = *(const uint2*)(pr + 4096 + cb + 32);
            const uint2 k1 = *(const uint2*)(pr + 5120 + cb), k2 = *(const uint2*)(pr + 5120 + cb + 32);
            const uint4 vv = *(const uint4*)(pr + 6144 + h * 128 + vc);
            const float q1f[4] = {bflo(q1.x), bfhi(q1.x), bflo(q1.y), bfhi(q1.y)}, q2f[4] = {bflo(q2.x), bfhi(q2.x), bflo(q2.y), bfhi(q2.y)};
            const float k1f[4] = {bflo(k1.x), bfhi(k1.x), bflo(k1.y), bfhi(k1.y)}, k2f[4] = {bflo(k2.x), bfhi(k2.x), bflo(k2.y), bfhi(k2.y)};
            float qa[4], qb[4], ka[4], kb[4];
#pragma unroll
            for (int e = 0; e < 4; ++e) {
                qa[e] = (q1f[e] * cc[e] - q2f[e] * sn[e]) * QSCALE; qb[e] = (q1f[e] * sn[e] + q2f[e] * cc[e]) * QSCALE;
                ka[e] = k1f[e] * cc[e] - k2f[e] * sn[e]; kb[e] = k1f[e] * sn[e] + k2f[e] * cc[e];
            }
            *(uint2*)(QB + (size_t)tok * 1024 + cb) = make_uint2(pk2(qa[0], qa[1]), pk2(qa[2], qa[3]));
            *(uint2*)(QB + (size_t)tok * 1024 + cb + 32) = make_uint2(pk2(qb[0], qb[1]), pk2(qb[2], qb[3]));
            *(uint2*)(KB + (size_t)tok * 1024 + cb) = make_uint2(pk2(ka[0], ka[1]), pk2(ka[2], ka[3]));
            *(uint2*)(KB + (size_t)tok * 1024 + cb + 32) = make_uint2(pk2(kb[0], kb[1]), pk2(kb[2], kb[3]));
            size_t orow; float* ko; float* vo;
            if (tok < NPT) { orow = ((size_t)(l * 2 + (tok >> 13)) * 8 + h) * 8192 + (tok & 8191); ko = p.out + O_KP; vo = p.out + O_VP; }
            else { const int r = tok - NPT; orow = ((size_t)(l * 16 + (r >> 5)) * 8 + h) * 32 + (r & 31); ko = p.out + O_KS; vo = p.out + O_VS; }
            *(float4*)(ko + orow * 128 + mq * 64 + d4) = make_float4(ka[0], ka[1], ka[2], ka[3]);
            *(float4*)(ko + orow * 128 + mq * 64 + d4 + 32) = make_float4(kb[0], kb[1], kb[2], kb[3]);
            *(float4*)(vo + orow * 128 + vc) = make_float4(bflo(vv.x), bfhi(vv.x), bflo(vv.y), bfhi(vv.y));
            *(float4*)(vo + orow * 128 + vc + 4) = make_float4(bflo(vv.z), bfhi(vv.z), bflo(vv.w), bfhi(vv.w));
        }
    }
    {
        u16* T = (u16*)lds;
        u16* VT = (u16*)(p.ws + WS_VT);
        uint4 pre0 = make_uint4(0, 0, 0, 0), pre1 = pre0;
#define VT_LOAD(it_) do { const int tt_ = (it_) & 127, h_ = ((it_) >> 7) & 7, b_ = (it_) >> 10; \
        pre0 = *(const uint4*)(P + (size_t)(b_ * 8192 + tt_ * 64 + (tid >> 4)) * LDP + 6144 + h_ * 128 + (tid & 15) * 8); \
        pre1 = *(const uint4*)(P + (size_t)(b_ * 8192 + tt_ * 64 + 32 + (tid >> 4)) * LDP + 6144 + h_ * 128 + (tid & 15) * 8); } while (0)
        if (bid < 2048) VT_LOAD(bid);
        for (int it = bid; it < 2048; it += nb) {
            const int tt = it & 127, h = (it >> 7) & 7, b = it >> 10;
            __syncthreads();
            *(uint4*)(T + (tid >> 4) * 136 + (tid & 15) * 8) = pre0; *(uint4*)(T + (32 + (tid >> 4)) * 136 + (tid & 15) * 8) = pre1;
            __syncthreads();
            if (it + nb < 2048) VT_LOAD(it + nb);
            const int c = tid & 127, tq = tid >> 7;
            unsigned w[8];
#pragma unroll
            for (int i = 0; i < 8; ++i) w[i] = (unsigned)T[(tq * 16 + 2 * i) * 136 + c] | ((unsigned)T[(tq * 16 + 2 * i + 1) * 136 + c] << 16);
            u16* o = VT + ((size_t)((b * 8 + h) * 128 + c)) * 8192 + tt * 64 + tq * 16;
            *(uint4*)o = make_uint4(w[0], w[1], w[4], w[5]); *(uint4*)(o + 8) = make_uint4(w[2], w[3], w[6], w[7]);
        }
#undef VT_LOAD
    }
}

__device__ __forceinline__ void gdn_chunk_load(const Params& p, int item, uint4& t0, uint4& t1, uint4& t2, uint4& t3, uint4& t4, uint4& t5, float& g, float& bt) {
    const int tid = tidx(), lane = tid & 63;
    const int ch = item >> 3, h = item & 7;
    const int tok0 = ch < 256 ? ch * 64 : NPT + (ch - 256) * 32, L = ch < 256 ? 64 : 32;
    const int row = (tid >> 4) & 31, seg = tid & 15;
    const uint4 z = make_uint4(0, 0, 0, 0);
    const size_t o0 = (size_t)(tok0 + row) * 1024 + h * 128 + seg * 8, o1 = o0 + (size_t)32 * 1024;
    const bool v1 = (row + 32) < L;
    t0 = *(const uint4*)((const u16*)(p.ws + WS_KA) + o0); t2 = *(const uint4*)((const u16*)(p.ws + WS_QA) + o0); t4 = *(const uint4*)((const u16*)(p.ws + WS_VA) + o0);
    t1 = z; t3 = z; t5 = z;
    if (v1) { t1 = *(const uint4*)((const u16*)(p.ws + WS_KA) + o1); t3 = *(const uint4*)((const u16*)(p.ws + WS_QA) + o1); t5 = *(const uint4*)((const u16*)(p.ws + WS_VA) + o1); }
    g = 0.f; bt = 0.f;
    if (tid < 64 && lane < L) { g = ((const float*)(p.ws + WS_GLOG))[(size_t)(tok0 + lane) * 8 + h]; bt = ((const float*)(p.ws + WS_BETA))[(size_t)(tok0 + lane) * 8 + h]; }
}
__device__ __forceinline__ void gdn_chunk_item(const Params& p, int item, int next_item, unsigned char* lds,
                                               uint4& t0, uint4& t1, uint4& t2, uint4& t3, uint4& t4, uint4& t5, float& gpre, float& bpre, const int skip = 0) {
    const int tid = tidx(), wid = tid >> 6, lane = tid & 63, fr = lane & 15, fq = lane >> 4;
    u16* kT = (u16*)lds; u16* qT = kT + 64 * 136; u16* vT = qT + 64 * 136;
    float* AT = (float*)(lds + 52224); float* Gs = (float*)(lds + 69632); float* Bs = Gs + 64;
    __syncthreads();
    {
        const int row = (tid >> 4) & 31, seg = tid & 15;
        *(uint4*)(kT + row * 136 + seg * 8) = t0; *(uint4*)(kT + (row + 32) * 136 + seg * 8) = t1;
        *(uint4*)(qT + row * 136 + seg * 8) = t2; *(uint4*)(qT + (row + 32) * 136 + seg * 8) = t3;
        *(uint4*)(vT + row * 136 + seg * 8) = t4; *(uint4*)(vT + (row + 32) * 136 + seg * 8) = t5;
    }
    if (wid == 0) {
        float g = gpre;
#pragma unroll
        for (int o = 1; o < 64; o <<= 1) { const float t = __shfl_up(g, o); if (lane >= o) g += t; }
        Gs[lane] = g;
        Bs[lane] = bpre;
    }
    __syncthreads();
    if (next_item >= 0) gdn_chunk_load(p, next_item, t0, t1, t2, t3, t4, t5, gpre, bpre);
    u16* QKM = (u16*)(p.ws + WS_QKM) + (size_t)item * 4096;
    if (!(skip & 2))
#pragma unroll
    for (int u = 0; u < 4; ++u) {
        const int id = wid * 4 + u, which = id >> 4, ti = (id >> 2) & 3, tj = id & 3;
        f32x4 acc = {0.f, 0.f, 0.f, 0.f};
        const u16* Ab = (which ? qT : kT) + (ti * 16 + fr) * 136 + fq * 8;
        const u16* Bb = kT + (tj * 16 + fr) * 136 + fq * 8;
#pragma unroll
        for (int ks = 0; ks < 4; ++ks) acc = __builtin_amdgcn_mfma_f32_16x16x32_bf16(*(const bf16x8*)(Ab + ks * 32), *(const bf16x8*)(Bb + ks * 32), acc, 0, 0, 0);
        const int j = tj * 16 + fr; const float Gj = Gs[j];
#pragma unroll
        for (int r = 0; r < 4; ++r) {
            const int i = ti * 16 + 4 * fq + r; const float Gi = Gs[i];
            if (which == 0) AT[j * 68 + i] = (i > j) ? Bs[i] * acc[r] * __expf(Gi - Gj) : 0.f;
            else QKM[i * 64 + permk(j)] = f2bf((i >= j) ? acc[r] * __expf(Gi - Gj) : 0.f);
        }
    }
    __syncthreads();
    if (tid < 256) { if (!(skip & 1)) {
        const int c = tid;
        int zoff; asm volatile("v_mov_b32 %0, 0" : "=v"(zoff));
        const float* ATz = AT + zoff;
        float* xs = (float*)(lds + 70144) + c;
        const u16* src = c < 128 ? (vT + c) : (kT + c - 128);
        for (int bk = 0; bk < 4; ++bk) {
            float w[16];
#pragma unroll
            for (int ii = 0; ii < 16; ++ii) { const int i = 16 * bk + ii; const float sc = c < 128 ? Bs[i] : Bs[i] * __expf(Gs[i]); w[ii] = sc * bf2f(src[i * 136]); }
#pragma unroll 4
            for (int j = 0; j < 16 * bk; ++j) {
                const float xj = xs[j * 256];
                const float4* ar = (const float4*)(ATz + j * 68 + 16 * bk);
#pragma unroll
                for (int q = 0; q < 4; ++q) { const float4 a4 = ar[q];
                    w[4 * q] = fmaf(-a4.x, xj, w[4 * q]); w[4 * q + 1] = fmaf(-a4.y, xj, w[4 * q + 1]); w[4 * q + 2] = fmaf(-a4.z, xj, w[4 * q + 2]); w[4 * q + 3] = fmaf(-a4.w, xj, w[4 * q + 3]); }
            }
            const float* ad = ATz + (16 * bk) * 69;
            float dg[15][16];
#pragma unroll
            for (int jj = 0; jj < 15; ++jj)
#pragma unroll
                for (int q = (jj + 1) >> 2; q < 4; ++q) { const float4 a4 = *(const float4*)(ad + jj * 68 + 4 * q);
                    dg[jj][4 * q] = a4.x; dg[jj][4 * q + 1] = a4.y; dg[jj][4 * q + 2] = a4.z; dg[jj][4 * q + 3] = a4.w; }
#pragma unroll
            for (int jj = 0; jj < 15; ++jj) {
                const float xj = w[jj];
#pragma unroll
                for (int ii = jj + 1; ii < 16; ++ii) w[ii] = fmaf(-dg[jj][ii], xj, w[ii]);
            }
            if (bk < 3) {
#pragma unroll
                for (int ii = 0; ii < 16; ++ii) xs[(16 * bk + ii) * 256] = w[ii];
            }
            if (c < 128) {
                u16* o = (u16*)(p.ws + WS_VNT) + (size_t)item * 8192 + c * 64 + 16 * bk;
                *(uint4*)o = make_uint4(pk2(w[0], w[1]), pk2(w[2], w[3]), pk2(w[4], w[5]), pk2(w[6], w[7]));
                *(uint4*)(o + 8) = make_uint4(pk2(w[8], w[9]), pk2(w[10], w[11]), pk2(w[12], w[13]), pk2(w[14], w[15]));
            } else {
                u16* o = (u16*)(p.ws + WS_KCUM) + (size_t)item * 8192 + permk(c - 128) + (16 * bk) * 128;
#pragma unroll
                for (int ii = 0; ii < 16; ++ii) o[ii * 128] = f2bf(w[ii]);
            }
        }
    } } else if (!(skip & 4)) {
        const int e = tid - 256;
        u16* QD = (u16*)(p.ws + WS_QD) + (size_t)item * 8192;
        u16* KDT = (u16*)(p.ws + WS_KDT) + (size_t)item * 8192;
        const float Gl = Gs[63];
#pragma unroll 4
        for (int k = 0; k < 16; ++k) {
            const int idx = e + 256 * k;
            { const int i = idx >> 6, dp = (idx & 63) * 2; const float s = __expf(Gs[i]);
              const unsigned u = *(const unsigned*)(qT + i * 136 + dp);
              *(unsigned*)(QD + i * 128 + permk(dp)) = pk2(bflo(u) * s, bfhi(u) * s); }
            { const int d = idx >> 5, jp = (idx & 31) * 2;
              const float v0 = bf2f(kT[jp * 136 + d]) * __expf(Gl - Gs[jp]), v1 = bf2f(kT[(jp + 1) * 136 + d]) * __expf(Gl - Gs[jp + 1]);
              *(unsigned*)(KDT + d * 64 + permk(jp)) = pk2(v0, v1); }
        }
        if (e == 0) ((float*)(p.ws + WS_GLAST))[item] = __expf(Gl);
    }
}

__device__ __forceinline__ bf16x8 ld2(const u16* a) { return *(const bf16x8*)a; }
__device__ __forceinline__ bf16x8 pkfrag(const f32x4& a, const f32x4& b) {
    typedef unsigned u32x4 __attribute__((ext_vector_type(4)));
    u32x4 w; w.x = pk2(a[0], a[1]); w.y = pk2(a[2], a[3]); w.z = pk2(b[0], b[1]); w.w = pk2(b[2], b[3]);
    return __builtin_bit_cast(bf16x8, w);
}
__device__ __forceinline__ void gdn_scan_item(const Params& p, int l, int ch0, int nsteps, int h, int cb, const float* s_init, float* s_out, int L) {
    const int lane = tidx() & 63, fr = lane & 15, fq = lane >> 4, c = cb * 16 + fr;
    f32x4 S[8];
#pragma unroll
    for (int u = 0; u < 8; ++u)
#pragma unroll
        for (int r = 0; r < 4; ++r) S[u][r] = s_init ? s_init[(size_t)(16 * u + 4 * fq + r) * 128 + c] : 0.f;
    float* ORAW = (float*)(p.ws + WS_ORAW);
    for (int st = 0; st < nsteps; ++st) {
        const int ch = ch0 + st, item = ch * 8 + h;
        const int tok0 = ch < 256 ? ch * 64 : NPT + (ch - 256) * 32;
        const u16* kc = (const u16*)(p.ws + WS_KCUM) + (size_t)item * 8192 + fr * 128 + 8 * fq;
        const u16* qd = (const u16*)(p.ws + WS_QD) + (size_t)item * 8192 + fr * 128 + 8 * fq;
        const u16* kdt = (const u16*)(p.ws + WS_KDT) + (size_t)item * 8192 + fr * 64 + 8 * fq;
        const u16* qk = (const u16*)(p.ws + WS_QKM) + (size_t)item * 4096 + fr * 64 + 8 * fq;
        const u16* vnt = (const u16*)(p.ws + WS_VNT) + (size_t)item * 8192 + c * 64 + 4 * fq;
        const float gl = ((const float*)(p.ws + WS_GLAST))[item];
        bf16x8 sb[4];
#pragma unroll
        for (int ks = 0; ks < 4; ++ks) sb[ks] = pkfrag(S[2 * ks], S[2 * ks + 1]);
        f32x4 w[4];
#pragma unroll
        for (int t = 0; t < 4; ++t) {
            f32x4 acc = {0.f, 0.f, 0.f, 0.f};
#pragma unroll
            for (int ks = 0; ks < 4; ++ks) acc = __builtin_amdgcn_mfma_f32_16x16x32_bf16(ld2(kc + t * 16 * 128 + ks * 32), sb[ks], acc, 0, 0, 0);
            const uint2 vn = *(const uint2*)(vnt + 16 * t);
            w[t][0] = bflo(vn.x) - acc[0]; w[t][1] = bfhi(vn.x) - acc[1]; w[t][2] = bflo(vn.y) - acc[2]; w[t][3] = bfhi(vn.y) - acc[3];
        }
        bf16x8 wb[2];
        wb[0] = pkfrag(w[0], w[1]); wb[1] = pkfrag(w[2], w[3]);
#pragma unroll
        for (int t = 0; t < 4; ++t) {
            f32x4 acc = {0.f, 0.f, 0.f, 0.f};
#pragma unroll
            for (int ks = 0; ks < 4; ++ks) acc = __builtin_amdgcn_mfma_f32_16x16x32_bf16(ld2(qd + t * 16 * 128 + ks * 32), sb[ks], acc, 0, 0, 0);
#pragma unroll
            for (int k2 = 0; k2 < 2; ++k2) acc = __builtin_amdgcn_mfma_f32_16x16x32_bf16(ld2(qk + t * 16 * 64 + k2 * 32), wb[k2], acc, 0, 0, 0);
#pragma unroll
            for (int r = 0; r < 4; ++r) { const int row = 16 * t + 4 * fq + r; if (row < L) ORAW[(size_t)(tok0 + row) * 1024 + h * 128 + c] = acc[r]; }
        }
#pragma unroll
        for (int u = 0; u < 8; ++u) {
            f32x4 acc = S[u] * gl;
#pragma unroll
            for (int k2 = 0; k2 < 2; ++k2) acc = __builtin_amdgcn_mfma_f32_16x16x32_bf16(ld2(kdt + u * 16 * 64 + k2 * 32), wb[k2], acc, 0, 0, 0);
            S[u] = acc;
        }
    }
#pragma unroll
    for (int u = 0; u < 8; ++u)
#pragma unroll
        for (int r = 0; r < 4; ++r) s_out[(size_t)(16 * u + 4 * fq + r) * 128 + c] = S[u][r];
}
constexpr int SC_KC = 0, SC_QD = 17408, SC_KDT = 34816, SC_QK = 53248, SC_STAGE = 62464;
__device__ __forceinline__ bf16x8 ld2s(const unsigned char* a) { return *(const bf16x8*)a; }
__device__ __forceinline__ void gdn_scan_block(const Params& p, int l, int b, int h, int cq, unsigned char* lds, const int mode = 0) {
    const int tid = tidx(), wid = __builtin_amdgcn_readfirstlane(tid >> 6), lane = tid & 63, fr = lane & 15, fq = lane >> 4;
    const int c = cq * 64 + (wid & 3) * 16 + fr;
    const bool comp = wid < 4 && mode != 1;
    const int rowA = tid >> 4, segA = tid & 15;
    const int rowB = tid >> 3, segB = tid & 7;
    const int sA = (rowA * 128 + segA * 8) * 2, dA = rowA * 272 + segA * 16;
    const int sB = (rowB * 64 + segB * 8) * 2, dB = rowB * 144 + segB * 16;
    const unsigned char* gKC = p.ws + WS_KCUM + sA; const unsigned char* gQD = p.ws + WS_QD + sA;
    const unsigned char* gKDT = p.ws + WS_KDT + sB; const unsigned char* gQK = p.ws + WS_QKM + sB;
    uint4 a0, a1, a2, a3, a4, a5, a6, b0, b1, b2, b3, b4, b5, b6;
#define SC_LOAD(P_, item) do { const size_t o_ = (size_t)(item) * 16384; \
        P_##0 = *(const uint4*)(gKC + o_); P_##1 = *(const uint4*)(gKC + o_ + 32 * 256); P_##2 = *(const uint4*)(gQD + o_); P_##3 = *(const uint4*)(gQD + o_ + 32 * 256); \
        P_##4 = *(const uint4*)(gKDT + o_); P_##5 = *(const uint4*)(gKDT + o_ + 64 * 128); P_##6 = *(const uint4*)(gQK + (size_t)(item) * 8192); } while (0)
#define SC_WRITE(P_, st) do { unsigned char* d_ = lds + (st) * SC_STAGE; \
        *(uint4*)(d_ + SC_KC + dA) = P_##0; *(uint4*)(d_ + SC_KC + dA + 32 * 272) = P_##1; *(uint4*)(d_ + SC_QD + dA) = P_##2; *(uint4*)(d_ + SC_QD + dA + 32 * 272) = P_##3; \
        *(uint4*)(d_ + SC_KDT + dB) = P_##4; *(uint4*)(d_ + SC_KDT + dB + 64 * 144) = P_##5; *(uint4*)(d_ + SC_QK + dB) = P_##6; } while (0)
    f32x4 S[8];
#pragma unroll
    for (int u = 0; u < 8; ++u) S[u] = (f32x4){0.f, 0.f, 0.f, 0.f};
    float* ORAW = (float*)(p.ws + (mode ? WS_T1 : WS_ORAW));
    const int item0 = (b * 128) * 8 + h;
    __syncthreads();
    SC_LOAD(a, item0); SC_WRITE(a, 0); SC_LOAD(a, item0 + 8);
    uint2 vn0[4], vn1[4]; float gl0, gl1;
    {
        const u16* vnt = (const u16*)(p.ws + WS_VNT) + (size_t)item0 * 8192 + c * 64 + 4 * fq;
#pragma unroll
        for (int t = 0; t < 4; ++t) { vn0[t] = *(const uint2*)(vnt + 16 * t); vn1[t] = *(const uint2*)(vnt + 8 * 8192 + 16 * t); }
        gl0 = ((const float*)(p.ws + WS_GLAST))[item0]; gl1 = ((const float*)(p.ws + WS_GLAST))[item0 + 8];
    }
    float* obuf = (float*)(lds + 2 * SC_STAGE);
    const int orow = tid >> 3, ocol = (tid & 7) * 8;
    __syncthreads();
    auto compute = [&](int st, uint2 (&vn)[4], const float gl) __attribute__((always_inline)) {
        const unsigned char* sb_ = lds + (st & 1) * SC_STAGE;
        const unsigned char* kc = sb_ + SC_KC + fr * 272 + fq * 16;
        const unsigned char* qd = sb_ + SC_QD + fr * 272 + fq * 16;
        const unsigned char* kdt = sb_ + SC_KDT + fr * 144 + fq * 16;
        const unsigned char* qk = sb_ + SC_QK + fr * 144 + fq * 16;
        bf16x8 ga[8], gb[8];
#define SC_RD(dst, base, pitch, t0, nk) do { _Pragma("unroll") for (int i_ = 0; i_ < 8; ++i_) dst[i_] = ld2s(base + ((t0) + i_ / (nk)) * 16 * (pitch) + (i_ % (nk)) * 64); } while (0)
        SC_RD(ga, kc, 272, 0, 4);
        SC_RD(gb, kc, 272, 2, 4);
        bf16x8 sb[4];
#pragma unroll
        for (int ks = 0; ks < 4; ++ks) sb[ks] = pkfrag(S[2 * ks], S[2 * ks + 1]);
        __builtin_amdgcn_sched_barrier(0);
        f32x4 w[4];
#pragma unroll
        for (int t = 0; t < 2; ++t) {
            f32x4 acc = {0.f, 0.f, 0.f, 0.f};
#pragma unroll
            for (int ks = 0; ks < 4; ++ks) acc = __builtin_amdgcn_mfma_f32_16x16x32_bf16(ga[t * 4 + ks], sb[ks], acc, 0, 0, 0);
            w[t][0] = bflo(vn[t].x) - acc[0]; w[t][1] = bfhi(vn[t].x) - acc[1]; w[t][2] = bflo(vn[t].y) - acc[2]; w[t][3] = bfhi(vn[t].y) - acc[3];
        }
        __builtin_amdgcn_sched_barrier(0);
        SC_RD(ga, kdt, 144, 0, 2);
        __builtin_amdgcn_sched_barrier(0);
#pragma unroll
        for (int t = 2; t < 4; ++t) {
            f32x4 acc = {0.f, 0.f, 0.f, 0.f};
#pragma unroll
            for (int ks = 0; ks < 4; ++ks) acc = __builtin_amdgcn_mfma_f32_16x16x32_bf16(gb[(t - 2) * 4 + ks], sb[ks], acc, 0, 0, 0);
            w[t][0] = bflo(vn[t].x) - acc[0]; w[t][1] = bfhi(vn[t].x) - acc[1]; w[t][2] = bflo(vn[t].y) - acc[2]; w[t][3] = bfhi(vn[t].y) - acc[3];
        }
        bf16x8 wb[2];
        wb[0] = pkfrag(w[0], w[1]); wb[1] = pkfrag(w[2], w[3]);
        __builtin_amdgcn_sched_barrier(0);
        SC_RD(gb, kdt, 144, 4, 2);
        __builtin_amdgcn_sched_barrier(0);
#pragma unroll
        for (int u = 0; u < 4; ++u) {
            f32x4 acc = S[u] * gl;
#pragma unroll
            for (int k2 = 0; k2 < 2; ++k2) acc = __builtin_amdgcn_mfma_f32_16x16x32_bf16(ga[u * 2 + k2], wb[k2], acc, 0, 0, 0);
            S[u] = acc;
        }
        __builtin_amdgcn_sched_barrier(0);
        SC_RD(ga, qd, 272, 0, 4);
        __builtin_amdgcn_sched_barrier(0);
#pragma unroll
        for (int u = 4; u < 8; ++u) {
            f32x4 acc = S[u] * gl;
#pragma unroll
            for (int k2 = 0; k2 < 2; ++k2) acc = __builtin_amdgcn_mfma_f32_16x16x32_bf16(gb[(u - 4) * 2 + k2], wb[k2], acc, 0, 0, 0);
            S[u] = acc;
        }
        __builtin_amdgcn_sched_barrier(0);
        SC_RD(gb, qd, 272, 2, 4);
        __builtin_amdgcn_sched_barrier(0);
        float* ob = obuf + (st & 1) * 4352 + (wid & 3) * 16 + fr;
        f32x4 o[4];
#pragma unroll
        for (int t = 0; t < 2; ++t) {
            o[t] = (f32x4){0.f, 0.f, 0.f, 0.f};
#pragma unroll
            for (int ks = 0; ks < 4; ++ks) o[t] = __builtin_amdgcn_mfma_f32_16x16x32_bf16(ga[t * 4 + ks], sb[ks], o[t], 0, 0, 0);
        }
        __builtin_amdgcn_sched_barrier(0);
        SC_RD(ga, qk, 144, 0, 2);
        __builtin_amdgcn_sched_barrier(0);
#pragma unroll
        for (int t = 2; t < 4; ++t) {
            o[t] = (f32x4){0.f, 0.f, 0.f, 0.f};
#pragma unroll
            for (int ks = 0; ks < 4; ++ks) o[t] = __builtin_amdgcn_mfma_f32_16x16x32_bf16(gb[(t - 2) * 4 + ks], sb[ks], o[t], 0, 0, 0);
        }
        __builtin_amdgcn_sched_barrier(0);
#pragma unroll
        for (int t = 0; t < 4; ++t) {
#pragma unroll
            for (int k2 = 0; k2 < 2; ++k2) o[t] = __builtin_amdgcn_mfma_f32_16x16x32_bf16(ga[t * 2 + k2], wb[k2], o[t], 0, 0, 0);
#pragma unroll
            for (int r = 0; r < 4; ++r) ob[(16 * t + 4 * fq + r) * 68] = o[t][r];
        }
#undef SC_RD
    };
#define SC_HALF(sc, LS, WS, VN, GL) do { \
        const int sp_ = (sc) > 0 ? (sc) - 1 : 0, sn_ = (sc) + 2 < 128 ? (sc) + 2 : 127; \
        const float4 ov_ = *(const float4*)(obuf + (sp_ & 1) * 4352 + orow * 68 + ocol), ow_ = *(const float4*)(obuf + (sp_ & 1) * 4352 + orow * 68 + ocol + 4); \
        if (mode != 2) SC_LOAD(LS, item0 + sn_ * 8); \
        { float* od_ = ORAW + (size_t)((b * 128 + sp_) * 64 + orow) * 1024 + h * 128 + cq * 64 + ocol; *(float4*)od_ = ov_; *(float4*)(od_ + 4) = ow_; }     \
        if (comp) compute(sc, VN, GL); \
        if (mode != 2) SC_WRITE(WS, ((sc) + 1) & 1); \
        { const u16* vnt_ = (const u16*)(p.ws + WS_VNT) + (size_t)(item0 + sn_ * 8) * 8192 + c * 64 + 4 * fq; \
          _Pragma("unroll") for (int t = 0; t < 4; ++t) VN[t] = *(const uint2*)(vnt_ + 16 * t); \
          GL = ((const float*)(p.ws + WS_GLAST))[item0 + sn_ * 8]; } \
        __syncthreads(); } while (0)
    for (int st = 0; st < 128; st += 2) { SC_HALF(st, b, a, vn0, gl0); SC_HALF(st + 1, a, b, vn1, gl1); }
#undef SC_HALF
    { float* od_ = ORAW + (size_t)((b * 128 + 127) * 64 + orow) * 1024 + h * 128 + cq * 64 + ocol; const float* os_ = obuf + 4352 + orow * 68 + ocol;
      *(float4*)od_ = *(const float4*)os_; *(float4*)(od_ + 4) = *(const float4*)(os_ + 4); }
#undef SC_LOAD
#undef SC_WRITE
    if (comp) {
        float* s_out = mode ? (float*)(p.ws + WS_T1) : p.out + O_SSMP + ((size_t)(l * 2 + b) * 8 + h) * 16384;
#pragma unroll
        for (int u = 0; u < 8; ++u)
#pragma unroll
            for (int r = 0; r < 4; ++r) s_out[(size_t)(16 * u + 4 * fq + r) * 128 + c] = S[u][r];
    }
}
__device__ __forceinline__ void phase_post2(const Params& p, int l) {
    const int wid = tidx() >> 6, lane = tidx() & 63, hs = lane >> 4, c8 = (lane & 15) * 8;
    const float* ORAW = (const float*)(p.ws + WS_ORAW); const u16* P = (const u16*)(p.ws + WS_P); u16* OAN = (u16*)(p.ws + WS_OAN);
    const float4 ga = *(const float4*)(p.in[15] + l * 128 + c8), gb = *(const float4*)(p.in[15] + l * 128 + c8 + 4);
    for (int it = bidx() * 8 + wid; it < NTOK * 2; it += gridDim.x * 8) {
        const int tok = it >> 1, h = (it & 1) * 4 + hs;
        const float* op = ORAW + (size_t)tok * 1024 + h * 128 + c8;
        const float4 x = *(const float4*)op, y = *(const float4*)(op + 4);
        const uint4 z = *(const uint4*)(P + (size_t)tok * LDP + 3072 + h * 128 + c8);
        float ss = x.x * x.x + x.y * x.y + x.z * x.z + x.w * x.w + y.x * y.x + y.y * y.y + y.z * y.z + y.w * y.w;
#pragma unroll
        for (int o = 8; o; o >>= 1) ss += __shfl_xor(ss, o);
        const float rstd = rsqrtf(ss * (1.f / 128.f) + EPSF);
        uint4 w;
        w.x = pk2(x.x * rstd * ga.x * siluf(bflo(z.x)), x.y * rstd * ga.y * siluf(bfhi(z.x)));
        w.y = pk2(x.z * rstd * ga.z * siluf(bflo(z.y)), x.w * rstd * ga.w * siluf(bfhi(z.y)));
        w.z = pk2(y.x * rstd * gb.x * siluf(bflo(z.z)), y.y * rstd * gb.y * siluf(bfhi(z.z)));
        w.w = pk2(y.z * rstd * gb.z * siluf(bflo(z.w)), y.w * rstd * gb.w * siluf(bfhi(z.w)));
        *(uint4*)(OAN + (size_t)tok * 1024 + h * 128 + c8) = w;
    }
}

__device__ __forceinline__ void phase_final(const Params& p) {
    const int wid = tidx() >> 6, lane = tidx() & 63;
    const float* X = (const float*)(p.ws + WS_X); const float* fw = p.in[21];
    for (int tok = bidx() * 8 + wid; tok < NTOK; tok += gridDim.x * 8) {
        const float4* xr = (const float4*)(X + (size_t)tok * 1024);
        float4 v[4]; float ss = 0.f;
#pragma unroll
        for (int i = 0; i < 4; ++i) { v[i] = xr[lane + 64 * i]; ss += v[i].x * v[i].x + v[i].y * v[i].y + v[i].z * v[i].z + v[i].w * v[i].w; }
        ss = wave_sum(ss);
        const float rstd = rsqrtf(ss * (1.f / 1024.f) + EPSF);
#pragma unroll
        for (int i = 0; i < 4; ++i) { const float4 w = ((const float4*)fw)[lane + 64 * i];
            ((float4*)(p.out + O_Y + (size_t)tok * 1024))[lane + 64 * i] = make_float4(v[i].x * rstd * w.x, v[i].y * rstd * w.y, v[i].z * rstd * w.z, v[i].w * rstd * w.w); }
    }
}

__device__ __forceinline__ float lam_of(const Params& p, int l, int lane) {
    const float* lq = p.in[16] + l * 256;
    const float a = wave_sum(lq[lane] * lq[64 + lane]), b = wave_sum(lq[128 + lane] * lq[192 + lane]);
    return __expf(a) - __expf(b) + lam_init_of(l);
}
__device__ __forceinline__ void attn_store(const Params& p, int l, int tok, int h, int hh, const f32x16 (&d)[4], float ss) {
    ss += __shfl_xor(ss, 32);
    const float sc = rsqrtf(ss * (1.f / 128.f) + EPSF) * (1.f - lam_init_of(l));
    const u16* zp = (const u16*)(p.ws + WS_P) + (size_t)tok * LDP + 7168 + h * 128;
    u16* op = (u16*)(p.ws + WS_OBN) + (size_t)tok * 1024 + h * 128;
    const float* dw = p.in[17] + l * 128;
#pragma unroll
    for (int t = 0; t < 4; ++t)
#pragma unroll
        for (int g = 0; g < 4; ++g) {
            const int vc = 32 * t + 8 * g + 4 * hh;
            const uint2 z = *(const uint2*)(zp + vc); const float4 w = *(const float4*)(dw + vc);
            const float o0 = d[t][4 * g] * sc * w.x * siluf(bflo(z.x)), o1 = d[t][4 * g + 1] * sc * w.y * siluf(bfhi(z.x));
            const float o2 = d[t][4 * g + 2] * sc * w.z * siluf(bflo(z.y)), o3 = d[t][4 * g + 3] * sc * w.w * siluf(bfhi(z.y));
            *(uint2*)(op + vc) = make_uint2(pk2(o0, o1), pk2(o2, o3));
        }
}

constexpr int AT_KPITCH = 272, AT_VPITCH = 144, AT_KBYTES = 64 * AT_KPITCH, AT_VBYTES = 128 * AT_VPITCH, AT_VBASE = 2 * AT_KBYTES;

__device__ __forceinline__ void attn_prompt_item(const Params& p, int l, int b, int h, int qb, unsigned char* lds) {
    const int tid = tidx(), wid = __builtin_amdgcn_readfirstlane(tid >> 6), lane = tid & 63;
    const int m = wid & 1, rg = wid >> 1, ql = lane & 31, hh = lane >> 5;
    const bool late = wid >= 4;
    const int tokq = b * 8192 + qb * 128 + rg * 32 + ql;
    const u16* QB = (const u16*)(p.ws + WS_QB);
    bf16x8 qf[4];
#pragma unroll
    for (int s = 0; s < 4; ++s) qf[s] = *(const bf16x8*)(QB + (size_t)tokq * 1024 + h * 128 + m * 64 + 16 * s + 8 * hh);
    const int ntb = 2 * qb + 2, ntw = 2 * qb + 1 + (rg >> 1);
    f32x16 O[4];
#pragma unroll
    for (int t = 0; t < 4; ++t)
#pragma unroll
        for (int r = 0; r < 16; ++r) O[t][r] = 0.f;
    float mrun = -1e30f, lrun = 0.f;
    const u16* KBp = (const u16*)(p.ws + WS_KB) + (size_t)(b * 8192) * 1024 + h * 128;
    const u16* VTp = (const u16*)(p.ws + WS_VT) + (size_t)((b * 8 + h) * 128) * 8192;
    const int krow0 = tid >> 4, kseg = tid & 15;
    const int vrow0 = tid >> 3, vseg = tid & 7;
    uint4 kr0, kr1, vr0, vr1;
#define AT_LOAD(j) do { \
        kr0 = *(const uint4*)(KBp + (size_t)((j) * 64 + krow0) * 1024 + kseg * 8); kr1 = *(const uint4*)(KBp + (size_t)((j) * 64 + krow0 + 32) * 1024 + kseg * 8); \
        vr0 = *(const uint4*)(VTp + (size_t)(vrow0) * 8192 + (j) * 64 + vseg * 8); vr1 = *(const uint4*)(VTp + (size_t)(vrow0 + 64) * 8192 + (j) * 64 + vseg * 8); } while (0)
#define AT_WRITE(ks_, vs_) do { unsigned char* kb = lds + (ks_) * AT_KBYTES; unsigned char* vb = lds + AT_VBASE + (vs_) * AT_VBYTES; \
        *(uint4*)(kb + (krow0) * AT_KPITCH + kseg * 16) = kr0; *(uint4*)(kb + (krow0 + 32) * AT_KPITCH + kseg * 16) = kr1; \
        *(uint4*)(vb + (vrow0) * AT_VPITCH + vseg * 16) = vr0; *(uint4*)(vb + (vrow0 + 64) * AT_VPITCH + vseg * 16) = vr1; } while (0)
    auto pv = [&](const unsigned char* vb, const bf16x8 f0, const bf16x8 f1, const bf16x8 f2, const bf16x8 f3) __attribute__((always_inline)) {
        const unsigned char* vl = vb + ql * AT_VPITCH + hh * 16;
        bf16x8 va[4], vc[4];
#define AT_VRD(dst, k) do { _Pragma("unroll") for (int t = 0; t < 4; ++t) dst[t] = *(const bf16x8*)(vl + (32 * t) * AT_VPITCH + (k) * 32); } while (0)
#define AT_VMM(src, f) do { _Pragma("unroll") for (int t = 0; t < 4; ++t) O[t] = __builtin_amdgcn_mfma_f32_32x32x16_bf16(src[t], f, O[t], 0, 0, 0); } while (0)
        AT_VRD(va, 0); AT_VRD(vc, 1);
        __builtin_amdgcn_sched_barrier(0);
        AT_VMM(va, f0);
        __builtin_amdgcn_sched_barrier(0);
        AT_VRD(va, 2);
        __builtin_amdgcn_sched_barrier(0);
        AT_VMM(vc, f1);
        __builtin_amdgcn_sched_barrier(0);
        AT_VRD(vc, 3);
        __builtin_amdgcn_sched_barrier(0);
        AT_VMM(va, f2); AT_VMM(vc, f3);
        __builtin_amdgcn_sched_barrier(0);
#undef AT_VRD
#undef AT_VMM
    };
    typedef unsigned u32x4 __attribute__((ext_vector_type(4)));
    u32x4 pp0 = {0, 0, 0, 0}, pp1 = {0, 0, 0, 0}, pp2 = {0, 0, 0, 0}, pp3 = {0, 0, 0, 0};
    __syncthreads();
    AT_LOAD(0); AT_WRITE(0, 0);
    __syncthreads();
    int vcur = 0;
    for (int j = 0; j < ntb; ++j) {
        const int vprev = vcur == 0 ? 2 : vcur - 1, vnext = vcur == 2 ? 0 : vcur + 1;
        if (j + 1 < ntb) AT_LOAD(j + 1);
        if (late && j >= 1) pv(lds + AT_VBASE + vprev * AT_VBYTES, __builtin_bit_cast(bf16x8, pp0), __builtin_bit_cast(bf16x8, pp1), __builtin_bit_cast(bf16x8, pp2), __builtin_bit_cast(bf16x8, pp3));
        if (j < ntw) {
            const unsigned char* kb = lds + (j & 1) * AT_KBYTES;
            bf16x8 kf[8];
#pragma unroll
            for (int kt = 0; kt < 2; ++kt)
#pragma unroll
                for (int s = 0; s < 4; ++s) kf[kt * 4 + s] = *(const bf16x8*)(kb + (32 * kt + ql) * AT_KPITCH + m * 128 + s * 32 + hh * 16);
            __builtin_amdgcn_sched_barrier(0);
            f32x16 st[2];
#pragma unroll
            for (int kt = 0; kt < 2; ++kt)
#pragma unroll
                for (int r = 0; r < 16; ++r) st[kt][r] = 0.f;
#pragma unroll
            for (int s = 0; s < 4; ++s) {
                st[0] = __builtin_amdgcn_mfma_f32_32x32x16_bf16(kf[s], qf[s], st[0], 0, 0, 0);
                st[1] = __builtin_amdgcn_mfma_f32_32x32x16_bf16(kf[4 + s], qf[s], st[1], 0, 0, 0);
            }
            __builtin_amdgcn_sched_barrier(0);
            float mx = st[0][0];
#pragma unroll
            for (int r = 1; r < 16; ++r) mx = fmaxf(mx, st[0][r]);
#pragma unroll
            for (int r = 0; r < 16; ++r) mx = fmaxf(mx, st[1][r]);
            mx = fmaxf(mx, __shfl_xor(mx, 32));
            if (__any(mx > mrun)) {
                const float mnew_ = fmaxf(mrun, mx), alpha = __builtin_amdgcn_exp2f(mrun - mnew_);
                mrun = mnew_; lrun *= alpha;
#pragma unroll
                for (int t = 0; t < 4; ++t) O[t] *= alpha;
            }
            const float mnew = mrun;
#define AT_PFRAG(dst, kt, s2) do { float e0 = __builtin_amdgcn_exp2f(st[kt][8 * s2 + 0] - mnew), e1 = __builtin_amdgcn_exp2f(st[kt][8 * s2 + 1] - mnew), \
        e2 = __builtin_amdgcn_exp2f(st[kt][8 * s2 + 2] - mnew), e3 = __builtin_amdgcn_exp2f(st[kt][8 * s2 + 3] - mnew), \
        e4 = __builtin_amdgcn_exp2f(st[kt][8 * s2 + 4] - mnew), e5 = __builtin_amdgcn_exp2f(st[kt][8 * s2 + 5] - mnew), \
        e6 = __builtin_amdgcn_exp2f(st[kt][8 * s2 + 6] - mnew), e7 = __builtin_amdgcn_exp2f(st[kt][8 * s2 + 7] - mnew); \
        lrun += ((e0 + e1) + (e2 + e3)) + ((e4 + e5) + (e6 + e7)); \
        dst.x = pk2(e0, e1); dst.y = pk2(e2, e3); dst.z = pk2(e4, e5); dst.w = pk2(e6, e7); } while (0)
            AT_PFRAG(pp0, 0, 0); AT_PFRAG(pp1, 0, 1); AT_PFRAG(pp2, 1, 0); AT_PFRAG(pp3, 1, 1);
#undef AT_PFRAG
            __builtin_amdgcn_sched_barrier(0);
            if (!late) pv(lds + AT_VBASE + vcur * AT_VBYTES, __builtin_bit_cast(bf16x8, pp0), __builtin_bit_cast(bf16x8, pp1), __builtin_bit_cast(bf16x8, pp2), __builtin_bit_cast(bf16x8, pp3));
        }
        if (j + 1 < ntb) AT_WRITE((j + 1) & 1, vnext);
        __syncthreads();
        vcur = vnext;
    }
    if (late) { const int vlast = vcur == 0 ? 2 : vcur - 1;
        pv(lds + AT_VBASE + vlast * AT_VBYTES, __builtin_bit_cast(bf16x8, pp0), __builtin_bit_cast(bf16x8, pp1), __builtin_bit_cast(bf16x8, pp2), __builtin_bit_cast(bf16x8, pp3)); }
    __syncthreads();
#undef AT_LOAD
#undef AT_WRITE
    const float inv = 1.f / (lrun + __shfl_xor(lrun, 32));
    float* xb = (float*)lds + rg * 4096;
    if (m == 1) {
#pragma unroll
        for (int t = 0; t < 4; ++t)
#pragma unroll
            for (int r = 0; r < 16; ++r) xb[(t * 16 + r) * 64 + lane] = O[t][r] * inv;
    }
    __syncthreads();
    if (m == 0) {
        const float lam = lam_of(p, l, lane);
        float ss = 0.f;
#pragma unroll
        for (int t = 0; t < 4; ++t)
#pragma unroll
            for (int r = 0; r < 16; ++r) { const float d = O[t][r] * inv - lam * xb[(t * 16 + r) * 64 + lane]; O[t][r] = d; ss += d * d; }
        attn_store(p, l, tokq, h, hh, O, ss);
    }
}

__device__ __forceinline__ void attn_sample_item(const Params& p, int l, int b, int h, unsigned char* lds) {
    const int tid = tidx(), wid = __builtin_amdgcn_readfirstlane(tid >> 6), lane = tid & 63, ql = lane & 31, hh = lane >> 5;
    const int t = wid & 3, kh = wid >> 2;
    const int tok0 = NPT + b * 32, tokq = tok0 + ql;
    const u16* QB = (const u16*)(p.ws + WS_QB); const u16* KB = (const u16*)(p.ws + WS_KB); const u16* P = (const u16*)(p.ws + WS_P);
    const float* CK = p.in[4] + ((size_t)(l * 16 + b) * 8 + h) * 1024 * 128;
    const float* CV = p.in[5] + ((size_t)(l * 16 + b) * 8 + h) * 1024 * 128;
    float* xo = (float*)lds;
    float* xss = (float*)(lds + 32768);
    typedef unsigned u32x4 __attribute__((ext_vector_type(4)));
    f32x16 O1;
#pragma unroll
    for (int r = 0; r < 16; ++r) O1[r] = 0.f;
    f32x16 O;
    __syncthreads();
    for (int m = 0; m < 2; ++m) {
        bf16x8 qf[4];
#pragma unroll
        for (int s = 0; s < 4; ++s) qf[s] = *(const bf16x8*)(QB + (size_t)tokq * 1024 + h * 128 + m * 64 + 16 * s + 8 * hh);
#pragma unroll
        for (int r = 0; r < 16; ++r) O[r] = 0.f;
        float mrun = -1e30f, lrun = 0.f;
        const int kt0 = kh ? 17 : 0, kt1 = kh ? 33 : 17;
        for (int kt = kt0; kt < kt1; ++kt) {
            f32x16 st;
#pragma unroll
            for (int r = 0; r < 16; ++r) st[r] = 0.f;
            if (kt < 32) {
                const float* kp = CK + (size_t)(kt * 32 + ql) * 128 + m * 64 + 8 * hh;
#pragma unroll
                for (int s = 0; s < 4; ++s) {
                    const float4 x = *(const float4*)(kp + 16 * s), y = *(const float4*)(kp + 16 * s + 4);
                    u32x4 w; w.x = pk2(x.x, x.y); w.y = pk2(x.z, x.w); w.z = pk2(y.x, y.y); w.w = pk2(y.z, y.w);
                    st = __builtin_amdgcn_mfma_f32_32x32x16_bf16(__builtin_bit_cast(bf16x8, w), qf[s], st, 0, 0, 0);
                }
            } else {
                const u16* kp = KB + (size_t)(tok0 + ql) * 1024 + h * 128 + m * 64 + 8 * hh;
#pragma unroll
                for (int s = 0; s < 4; ++s) st = __builtin_amdgcn_mfma_f32_32x32x16_bf16(*(const bf16x8*)(kp + 16 * s), qf[s], st, 0, 0, 0);
            }
            float mx = st[0];
#pragma unroll
            for (int r = 1; r < 16; ++r) mx = fmaxf(mx, st[r]);
            mx = fmaxf(mx, __shfl_xor(mx, 32));
            const float mnew = fmaxf(mrun, mx), alpha = __builtin_amdgcn_exp2f(mrun - mnew);
            mrun = mnew; lrun *= alpha;
            O *= alpha;
            float e[16];
#pragma unroll
            for (int r = 0; r < 16; ++r) { e[r] = __builtin_amdgcn_exp2f(st[r] - mnew); lrun += e[r]; }
#pragma unroll
            for (int s2 = 0; s2 < 2; ++s2) {
                u32x4 pw; pw.x = pk2(e[8 * s2], e[8 * s2 + 1]); pw.y = pk2(e[8 * s2 + 2], e[8 * s2 + 3]); pw.z = pk2(e[8 * s2 + 4], e[8 * s2 + 5]); pw.w = pk2(e[8 * s2 + 6], e[8 * s2 + 7]);
                float v[8];
                if (kt < 32) {
                    const float* vp = CV + (size_t)(kt * 32 + 16 * s2 + 4 * hh) * 128 + 32 * t + ql;
#pragma unroll
                    for (int i = 0; i < 4; ++i) { v[i] = vp[i * 128]; v[4 + i] = vp[(8 + i) * 128]; }
                } else {
                    const u16* vp = P + (size_t)(tok0 + 16 * s2 + 4 * hh) * LDP + 6144 + h * 128 + 32 * t + ql;
#pragma unroll
                    for (int i = 0; i < 4; ++i) { v[i] = bf2f(vp[(size_t)i * LDP]); v[4 + i] = bf2f(vp[(size_t)(8 + i) * LDP]); }
                }
                u32x4 w; w.x = pk2(v[0], v[1]); w.y = pk2(v[2], v[3]); w.z = pk2(v[4], v[5]); w.w = pk2(v[6], v[7]);
                O = __builtin_amdgcn_mfma_f32_32x32x16_bf16(__builtin_bit_cast(bf16x8, w), __builtin_bit_cast(bf16x8, pw), O, 0, 0, 0);
            }
        }
        float* sl = xo + t * 1152;
        if (kh == 1) {
#pragma unroll
            for (int r = 0; r < 16; ++r) sl[r * 64 + lane] = O[r];
            sl[1024 + lane] = mrun; sl[1088 + lane] = lrun;
        }
        __syncthreads();
        if (kh == 0) {
            const float mo = sl[1024 + lane], lo = sl[1088 + lane];
            const float mnew = fmaxf(mrun, mo), a = __builtin_amdgcn_exp2f(mrun - mnew), ao = __builtin_amdgcn_exp2f(mo - mnew);
            lrun = lrun * a + lo * ao;
            const float inv = 1.f / (lrun + __shfl_xor(lrun, 32));
#pragma unroll
            for (int r = 0; r < 16; ++r) O[r] = (O[r] * a + sl[r * 64 + lane] * ao) * inv;
            if (m == 0) O1 = O;
        }
        __syncthreads();
    }
    float ss = 0.f;
    if (kh == 0) {
        const float lam = lam_of(p, l, lane);
#pragma unroll
        for (int r = 0; r < 16; ++r) { const float d = O1[r] - lam * O[r]; O[r] = d; ss += d * d; }
        ss += __shfl_xor(ss, 32);
        if (hh == 0) xss[t * 32 + ql] = ss;
    }
    __syncthreads();
    if (kh == 0) {
        const float tot = xss[ql] + xss[32 + ql] + xss[64 + ql] + xss[96 + ql];
        const float sc = rsqrtf(tot * (1.f / 128.f) + EPSF) * (1.f - lam_init_of(l));
        const u16* zp = (const u16*)(p.ws + WS_P) + (size_t)tokq * LDP + 7168 + h * 128;
        u16* op = (u16*)(p.ws + WS_OBN) + (size_t)tokq * 1024 + h * 128;
        const float* dw = p.in[17] + l * 128;
#pragma unroll
        for (int g = 0; g < 4; ++g) {
            const int vc = 32 * t + 8 * g + 4 * hh;
            const uint2 z = *(const uint2*)(zp + vc); const float4 w = *(const float4*)(dw + vc);
            const float o0 = O[4 * g] * sc * w.x * siluf(bflo(z.x)), o1 = O[4 * g + 1] * sc * w.y * siluf(bfhi(z.x));
            const float o2 = O[4 * g + 2] * sc * w.z * siluf(bflo(z.y)), o3 = O[4 * g + 3] * sc * w.w * siluf(bfhi(z.y));
            *(uint2*)(op + vc) = make_uint2(pk2(o0, o1), pk2(o2, o3));
        }
    }
}

__device__ __forceinline__ void phase_cat(const Params& p, int l, unsigned char* lds, int sub) {
    const int bid = bidx(), nb = gridDim.x;
    uint4 t0, t1, t2, t3, t4, t5; float gpre, bpre;
    if (bid < NITEM) gdn_chunk_load(p, bid, t0, t1, t2, t3, t4, t5, gpre, bpre);
#if defined(REP_SUB)
    if (sub != 7) { for (int it = bid; it < NITEM; it += nb) gdn_chunk_item(p, it, it + nb < NITEM ? it + nb : -1, lds, t0, t1, t2, t3, t4, t5, gpre, bpre, REP_SUB); return; }
#endif
    for (int it = bid; it < NITEM; it += nb) gdn_chunk_item(p, it, it + nb < NITEM ? it + nb : -1, lds, t0, t1, t2, t3, t4, t5, gpre, bpre);
}
constexpr int QCTR_OFF = 12288;
__device__ __forceinline__ int queue_pop(unsigned* ctr, unsigned char* lds) {
    __syncthreads();
    if (tidx() == 0) *(volatile int*)(lds + LDS_BYTES - 16) = (int)atomicAdd(ctr, 1u);
    __syncthreads();
    return *(volatile int*)(lds + LDS_BYTES - 16);
}
__device__ __forceinline__ void phase_scan(const Params& p, int l, unsigned char* lds, int sub) {
    const int wid = __builtin_amdgcn_readfirstlane(tidx() >> 6), bid = bidx(), nb = gridDim.x;
    const int npb = nb > 32 ? 32 : nb;
    if (bid < npb) for (int it = bid; it < 32; it += npb) gdn_scan_block(p, l, it >> 4, (it >> 1) & 7, it & 1, lds);
    unsigned* ctr = (unsigned*)(p.ws + WS_GLAST + QCTR_OFF) + l;
    for (;;) {
        const int it = queue_pop(ctr, lds);
        if (it >= 128 + 1024 + 128) break;
        if (it < 128) attn_sample_item(p, l, it >> 3, it & 7, lds);
        else if (it < 128 + 1024) { const int j = it - 128, qb = 63 - (j >> 4), bh = j & 15; attn_prompt_item(p, l, bh >> 3, bh & 7, qb, lds); }
        else {
            const int wi = (it - 1152) * 8 + wid, cb = wi & 7, h = (wi >> 3) & 7, b = wi >> 6;
            const size_t so = ((size_t)(l * 16 + b) * 8 + h) * 16384;
            gdn_scan_item(p, l, 256 + b, 1, h, cb, p.in[6] + so, p.out + O_SSMS + so, 32);
        }
    }
}

#define XB_TMO      128
#define XB_XCNT(j)  (256  + 64 * (j))
#define XB_XSUB(j)  (1280 + 64 * (j))
#define XB_XGEN(j)  (2304 + 64 * (j))
#define XB_TOP      3328
#define XB_TOPGEN   3392
#define XCD_BAR_WORDS 3456
#define XB_SPIN_CAP (1u << 18)
#define LAS __attribute__((address_space(3)))

__device__ __forceinline__ unsigned xb_ld(unsigned* p)              { return __hip_atomic_load(p, __ATOMIC_RELAXED, __HIP_MEMORY_SCOPE_AGENT); }
__device__ __forceinline__ unsigned xb_add(unsigned* p, unsigned v) { return __hip_atomic_fetch_add(p, v, __ATOMIC_RELAXED, __HIP_MEMORY_SCOPE_AGENT); }
__device__ __forceinline__ unsigned xb_xcc_id() { return (unsigned)__builtin_amdgcn_s_getreg((3 << 11) | 20) & 0xFu; }
#define XB_SPIN(cond, bar) do { unsigned _sp = 0; while (cond) { __builtin_amdgcn_s_sleep(1); \
    if ((++_sp & 255u) == 0u) { if (xb_ld(&(bar)[XB_TMO])) break; if (_sp > XB_SPIN_CAP) { atomicAdd(&(bar)[XB_TMO], 1u); break; } } } } while (0)

struct XcdBarrier {
    unsigned* bar; unsigned x;
    volatile LAS unsigned* st;
};

__device__ __forceinline__ XcdBarrier xcd_barrier_post(unsigned* bar, volatile LAS unsigned* st) {
    XcdBarrier b; b.bar = bar; b.x = xb_xcc_id(); b.st = st;
    if (tidx() == 0) (void)xb_add(&bar[XB_XCNT(b.x)], 1u);
    return b;
}
__device__ __forceinline__ void xcd_barrier_complete(unsigned* bar, unsigned x, unsigned& nloc, unsigned& nx) {
    const unsigned G = gridDim.x * gridDim.y * gridDim.z;
    unsigned sum, cnt, mine, sp = 0u;
    for (;;) {
        sum = 0u; cnt = 0u; mine = 0u;
#pragma unroll
        for (unsigned j = 0; j < 16; ++j) { const unsigned c = xb_ld(&bar[XB_XCNT(j)]); sum += c; cnt += (c > 0u) ? 1u : 0u; mine = (j == x) ? c : mine; }
        if (sum == G) break;
        __builtin_amdgcn_s_sleep(1);
        if ((++sp & 255u) == 0u) { if (xb_ld(&bar[XB_TMO])) break; if (sp > XB_SPIN_CAP) { atomicAdd(&bar[XB_TMO], 1u); break; } }
    }
    nloc = mine > 0u ? mine : 1u; nx = cnt > 0u ? cnt : 1u;
}

__device__ __forceinline__ void xcd_barrier(const XcdBarrier& b) {
    asm volatile("s_waitcnt vmcnt(0)" ::: "memory");
    __syncthreads();
    if (tidx() == 0) {
        unsigned* bar = b.bar;
        __builtin_amdgcn_s_waitcnt(0);
        unsigned nloc = b.st[0], nx = b.st[1];
        if (nloc == 0u) { xcd_barrier_complete(bar, b.x, nloc, nx); b.st[0] = nloc; b.st[1] = nx; }
        const unsigned old = xb_add(&bar[XB_XSUB(b.x)], 1u);
        const unsigned gen = old / nloc;
        if (old + 1u == (gen + 1u) * nloc) {
            __builtin_amdgcn_fence(__ATOMIC_RELEASE, "agent");
            asm volatile("s_waitcnt vmcnt(0)" ::: "memory");
            const unsigned og = xb_add(&bar[XB_TOP], 1u);
            const unsigned tg = og / nx;
            if (og + 1u == (tg + 1u) * nx) xb_add(&bar[XB_TOPGEN], 1u);
            else XB_SPIN(xb_ld(&bar[XB_TOPGEN]) == tg, bar);
            __builtin_amdgcn_fence(__ATOMIC_ACQUIRE, "agent");
            xb_add(&bar[XB_XGEN(b.x)], 1u);
            asm volatile("s_waitcnt vmcnt(0)" ::: "memory");
        } else {
            XB_SPIN(xb_ld(&bar[XB_XGEN(b.x)]) == gen, bar);
            __builtin_amdgcn_fence(__ATOMIC_ACQUIRE, "agent");
            asm volatile("s_waitcnt vmcnt(0)" ::: "memory");
        }
    }
    __syncthreads();
}

__global__ void __launch_bounds__(512, 2) fwd_kernel(Params p) {
    extern __shared__ __attribute__((aligned(16))) unsigned char lds[];
    cg::grid_group grid = cg::this_grid();
    if (tidx() == 0) { *(volatile unsigned*)(lds + LDS_BYTES - 32) = 0u; *(volatile unsigned*)(lds + LDS_BYTES - 28) = 0u; }
    __syncthreads();
    XcdBarrier xb = xcd_barrier_post((unsigned*)(p.ws + WS_BAR), (volatile LAS unsigned*)(lds + LDS_BYTES - 32));
    for (int ph = p.ph_lo; ph < p.ph_hi; ++ph) {
#ifdef REP_KIND
      const int nrep = ((ph == 0 ? 0 : (ph == 33 ? 9 : 1 + ((ph - 1) & 7))) == REP_KIND) ? 2 : 1;
      for (int rep = 0; rep < nrep; ++rep) {
        if (rep) grid.sync();
#endif
#ifndef ONLY
#define ONLY -1
#endif
#define EN(k) (ONLY < 0 || ONLY == (k))
#if defined(REP_KIND) && defined(REP_SUB)
#define CATSUB (rep ? REP_SUB : 7)
#else
#define CATSUB 7
#endif
        if (ph == 0) { if (EN(0)) phase_prep(p, lds); }
        else if (ph == 33) { if (EN(9)) phase_final(p); }
        else {
            const int l = (ph - 1) >> 3, k = (ph - 1) & 7;
            const u16* WTIN = (const u16*)(p.ws + WS_WTIN) + (size_t)l * LDP * 1024;
            if (k == 0) { if (EN(1)) phase_norm(p, l); }
            else if (k == 1) { if (EN(2)) { EpiP E; E.O = (u16*)(p.ws + WS_P); run_gemm(lds, (const u16*)(p.ws + WS_H), WTIN, NTOK, LDP, E); } }
            else if (k == 2) { if (EN(3)) phase_post1(p, l, lds); }
            else if (k == 3) { if (EN(4)) phase_cat(p, l, lds, CATSUB); }
            else if (k == 4) { if (EN(5)) phase_scan(p, l, lds, CATSUB); }
            else if (k == 5) { if (EN(6)) phase_post2(p, l); }
            else if (k == 6) { if (EN(7)) {
                EpiG2<0> E0; E0.P = (const u16*)(p.ws + WS_P); E0.T1 = (float*)(p.ws + WS_T1); E0.MG = (u16*)(p.ws + WS_MERGED);
                run_gemm(lds, (const u16*)(p.ws + WS_OAN), (const u16*)(p.ws + WS_WTPA) + (size_t)l * 1048576, NTOK, 1024, E0);
                __syncthreads();
                EpiG2<1> E1; E1.P = E0.P; E1.T1 = E0.T1; E1.MG = E0.MG;
                run_gemm(lds, (const u16*)(p.ws + WS_OBN), (const u16*)(p.ws + WS_WTPB) + (size_t)l * 1048576, NTOK, 1024, E1); }
            } else if (EN(8)) {
                EpiG3 E; E.X = (float*)(p.ws + WS_X); E.MODL = (const float*)(p.ws + WS_MOD) + (size_t)l * 18 * 3072;
                run_gemm(lds, (const u16*)(p.ws + WS_MERGED), (const u16*)(p.ws + WS_WTOUT) + (size_t)l * 1048576, NTOK, 1024, E);
            }
        }
#ifdef REP_KIND
      }
#endif
        if (ph + 1 < p.ph_hi) { if (ph == p.ph_lo) grid.sync(); else xcd_barrier(xb); }
#ifdef EXTRA_SYNC
        if (ph + 1 < p.ph_hi) { xcd_barrier(xb); xcd_barrier(xb); xcd_barrier(xb); }
#endif
    }
}

#ifndef MEGA
#define MEGA 1
#endif
extern "C" void kernel_launch(void* const* d_in, const int* in_sizes, int n_in, void* d_out, int out_size, void* d_ws, size_t ws_size, hipStream_t stream) {
    static int grid = 0;
    if (grid == 0) {
        int dev = 0, cus = 0;
        hipGetDevice(&dev);
        hipDeviceGetAttribute(&cus, hipDeviceAttributeMultiprocessorCount, dev);
        if (hipFuncSetAttribute((const void*)fwd_kernel, hipFuncAttributeMaxDynamicSharedMemorySize, LDS_BYTES) != hipSuccess) fprintf(stderr, "hipFuncSetAttribute failed\n");
        int per_cu = 0;
        hipOccupancyMaxActiveBlocksPerMultiprocessor(&per_cu, (const void*)fwd_kernel, 512, LDS_BYTES);
        if (per_cu < 1) fprintf(stderr, "occupancy query says %d blocks per CU\n", per_cu);
        (void)hipGetLastError();
        grid = cus > 0 ? cus : 256;
        if (ws_size < WS_END) fprintf(stderr, "workspace too small: %zu < %zu\n", ws_size, (size_t)WS_END);
    }
    Params p{};
    for (int i = 0; i < 22; ++i) p.in[i] = (const float*)d_in[i];
    p.out = (float*)d_out; p.ws = (unsigned char*)d_ws;
#if MEGA
    p.ph_lo = 0; p.ph_hi = 34;
    if (hipMemsetAsync((unsigned char*)d_ws + WS_BAR, 0, XCD_BAR_WORDS * 4, stream) != hipSuccess) fprintf(stderr, "memset of barrier words failed\n");
    void* args[] = {&p};
    hipError_t e = hipLaunchCooperativeKernel((const void*)fwd_kernel, dim3(grid), dim3(512), args, LDS_BYTES, stream);
    if (e != hipSuccess) fprintf(stderr, "cooperative launch failed: %s (grid %d)\n", hipGetErrorString(e), grid);
#else
    for (int ph = 0; ph < 34; ++ph) {
        p.ph_lo = ph; p.ph_hi = ph + 1;
        hipLaunchKernelGGL(fwd_kernel, dim3(grid), dim3(512), LDS_BYTES, stream, p);
    }
#endif
}
```
